# Optimizing an MI355X kernel written in HIP

```python
import math
import jax, jax.numpy as jnp
from jax import lax
import numpy as np

D_MODEL = 2048
BATCH = 4
SEQ = 4096
DEPTH = 1

NSA_HEADS = 16
NSA_GROUPS = 4
NSA_HEAD_DIM = 64
NSA_REP = NSA_HEADS // NSA_GROUPS
NSA_WIDTH = NSA_HEADS * NSA_HEAD_DIM
KV_WIDTH = NSA_GROUPS * NSA_HEAD_DIM
CMP_BLOCK = 32
CMP_STRIDE = 16
CMP_HIDDEN = 128
SEL_BLOCK = 64
SEL_TOPK = 8
WINDOW = 512
Q_BLOCK = 128

SSM_WIDTH = 1024
SSM_GROUP = 16
SSM_GROUPS = SSM_WIDTH // SSM_GROUP
SSM_STATE = 64
DT_MIN = 1e-3
DT_MAX = 1e-1

REL_BUCKETS = 32
REL_MAX_DIST = 128

DEEPNORM_ALPHA = (2 * DEPTH) ** 0.25
DEEPNORM_BETA = (8 * DEPTH) ** -0.25
LN_EPS = 1e-5
MASK_VALUE = -1e30
FORCE_VALUE = 1e4

IN_SPLITS = (NSA_WIDTH, 6 * KV_WIDTH, 3 * NSA_HEADS, NSA_WIDTH, SSM_WIDTH, SSM_WIDTH, D_MODEL, D_MODEL)
IN_WIDTH = sum(IN_SPLITS)

kernel_name = 'hybrid_nsa_s5_gated_block'


def _ln(x):
    xf = x.astype(jnp.float32)
    mu = jnp.mean(xf, axis=-1, keepdims=True)
    var = jnp.mean(jnp.square(xf - mu), axis=-1, keepdims=True)
    return ((xf - mu) * lax.rsqrt(var + LN_EPS)).astype(x.dtype)


def _t5_bucket(dist):
    n = jnp.maximum(dist, 0)
    max_exact = REL_BUCKETS // 2
    nf = jnp.maximum(n, max_exact).astype(jnp.float32)
    large = max_exact + (jnp.log(nf / max_exact) / math.log(REL_MAX_DIST / max_exact)
                         * (REL_BUCKETS - max_exact)).astype(jnp.int32)
    large = jnp.minimum(large, REL_BUCKETS - 1)
    return jnp.where(n < max_exact, n, large)


def _masked_softmax(s, valid):
    p = jax.nn.softmax(jnp.where(valid, s, MASK_VALUE), axis=-1)
    return jnp.where(valid, p, 0.0)


def _nsa(q, kv, gates, rel_bias, pos_k, pos_v, wk1, wk2, wv1, wv2):
    B, L, _ = q.shape
    G, R, dh = NSA_GROUPS, NSA_REP, NSA_HEAD_DIM
    dtype = q.dtype
    kc_in, vc_in, ks, vs, kw, vw = [t.reshape(B, L, G, dh) for t in jnp.split(kv, 6, axis=-1)]

    n_cmp = (L - CMP_BLOCK) // CMP_STRIDE + 1
    tok = jnp.arange(n_cmp)[:, None] * CMP_STRIDE + jnp.arange(CMP_BLOCK)[None, :]
    cmp_end = jnp.arange(n_cmp) * CMP_STRIDE + CMP_BLOCK - 1

    def compress(t, pos, w1, w2):
        blk = t[:, tok] + pos[:, None, :]
        blk = blk.transpose(0, 1, 3, 2, 4).reshape(B, n_cmp, G, CMP_BLOCK * dh)
        out = jax.nn.gelu(blk @ w1) @ w2
        return out.transpose(0, 2, 1, 3)

    kc = compress(kc_in, pos_k, wk1, wk2)
    vc = compress(vc_in, pos_v, wv1, wv2)

    n_sel = L // SEL_BLOCK
    n_top = min(SEL_TOPK, n_sel)
    ks_blk = ks.reshape(B, n_sel, SEL_BLOCK, G, dh).transpose(0, 3, 1, 2, 4)
    vs_blk = vs.reshape(B, n_sel, SEL_BLOCK, G, dh).transpose(0, 3, 1, 2, 4)
    ci = jnp.arange(n_cmp)[:, None] * CMP_STRIDE
    sj = jnp.arange(n_sel)[None, :] * SEL_BLOCK
    overlap = ((ci < sj + SEL_BLOCK) & (ci + CMP_BLOCK > sj)).astype(jnp.float32)
    blk_id = jnp.arange(n_sel)

    kw_pad = jnp.pad(kw, ((0, 0), (WINDOW, 0), (0, 0), (0, 0)))
    vw_pad = jnp.pad(vw, ((0, 0), (WINDOW, 0), (0, 0), (0, 0)))

    tbl = rel_bias.astype(jnp.float32)
    tbl_g = tbl.reshape(REL_BUCKETS, G, R).transpose(1, 0, 2)
    bi = jnp.arange(B)[:, None, None, None]
    gi = jnp.arange(G)[None, :, None, None]
    gi5 = jnp.arange(G)[None, :, None, None, None]
    scale = dh ** -0.5

    def head_bias(dist):
        b = tbl[_t5_bucket(dist)]
        return jnp.moveaxis(b, -1, 0).reshape(G, R, *dist.shape)

    n_qb = L // Q_BLOCK
    q_blocks = q.reshape(B, n_qb, Q_BLOCK, G, R, dh).transpose(1, 0, 3, 4, 2, 5)
    g_blocks = gates.reshape(B, n_qb, Q_BLOCK, NSA_HEADS, 3).transpose(1, 0, 2, 3, 4)

    def block_fn(args):
        cidx, qb, gb = args
        t = cidx * Q_BLOCK + jnp.arange(Q_BLOCK)
        qs = qb * scale

        s = jnp.einsum('bgrqd,bgnd->bgrqn', qs, kc).astype(jnp.float32)
        s = s + head_bias(t[:, None] - cmp_end[None, :])
        p_c = _masked_softmax(s, cmp_end[None, :] <= t[:, None])
        o_c = jnp.einsum('bgrqn,bgnd->bgrqd', p_c.astype(dtype), vc)

        imp = jnp.sum(p_c, axis=2) @ overlap
        cur = t // SEL_BLOCK
        forced = (blk_id[None, :] == 0) | (blk_id[None, :] == cur[:, None]) | (blk_id[None, :] == cur[:, None] - 1)
        imp = jnp.where(forced, FORCE_VALUE, imp)
        imp = jnp.where(blk_id[None, :] <= cur[:, None], imp, MASK_VALUE)
        _, sel = lax.top_k(imp, n_top)

        k_g = ks_blk[bi, gi, sel]
        v_g = vs_blk[bi, gi, sel]
        pos = sel[..., None] * SEL_BLOCK + jnp.arange(SEL_BLOCK)
        dist = t[None, None, :, None, None] - pos
        sb = jnp.moveaxis(tbl_g[gi5, _t5_bucket(dist)], -1, 2)
        s = jnp.einsum('bgrqd,bgqnkd->bgrqnk', qs, k_g).astype(jnp.float32) + sb
        n_tok = n_top * SEL_BLOCK
        s = s.reshape(B, G, R, Q_BLOCK, n_tok)
        valid_s = (dist >= 0).reshape(B, G, 1, Q_BLOCK, n_tok)
        p_s = _masked_softmax(s, valid_s)
        o_s = jnp.einsum('bgrqm,bgqmd->bgrqd', p_s.astype(dtype), v_g.reshape(B, G, Q_BLOCK, n_tok, dh))

        kwb = lax.dynamic_slice_in_dim(kw_pad, cidx * Q_BLOCK, WINDOW + Q_BLOCK, axis=1)
        vwb = lax.dynamic_slice_in_dim(vw_pad, cidx * Q_BLOCK, WINDOW + Q_BLOCK, axis=1)
        wpos = cidx * Q_BLOCK - WINDOW + jnp.arange(WINDOW + Q_BLOCK)
        wdist = t[:, None] - wpos[None, :]
        valid_w = (wpos[None, :] >= 0) & (wdist >= 0) & (wdist < WINDOW)
        s = jnp.einsum('bgrqd,bkgd->bgrqk', qs, kwb).astype(jnp.float32) + head_bias(wdist)
        p_w = _masked_softmax(s, valid_w)
        o_w = jnp.einsum('bgrqk,bkgd->bgrqd', p_w.astype(dtype), vwb)

        g = gb.transpose(0, 2, 1, 3).reshape(B, G, R, Q_BLOCK, 3)
        o = o_c * g[..., 0:1] + o_s * g[..., 1:2] + o_w * g[..., 2:3]
        return o.transpose(0, 3, 1, 2, 4).reshape(B, Q_BLOCK, NSA_WIDTH)

    out = lax.map(block_fn, (jnp.arange(n_qb), q_blocks, g_blocks))
    return out.transpose(1, 0, 2, 3).reshape(B, L, NSA_WIDTH)


def _cmul_combine(e1, e2):
    a1r, a1i, b1r, b1i = e1
    a2r, a2i, b2r, b2i = e2
    return (a2r * a1r - a2i * a1i,
            a2r * a1i + a2i * a1r,
            a2r * b1r - a2i * b1i + b2r,
            a2r * b1i + a2i * b1r + b2i)


def _s5(u, a_re, a_im, log_dt, b_re, b_im, c_re, c_im, d_skip, w_glu, b_glu):
    B, L, _ = u.shape
    f32 = jnp.float32
    dt = jnp.exp(log_dt.astype(f32))[:, None]
    ar, ai = a_re.astype(f32), a_im.astype(f32)
    mag = jnp.exp(ar * dt)
    lr, li = mag * jnp.cos(ai * dt), mag * jnp.sin(ai * dt)
    den = ar * ar + ai * ai
    nr, ni = lr - 1.0, li
    fr, fi = (nr * ar + ni * ai) / den, (ni * ar - nr * ai) / den
    br, bim = b_re.astype(f32), b_im.astype(f32)
    bbr = fr[..., None] * br - fi[..., None] * bim
    bbi = fr[..., None] * bim + fi[..., None] * br
    ug = u.astype(f32).reshape(B, L, SSM_GROUPS, SSM_GROUP).transpose(1, 0, 2, 3)
    xr = jnp.einsum('lbgc,gpc->lbgp', ug, bbr)
    xi = jnp.einsum('lbgc,gpc->lbgp', ug, bbi)
    lam_r = jnp.broadcast_to(lr[None, None], xr.shape)
    lam_i = jnp.broadcast_to(li[None, None], xr.shape)
    _, _, hr, hi = lax.associative_scan(_cmul_combine, (lam_r, lam_i, xr, xi), axis=0)
    y = (jnp.einsum('lbgp,gcp->lbgc', hr, c_re.astype(f32))
         - jnp.einsum('lbgp,gcp->lbgc', hi, c_im.astype(f32)))
    y = y.transpose(1, 0, 2, 3).reshape(B, L, SSM_WIDTH) + d_skip.astype(f32) * u.astype(f32)
    y = jax.nn.gelu(y).astype(u.dtype)
    return y * jax.nn.sigmoid(y @ w_glu + b_glu)


def setup_inputs(seed: int = 0) -> dict:
    key = jax.random.key(seed)
    k = jax.random.split(key, 32)
    f32 = jnp.float32
    D, dh = D_MODEL, NSA_HEAD_DIM

    def nrm(i, shape, std):
        return jax.random.normal(k[i], shape, f32) * std

    return {
        'x': nrm(0, (BATCH, SEQ, D), 1.0),
        'c': nrm(1, (BATCH, D), 1.0),
        'w_ada': nrm(2, (DEPTH, D, 3 * D), 0.5 * D ** -0.5),
        'b_ada': nrm(3, (DEPTH, 3 * D), 0.02),
        'w_in': nrm(4, (DEPTH, D, IN_WIDTH), D ** -0.5),
        'rel_bias': nrm(5, (REL_BUCKETS, NSA_HEADS), 0.2),
        'cmp_pos_k': nrm(6, (DEPTH, CMP_BLOCK, dh), 0.1),
        'cmp_pos_v': nrm(7, (DEPTH, CMP_BLOCK, dh), 0.1),
        'w_cmp_k1': nrm(8, (DEPTH, CMP_BLOCK * dh, CMP_HIDDEN), (CMP_BLOCK * dh) ** -0.5),
        'w_cmp_k2': nrm(9, (DEPTH, CMP_HIDDEN, dh), CMP_HIDDEN ** -0.5),
        'w_cmp_v1': nrm(10, (DEPTH, CMP_BLOCK * dh, CMP_HIDDEN), (CMP_BLOCK * dh) ** -0.5),
        'w_cmp_v2': nrm(11, (DEPTH, CMP_HIDDEN, dh), CMP_HIDDEN ** -0.5),
        'ssm_a_re': -0.5 + nrm(12, (DEPTH, SSM_GROUPS, SSM_STATE), 0.01),
        'ssm_a_im': jnp.pi * jnp.arange(SSM_STATE, dtype=f32)[None, None, :] + nrm(13, (DEPTH, SSM_GROUPS, SSM_STATE), 0.01),
        'ssm_log_dt': jax.random.uniform(k[14], (DEPTH, SSM_GROUPS), f32, math.log(DT_MIN), math.log(DT_MAX)),
        'ssm_b_re': nrm(15, (DEPTH, SSM_GROUPS, SSM_STATE, SSM_GROUP), (2 * SSM_GROUP) ** -0.5),
        'ssm_b_im': nrm(16, (DEPTH, SSM_GROUPS, SSM_STATE, SSM_GROUP), (2 * SSM_GROUP) ** -0.5),
        'ssm_c_re': nrm(17, (DEPTH, SSM_GROUPS, SSM_GROUP, SSM_STATE), 0.25),
        'ssm_c_im': nrm(18, (DEPTH, SSM_GROUPS, SSM_GROUP, SSM_STATE), 0.25),
        'ssm_d': nrm(19, (DEPTH, SSM_WIDTH), 1.0),
        'w_glu': nrm(20, (DEPTH, SSM_WIDTH, SSM_WIDTH), SSM_WIDTH ** -0.5),
        'b_glu': nrm(21, (DEPTH, SSM_WIDTH), 0.02),
        'w_branch_nsa': nrm(22, (DEPTH, NSA_WIDTH, D), NSA_WIDTH ** -0.5 * DEEPNORM_BETA),
        'w_branch_ssm': nrm(23, (DEPTH, SSM_WIDTH, D), SSM_WIDTH ** -0.5 * DEEPNORM_BETA),
        'w_out': nrm(24, (DEPTH, D, D), D ** -0.5 * DEEPNORM_BETA),
        'ln_g': 1.0 + nrm(25, (DEPTH, D), 0.02),
        'ln_b': nrm(26, (DEPTH, D), 0.02),
    }


def reference(x, c, w_ada, b_ada, w_in, rel_bias, cmp_pos_k, cmp_pos_v, w_cmp_k1, w_cmp_k2,
              w_cmp_v1, w_cmp_v2, ssm_a_re, ssm_a_im, ssm_log_dt, ssm_b_re, ssm_b_im, ssm_c_re,
              ssm_c_im, ssm_d, w_glu, b_glu, w_branch_nsa, w_branch_ssm, w_out, ln_g, ln_b):
    offs = np.cumsum(IN_SPLITS)[:-1].tolist()
    for i in range(DEPTH):
        mod = c @ w_ada[i] + b_ada[i]
        shift, scale, gate = jnp.split(mod, 3, axis=-1)
        h = _ln(x) * (1.0 + scale[:, None, :]) + shift[:, None, :]

        proj = h @ w_in[i]
        q, kv, ng, za, us, zb, ga, gb = jnp.split(proj, offs, axis=-1)

        o_a = _nsa(q, kv, jax.nn.sigmoid(ng), rel_bias, cmp_pos_k[i], cmp_pos_v[i],
                   w_cmp_k1[i], w_cmp_k2[i], w_cmp_v1[i], w_cmp_v2[i]) * jax.nn.silu(za)
        o_b = _s5(us, ssm_a_re[i], ssm_a_im[i], ssm_log_dt[i], ssm_b_re[i], ssm_b_im[i],
                  ssm_c_re[i], ssm_c_im[i], ssm_d[i], w_glu[i], b_glu[i]) * jax.nn.silu(zb)

        m = jax.nn.sigmoid(ga) * (o_a @ w_branch_nsa[i]) + jax.nn.sigmoid(gb) * (o_b @ w_branch_ssm[i])
        y = m @ w_out[i]

        x = _ln(DEEPNORM_ALPHA * x + gate[:, None, :] * y) * ln_g[i] + ln_b[i]
    return x
```

```cpp
#include <hip/hip_runtime.h>
#include <cstdio>
#include <cstdint>
namespace pg8 {
#define PG8_LAS __attribute__((address_space(3)))
typedef unsigned short bf16_t;
typedef short bf16x8 __attribute__((ext_vector_type(8)));
typedef float f32x4 __attribute__((ext_vector_type(4)));
typedef unsigned u32x4 __attribute__((ext_vector_type(4)));
constexpr int BM = 256, BK = 64, HALF = 128, HTB = HALF * BK * 2  , STAGE_BYTES = 8 * HTB, NXCD = 8, WGM = 8;

__host__ __device__ __forceinline__ int lds_byte(int r, int c) { const int st = (r >> 4) * 2 + (c >> 5), rr = r & 15, cc = c & 31, ob = rr * 64 + cc * 2; return st * 1024 + (ob ^ (((ob >> 9) & 1) << 5)); }
__host__ __device__ __forceinline__ void stage_rc(int b, int& R, int& C) { const int st = b / 1024, sb = b % 1024, swz = sb ^ (((sb >> 9) & 1) << 5); R = (st >> 1) * 16 + swz / 64; C = (st & 1) * 32 + (swz % 64) / 2; }
__host__ __device__ __forceinline__ int perm32(int rho) { const int n = rho >> 4, i = rho & 15; return 8 * (i >> 2) + 4 * n + (i & 3); }

struct Unit { int pm, pn; };
struct Gemm { const bf16_t* A; const bf16_t* Bt; int M, N, K; };

struct StaticOrder {
    int nM, nN, nwg, G, c;
    __host__ __device__ void init(int M, int N, int G_, int c_) { nM = M / BM; nN = N / BM; nwg = nM * nN; G = G_; c = c_; }
    __host__ __device__ bool next(int i, Unit& u) const {
        const long L = (long)i * G + c; if (L >= nwg) return false;
        int wgid = (int)L; { const int q = nwg / NXCD, r = nwg % NXCD, xcd = wgid % NXCD, off = wgid / NXCD; wgid = (xcd < r ? xcd * (q + 1) : r * (q + 1) + (xcd - r) * q) + off; }
        const int nig = WGM * nN, gid = wgid / nig, fm = gid * WGM, gsz = (nM - fm) < WGM ? (nM - fm) : WGM;
        u.pm = fm + ((wgid % nig) % gsz); u.pn = (wgid % nig) / gsz; return true;
    }
    __device__ __forceinline__ void a_ready(const Unit&) const {}
    __device__ __forceinline__ void done(const Unit&) const {}
};

__device__ __forceinline__ unsigned cvt_pk_bf16(float lo, float hi) { unsigned r; asm volatile("v_cvt_pk_bf16_f32 %0, %1, %2" : "=v"(r) : "v"(lo), "v"(hi)); return r; }
typedef float f32x2 __attribute__((ext_vector_type(2)));
__device__ __forceinline__ f32x2 gelu_pk(f32x2 v) {
    const f32x2 av = __builtin_elementwise_abs(v), d = av * 0.2316418882f + 1.0f;
    f32x2 t; t.x = __builtin_amdgcn_rcpf(d.x); t.y = __builtin_amdgcn_rcpf(d.y);
    f32x2 q = t * 0.5307027145f + (-0.7265760135f); q = q * t + 0.7107068705f; q = q * t + (-0.142248368f); q = q * t + 0.127414796f; q = q * t;
    const f32x2 s = (v * v) * (-0.72134752044f);
    f32x2 e; e.x = __builtin_amdgcn_exp2f(s.x); e.y = __builtin_amdgcn_exp2f(s.y);
    const f32x2 m = v * (q * e), r = v - m;
    f32x2 o; o.x = v.x < 0.f ? m.x : r.x; o.y = v.y < 0.f ? m.y : r.y; return o;
}

template <class Epi, class Sched, bool ALIGN_EPI = false, bool SP2 = false>
__device__ __forceinline__ void gemm_phase(PG8_LAS unsigned char* lds, const Gemm g, const Sched& S, const Epi& E) {
    const int tid = threadIdx.x, wid = __builtin_amdgcn_readfirstlane(tid >> 6), lane = tid & 63, wr = wid >> 2, wc = wid & 3, fr = lane & 15, fq = lane >> 4;
    const int K = g.K, nt = K / BK;
    unsigned voffA[2], voffB[2];
#pragma unroll
    for (int i = 0; i < 2; ++i) { int R, C; stage_rc(tid * 16 + i * 8192, R, C); const int Rb = Epi::PERM ? ((R & ~31) + perm32(R & 31)) : R;
        voffA[i] = (unsigned)(R * K + C) * 2u; voffB[i] = (unsigned)(Rb * K + C) * 2u; }
    const size_t kstep = (size_t)(BK * 2);
    const size_t hstep = (size_t)HALF * K * 2;
    const size_t tstep = 2 * hstep;
    const unsigned ldsw = (unsigned)wid * 1024u;
    const int aoff = lds_byte(wr * 64 + fr, fq * 8), boff = lds_byte(wc * 32 + fr, fq * 8);
#define PG8_SA(b, h) (((b) * 2 + (h)) * HTB)
#define PG8_SB(b, h) ((4 + (b) * 2 + (h)) * HTB)
#define PG8_STAGE(bufoff, gbase, voff) do { _Pragma("unroll") for (int _i = 0; _i < 2; ++_i) \
        __builtin_amdgcn_global_load_lds((const unsigned*)((const char*)(gbase) + (voff)[_i]), (PG8_LAS unsigned*)(lds + (bufoff) + ldsw + _i * 8192), 16, 0, 0); } while (0)
#define PG8_LDA(dst, b, h) do { _Pragma("unroll") for (int m = 0; m < 4; ++m) _Pragma("unroll") for (int k = 0; k < 2; ++k) dst[m][k] = *(const PG8_LAS bf16x8*)(lds + PG8_SA(b, h) + aoff + m * 2048 + k * 1024); } while (0)
#define PG8_LDB(dst, b, h) do { _Pragma("unroll") for (int n = 0; n < 2; ++n) _Pragma("unroll") for (int k = 0; k < 2; ++k) dst[n][k] = *(const PG8_LAS bf16x8*)(lds + PG8_SB(b, h) + boff + n * 2048 + k * 1024); } while (0)
#define PG8_MMA(ai, bj, At, Bt) do { __builtin_amdgcn_s_setprio(1); _Pragma("unroll") for (int m = 0; m < 4; ++m) _Pragma("unroll") for (int n = 0; n < 2; ++n) _Pragma("unroll") for (int k = 0; k < 2; ++k) \
        acc[ai][bj][m][n] = __builtin_amdgcn_mfma_f32_16x16x32_bf16(Bt[n][k], At[m][k], acc[ai][bj][m][n], 0, 0, 0); __builtin_amdgcn_s_setprio(0); } while (0)
#define PG8_WAIT_V(n) asm volatile("s_waitcnt vmcnt(" #n ")" ::: "memory")
#define PG8_WAIT_L(n) asm volatile("s_waitcnt lgkmcnt(" #n ")" ::: "memory")
#define PG8_BAR __builtin_amdgcn_s_barrier()
#define PG8_SCHED __builtin_amdgcn_sched_barrier(0)
    Unit cur, nxt; int ui = 0;
    if (!S.next(0, cur)) return;
    f32x4 acc[2][2][4][2];
#pragma unroll
    for (int a = 0; a < 2; ++a)
#pragma unroll
        for (int b = 0; b < 2; ++b)
#pragma unroll
            for (int m = 0; m < 4; ++m)
#pragma unroll
                for (int n = 0; n < 2; ++n) acc[a][b][m][n] = (f32x4){0.f, 0.f, 0.f, 0.f};
    bf16x8 At[4][2], B0[2][2], B1[2][2];
    const char* cA = (const char*)g.A + (size_t)cur.pm * tstep; const char* cB = (const char*)g.Bt + (size_t)cur.pn * tstep;
    S.a_ready(cur);
    if constexpr (SP2) {
        PG8_STAGE(PG8_SB(0, 0), cB, voffB); PG8_STAGE(PG8_SB(0, 1), cB + hstep, voffB); PG8_STAGE(PG8_SA(0, 0), cA, voffA); PG8_STAGE(PG8_SA(0, 1), cA + hstep, voffA);
        if (wr == 1) PG8_BAR;
        PG8_WAIT_V(2); PG8_BAR;
        PG8_STAGE(PG8_SB(1, 0), cB + kstep, voffB); PG8_STAGE(PG8_SA(1, 0), cA + kstep, voffA); PG8_STAGE(PG8_SB(1, 1), cB + hstep + kstep, voffB);
        PG8_WAIT_V(6); PG8_BAR;
    } else {
        PG8_STAGE(PG8_SB(0, 0), cB, voffB); PG8_STAGE(PG8_SA(0, 0), cA, voffA); PG8_STAGE(PG8_SB(0, 1), cB + hstep, voffB); PG8_STAGE(PG8_SA(0, 1), cA + hstep, voffA);
        if (wr == 1) PG8_BAR;
        PG8_WAIT_V(4); PG8_BAR;
        PG8_STAGE(PG8_SB(1, 0), cB + kstep, voffB); PG8_STAGE(PG8_SA(1, 0), cA + kstep, voffA); PG8_STAGE(PG8_SB(1, 1), cB + hstep + kstep, voffB);
        PG8_WAIT_V(6); PG8_BAR;
    }
    for (;;) {
        const bool has_next = S.next(ui + 1, nxt);
        const char* nA = has_next ? (const char*)g.A + (size_t)nxt.pm * tstep : cA; const char* nB = has_next ? (const char*)g.Bt + (size_t)nxt.pn * tstep : cB;
        for (int t = 0; t < nt; t += 2) {
            const bool last = (t == nt - 2);
            const char* a1 = cA + (size_t)(t + 1) * kstep;
            const char* a2 = last ? nA : cA + (size_t)(t + 2) * kstep; const char* b2 = last ? nB : cB + (size_t)(t + 2) * kstep;
            const char* a3 = a2 + kstep; const char* b3 = b2 + kstep;
            if (last && has_next) S.a_ready(nxt);
            if constexpr (SP2) {
            PG8_LDB(B0, 0, 0); PG8_LDB(B1, 0, 1); PG8_SCHED; PG8_LDA(At, 0, 0); PG8_STAGE(PG8_SA(1, 1), a1 + hstep, voffA);
            PG8_WAIT_V(8); PG8_WAIT_L(0); PG8_BAR; PG8_MMA(0, 0, At, B0); PG8_MMA(0, 1, At, B1); PG8_BAR; PG8_SCHED;
            PG8_LDA(At, 0, 1); PG8_STAGE(PG8_SB(0, 0), b2, voffB); PG8_STAGE(PG8_SB(0, 1), b2 + hstep, voffB); PG8_STAGE(PG8_SA(0, 0), a2, voffA);
            PG8_WAIT_V(8); PG8_WAIT_L(0); PG8_BAR; PG8_MMA(1, 0, At, B0); PG8_MMA(1, 1, At, B1); PG8_BAR; PG8_SCHED;
            PG8_LDB(B0, 1, 0); PG8_LDB(B1, 1, 1); PG8_SCHED; PG8_LDA(At, 1, 0); PG8_STAGE(PG8_SA(0, 1), a2 + hstep, voffA);
            PG8_WAIT_V(8); PG8_WAIT_L(0); PG8_BAR; PG8_MMA(0, 0, At, B0); PG8_MMA(0, 1, At, B1); PG8_BAR; PG8_SCHED;
            PG8_LDA(At, 1, 1); PG8_STAGE(PG8_SB(1, 0), b3, voffB); PG8_STAGE(PG8_SB(1, 1), b3 + hstep, voffB); PG8_STAGE(PG8_SA(1, 0), a3, voffA);
            PG8_WAIT_V(8); PG8_WAIT_L(0); PG8_BAR; PG8_MMA(1, 0, At, B0); PG8_MMA(1, 1, At, B1); PG8_BAR; PG8_SCHED;
            } else {
            PG8_LDB(B0, 0, 0); PG8_SCHED; PG8_LDA(At, 0, 0); PG8_STAGE(PG8_SA(1, 1), a1 + hstep, voffA);
            PG8_WAIT_L(8); PG8_BAR; PG8_WAIT_L(0); PG8_MMA(0, 0, At, B0); PG8_BAR; PG8_SCHED;
            PG8_LDB(B1, 0, 1); PG8_STAGE(PG8_SB(0, 0), b2, voffB);
            PG8_BAR; PG8_WAIT_L(0); PG8_MMA(0, 1, At, B1); PG8_BAR;
            PG8_LDA(At, 0, 1); PG8_STAGE(PG8_SA(0, 0), a2, voffA);
            PG8_BAR; PG8_WAIT_L(0); PG8_MMA(1, 0, At, B0); PG8_BAR; PG8_SCHED;
            PG8_STAGE(PG8_SB(0, 1), b2 + hstep, voffB);
            PG8_WAIT_V(6); PG8_BAR; PG8_MMA(1, 1, At, B1); PG8_BAR;
            PG8_LDB(B0, 1, 0); PG8_SCHED; PG8_LDA(At, 1, 0); PG8_STAGE(PG8_SA(0, 1), a2 + hstep, voffA);
            PG8_WAIT_L(8); PG8_BAR; PG8_WAIT_L(0); PG8_MMA(0, 0, At, B0); PG8_BAR; PG8_SCHED;
            PG8_LDB(B1, 1, 1); PG8_STAGE(PG8_SB(1, 0), b3, voffB);
            PG8_BAR; PG8_WAIT_L(0); PG8_MMA(0, 1, At, B1); PG8_BAR;
            PG8_LDA(At, 1, 1); PG8_STAGE(PG8_SA(1, 0), a3, voffA);
            PG8_BAR; PG8_WAIT_L(0); PG8_MMA(1, 0, At, B0); PG8_BAR; PG8_SCHED;
            PG8_STAGE(PG8_SB(1, 1), b3 + hstep, voffB);
            PG8_WAIT_V(6); PG8_BAR; PG8_MMA(1, 1, At, B1); PG8_BAR;
            }
        }
        if constexpr (ALIGN_EPI) { if (wr == 0) PG8_BAR; }
        if constexpr (!Epi::AFTER_DRAIN) { E(acc, cur, wr, wc, fr, fq); S.done(cur); }
        if (!has_next) break;
#pragma unroll
        for (int a = 0; a < 2; ++a)
#pragma unroll
            for (int b = 0; b < 2; ++b)
#pragma unroll
                for (int m = 0; m < 4; ++m)
#pragma unroll
                    for (int n = 0; n < 2; ++n) acc[a][b][m][n] = (f32x4){0.f, 0.f, 0.f, 0.f};
        cur = nxt; cA = nA; cB = nB; ++ui;
        if constexpr (ALIGN_EPI) { if (wr == 1) PG8_BAR; }
    }
    PG8_WAIT_V(0);
    if constexpr (!ALIGN_EPI) { if (wr == 0) PG8_BAR; }
    PG8_BAR;
    if constexpr (Epi::AFTER_DRAIN) { E.fused(acc, cur, wr, wc, fr, fq, lds, wid, lane); S.done(cur); }
#undef PG8_SA
#undef PG8_SB
#undef PG8_STAGE
#undef PG8_LDA
#undef PG8_LDB
#undef PG8_MMA
#undef PG8_WAIT_V
#undef PG8_WAIT_L
#undef PG8_BAR
#undef PG8_SCHED
}
}
#define GAS __attribute__((address_space(1)))
#define LAS __attribute__((address_space(3)))
typedef unsigned short bf16;
typedef unsigned v4u __attribute__((ext_vector_type(4)));
typedef float f32x4 __attribute__((ext_vector_type(4)));
typedef short bf16x8 __attribute__((ext_vector_type(8)));
typedef GAS unsigned gu32;
typedef GAS unsigned long long gu64;
#define RLX_AGENT __ATOMIC_RELAXED, __HIP_MEMORY_SCOPE_AGENT
#define LDS_WAIT() asm volatile("s_waitcnt lgkmcnt(0)" ::: "memory")
#define VM_WAIT() asm volatile("s_waitcnt vmcnt(0)" ::: "memory")
__device__ __forceinline__ unsigned long long rt() { return __builtin_amdgcn_s_memrealtime(); }
__device__ __forceinline__ unsigned f2bf(float f) { unsigned u = __builtin_bit_cast(unsigned, f); return (u + 0x7fffu + ((u >> 16) & 1u)) >> 16; }
__device__ __forceinline__ unsigned pk2(float lo, float hi) { return f2bf(lo) | (f2bf(hi) << 16); }

#define XB_TMO      128
#define XB_XCNT(j)  (256  + 64 * (j))
#define XB_XSUB(j)  (1280 + 64 * (j))
#define XB_XGEN(j)  (2304 + 64 * (j))
#define XB_TOP      3328
#define XB_TOPGEN   3392
#define XCD_BAR_WORDS 3456
#define XB_SPIN_CAP (1u << 18)

__device__ __forceinline__ unsigned xb_ld(unsigned* p)              { return __hip_atomic_load(p, __ATOMIC_RELAXED, __HIP_MEMORY_SCOPE_AGENT); }
__device__ __forceinline__ unsigned xb_add(unsigned* p, unsigned v) { return __hip_atomic_fetch_add(p, v, __ATOMIC_RELAXED, __HIP_MEMORY_SCOPE_AGENT); }
__device__ __forceinline__ unsigned xb_xcc_id() { return (unsigned)__builtin_amdgcn_s_getreg((3 << 11) | 20) & 0xFu; }
#define XB_SPIN(cond, bar) do { unsigned _sp = 0; while (cond) { __builtin_amdgcn_s_sleep(1); \
    if ((++_sp & 255u) == 0u) { if (xb_ld(&(bar)[XB_TMO])) break; if (_sp > XB_SPIN_CAP) { atomicAdd(&(bar)[XB_TMO], 1u); break; } } } } while (0)

struct XcdBarrier {
    unsigned* bar; unsigned x;
    volatile LAS unsigned* st;
};

__device__ __forceinline__ XcdBarrier xcd_barrier_post(unsigned* bar, volatile LAS unsigned* st) {
    XcdBarrier b; b.bar = bar; b.x = xb_xcc_id(); b.st = st;
    if (threadIdx.x == 0) (void)xb_add(&bar[XB_XCNT(b.x)], 1u);
    return b;
}
__device__ __forceinline__ void xcd_barrier_complete(unsigned* bar, unsigned x, unsigned& nloc, unsigned& nx) {
    const unsigned G = gridDim.x * gridDim.y * gridDim.z;
    unsigned sum, cnt, mine, sp = 0u;
    for (;;) {
        sum = 0u; cnt = 0u; mine = 0u;
#pragma unroll
        for (unsigned j = 0; j < 16; ++j) { const unsigned c = xb_ld(&bar[XB_XCNT(j)]); sum += c; cnt += (c > 0u) ? 1u : 0u; mine = (j == x) ? c : mine; }
        if (sum == G) break;
        __builtin_amdgcn_s_sleep(1);
        if ((++sp & 255u) == 0u) { if (xb_ld(&bar[XB_TMO])) break; if (sp > XB_SPIN_CAP) { atomicAdd(&bar[XB_TMO], 1u); break; } }
    }
    nloc = mine > 0u ? mine : 1u; nx = cnt > 0u ? cnt : 1u;
}

__device__ __forceinline__ void xcd_barrier(const XcdBarrier& b) {
    asm volatile("s_waitcnt vmcnt(0)" ::: "memory");
    __syncthreads();
    if (threadIdx.x == 0) {
        unsigned* bar = b.bar;
        __builtin_amdgcn_s_waitcnt(0);
        unsigned nloc = b.st[0], nx = b.st[1];
        if (nloc == 0u) { xcd_barrier_complete(bar, b.x, nloc, nx); b.st[0] = nloc; b.st[1] = nx; }
        const unsigned old = xb_add(&bar[XB_XSUB(b.x)], 1u);
        const unsigned gen = old / nloc;
        if (old + 1u == (gen + 1u) * nloc) {
            __builtin_amdgcn_fence(__ATOMIC_RELEASE, "agent");
            asm volatile("s_waitcnt vmcnt(0)" ::: "memory");
            const unsigned og = xb_add(&bar[XB_TOP], 1u);
            const unsigned tg = og / nx;
            if (og + 1u == (tg + 1u) * nx) xb_add(&bar[XB_TOPGEN], 1u);
            else XB_SPIN(xb_ld(&bar[XB_TOPGEN]) == tg, bar);
            __builtin_amdgcn_fence(__ATOMIC_ACQUIRE, "agent");
            xb_add(&bar[XB_XGEN(b.x)], 1u);
            asm volatile("s_waitcnt vmcnt(0)" ::: "memory");
        } else {
            XB_SPIN(xb_ld(&bar[XB_XGEN(b.x)]) == gen, bar);
            __builtin_amdgcn_fence(__ATOMIC_ACQUIRE, "agent");
            asm volatile("s_waitcnt vmcnt(0)" ::: "memory");
        }
    }
    __syncthreads();
}

constexpr int NB = 4, SEQ = 4096, DM = 2048, MTOK = NB * SEQ;
constexpr int NHEAD = 16, NGRP = 4, HDIM = 64, NSAW = 1024, KVW = 256;
constexpr int SSMW = 1024;
constexpr int INW = 9776, INWP = 9984;
constexpr int CHUNK = 256, NCHUNK = SEQ / CHUNK;
constexpr float LN_EPS = 1e-5f;
constexpr float DN_ALPHA = 1.189207115002721f;
constexpr int NWAVES = 8, NTHR = 512;
constexpr int LDS_BYTES = 147456, RING_BYTES = 131072, MISC_OFF = RING_BYTES + 320;

constexpr size_t MiB = 1u << 20;
constexpr size_t WS_CTL = 0, CTL_ZERO_BYTES = 1 * MiB;
constexpr int CW_BAR = 4096;
constexpr size_t WS_MOD = 256 * 1024;
constexpr size_t WS_LUT = 512 * 1024;
constexpr size_t WS_BP = 520 * 1024;
constexpr size_t WS_KC = 1 * MiB;
constexpr size_t WS_VCT = 1 * MiB + 512 * 1024;
constexpr size_t WS_E = 2 * MiB;
constexpr size_t WS_WIN = 4 * MiB;
constexpr size_t WS_WGLU = 43 * MiB;
constexpr size_t WS_WBN = 45 * MiB;
constexpr size_t WS_WBS = 49 * MiB;
constexpr size_t WS_WOUT = 53 * MiB;
constexpr size_t WS_WK1 = 61 * MiB;
constexpr size_t WS_WV1 = 61 * MiB + 512 * 1024;
constexpr size_t WS_WK2 = 62 * MiB;
constexpr size_t WS_WV2 = 62 * MiB + 64 * 1024;
constexpr size_t WS_H = 64 * MiB;
constexpr size_t WS_Q = 128 * MiB;
constexpr size_t WS_KCI = 160 * MiB, WS_VCI = 168 * MiB, WS_KS = 176 * MiB, WS_KW = 184 * MiB;
constexpr size_t WS_VST = 192 * MiB, WS_VWT = 200 * MiB;
constexpr size_t WS_NGB = 208 * MiB;
constexpr size_t WS_ZA = 212 * MiB;
constexpr size_t WS_US = 244 * MiB;
constexpr size_t WS_ZB = 276 * MiB;
constexpr size_t WS_GA = 308 * MiB, WS_GB = 372 * MiB;
constexpr size_t WS_END = 436 * MiB;

typedef unsigned u32x2 __attribute__((ext_vector_type(2)));
typedef short s16x4 __attribute__((ext_vector_type(4)));

__device__ __forceinline__ float bflo(unsigned u) { return __builtin_bit_cast(float, u << 16); }
__device__ __forceinline__ float bfhi(unsigned u) { return __builtin_bit_cast(float, u & 0xffff0000u); }
__device__ __forceinline__ float bf2f(bf16 h) { return __builtin_bit_cast(float, (unsigned)h << 16); }
__device__ __forceinline__ unsigned cvtpk(float lo, float hi) { return pg8::cvt_pk_bf16(lo, hi); }
__device__ __forceinline__ float fexp(float x) { return __builtin_amdgcn_exp2f(x * 1.4426950408889634f); }
__device__ __forceinline__ float sigmoidf_(float v) { return __builtin_amdgcn_rcpf(1.f + fexp(-v)); }
__device__ __forceinline__ float siluf_(float v) { return v * sigmoidf_(v); }
__device__ __forceinline__ float gelu_tanh(float x) {
    const float z = 0.7978845608028654f * (x + 0.044715f * x * x * x);
    const float e = fexp(2.f * z);
    const float th = 1.f - 2.f * __builtin_amdgcn_rcpf(1.f + e);
    return 0.5f * x * (1.f + th);
}
__device__ __forceinline__ bf16x8 pack8(float a0, float a1, float a2, float a3, float a4, float a5, float a6, float a7) {
    v4u w; w.x = cvtpk(a0, a1); w.y = cvtpk(a2, a3); w.z = cvtpk(a4, a5); w.w = cvtpk(a6, a7);
    return __builtin_bit_cast(bf16x8, w);
}
__device__ __forceinline__ f32x4 mfma16(bf16x8 a, bf16x8 b, f32x4 c) { return __builtin_amdgcn_mfma_f32_16x16x32_bf16(a, b, c, 0, 0, 0); }
__device__ __forceinline__ float wave_sum(float v) {
#pragma unroll
    for (int o = 1; o < 64; o <<= 1) v += __shfl_xor(v, o);
    return v;
}

struct Ctx {
    float* out; unsigned char* ws;
    LAS unsigned char* lds;
    int tid, lane, wave, G, bid;
};
constexpr int PTR_OFF = RING_BYTES + 512;
__device__ __forceinline__ const float* inp(const Ctx& C, int i) {
    const LAS unsigned* tab = (const LAS unsigned*)(C.lds + PTR_OFF);
    const unsigned lo = __builtin_amdgcn_readfirstlane(tab[2 * i]), hi = __builtin_amdgcn_readfirstlane(tab[2 * i + 1]);
    return (const float*)(((unsigned long long)hi << 32) | lo);
}
#define WSP(T, off) ((T*)(C.ws + (off)))

struct EpiIn {
    static constexpr bool PERM = true, AFTER_DRAIN = false;
    unsigned char* ws;
    __device__ __forceinline__ void operator()(const pg8::f32x4 (&acc)[2][2][4][2], const pg8::Unit& u, int wr, int wc, int fr, int fq) const {
        const int pn = u.pn;
        int mode; size_t off; int ld; int cb;
        if (pn < 4) { mode = 1; off = WS_Q; ld = 1024; cb = pn * 256; }
        else if (pn < 10) { const int s = pn - 4; ld = 256; cb = 0; mode = 0;
            if (s == 0) off = WS_KCI; else if (s == 1) off = WS_VCI; else if (s == 2) off = WS_KS; else if (s == 3) { off = WS_VST; mode = 4; } else if (s == 4) off = WS_KW; else { off = WS_VWT; mode = 4; } }
        else if (pn < 14) { mode = 2; off = WS_ZA; ld = 1024; cb = (pn - 10) * 256; }
        else if (pn < 18) { mode = 0; off = WS_US; ld = 1024; cb = (pn - 14) * 256; }
        else if (pn < 22) { mode = 2; off = WS_ZB; ld = 1024; cb = (pn - 18) * 256; }
        else if (pn < 30) { mode = 3; off = WS_GA; ld = 2048; cb = (pn - 22) * 256; }
        else if (pn < 38) { mode = 3; off = WS_GB; ld = 2048; cb = (pn - 30) * 256; }
        else { mode = 5; off = WS_NGB; ld = 64; cb = 0; }
        bf16* base = (bf16*)(ws + off);
        const int row0 = u.pm * 256 + wr * 64 + fr;
#pragma unroll
        for (int ai = 0; ai < 2; ++ai)
#pragma unroll
            for (int m = 0; m < 4; ++m) {
                const int row = row0 + ai * 128 + m * 16;
#pragma unroll
                for (int bj = 0; bj < 2; ++bj) {
                    const int cc = bj * 128 + wc * 32 + 8 * fq;
                    float v[8];
#pragma unroll
                    for (int e = 0; e < 4; ++e) { v[e] = acc[ai][bj][m][0][e]; v[4 + e] = acc[ai][bj][m][1][e]; }
                    if (mode == 1) {
#pragma unroll
                        for (int e = 0; e < 8; ++e) v[e] *= 0.125f;
                    } else if (mode == 2) {
#pragma unroll
                        for (int e = 0; e < 8; ++e) v[e] = siluf_(v[e]);
                    } else if (mode == 3 || mode == 5) {
#pragma unroll
                        for (int e = 0; e < 8; ++e) v[e] = sigmoidf_(v[e]);
                    }
                    if (mode == 4) {
                        const int b = row >> 12, t = row & 4095, g = cc >> 6, d0 = cc & 63;
                        bf16* p = base + ((size_t)((b * 4 + g) * 64 + d0) << 12) + t;
#pragma unroll
                        for (int e = 0; e < 8; ++e) p[(size_t)e << 12] = (bf16)(cvtpk(v[e], 0.f) & 0xffffu);
                    } else if (mode == 5) {
                        if (cc < 48) { v4u w; w.x = cvtpk(v[0], v[1]); w.y = cvtpk(v[2], v[3]); w.z = cvtpk(v[4], v[5]); w.w = cvtpk(v[6], v[7]);
                            *(v4u*)(base + (size_t)row * 64 + cc) = w; }
                    } else {
                        v4u w; w.x = cvtpk(v[0], v[1]); w.y = cvtpk(v[2], v[3]); w.z = cvtpk(v[4], v[5]); w.w = cvtpk(v[6], v[7]);
                        *(v4u*)(base + (size_t)row * ld + cb + cc) = w;
                    }
                }
            }
    }
};

template <int MODE> struct EpiMix {
    static constexpr bool PERM = true, AFTER_DRAIN = false;
    const bf16* P0; const bf16* P1; bf16* O; const float* F0; const float* F1; float* OF; int ld;
    __device__ __forceinline__ void operator()(const pg8::f32x4 (&acc)[2][2][4][2], const pg8::Unit& u, int wr, int wc, int fr, int fq) const {
        const int row0 = u.pm * 256 + wr * 64 + fr;
#pragma unroll
        for (int ai = 0; ai < 2; ++ai)
#pragma unroll
            for (int m = 0; m < 4; ++m) {
                const int row = row0 + ai * 128 + m * 16;
#pragma unroll
                for (int bj = 0; bj < 2; ++bj) {
                    const int col = u.pn * 256 + bj * 128 + wc * 32 + 8 * fq;
                    float v[8];
#pragma unroll
                    for (int e = 0; e < 4; ++e) { v[e] = acc[ai][bj][m][0][e]; v[4 + e] = acc[ai][bj][m][1][e]; }
                    const size_t idx = (size_t)row * ld + col;
                    if (MODE == 0) {
                        const v4u y = *(const v4u*)(P0 + idx), z = *(const v4u*)(P1 + idx);
                        const f32x4 b0 = *(const f32x4*)(F0 + col), b1 = *(const f32x4*)(F0 + col + 4);
                        const float bb[8] = {b0.x, b0.y, b0.z, b0.w, b1.x, b1.y, b1.z, b1.w};
                        const unsigned yy[4] = {y.x, y.y, y.z, y.w}, zz[4] = {z.x, z.y, z.z, z.w};
#pragma unroll
                        for (int e = 0; e < 4; ++e) {
                            v[2 * e] = bflo(yy[e]) * sigmoidf_(v[2 * e] + bb[2 * e]) * bflo(zz[e]);
                            v[2 * e + 1] = bfhi(yy[e]) * sigmoidf_(v[2 * e + 1] + bb[2 * e + 1]) * bfhi(zz[e]);
                        }
                    } else if (MODE == 1) {
                        const v4u g = *(const v4u*)(P0 + idx); const unsigned gg[4] = {g.x, g.y, g.z, g.w};
#pragma unroll
                        for (int e = 0; e < 4; ++e) { v[2 * e] *= bflo(gg[e]); v[2 * e + 1] *= bfhi(gg[e]); }
                    } else if (MODE == 2) {
                        const v4u g = *(const v4u*)(P0 + idx), m1 = *(const v4u*)(P1 + idx);
                        const unsigned gg[4] = {g.x, g.y, g.z, g.w}, mm[4] = {m1.x, m1.y, m1.z, m1.w};
#pragma unroll
                        for (int e = 0; e < 4; ++e) { v[2 * e] = bflo(mm[e]) + v[2 * e] * bflo(gg[e]); v[2 * e + 1] = bfhi(mm[e]) + v[2 * e + 1] * bfhi(gg[e]); }
                    } else {
                        const int b = row >> 12;
                        const f32x4 x0 = *(const f32x4*)(F0 + idx), x1 = *(const f32x4*)(F0 + idx + 4);
                        const f32x4 g0 = *(const f32x4*)(F1 + b * 6144 + 4096 + col), g1 = *(const f32x4*)(F1 + b * 6144 + 4096 + col + 4);
                        f32x4 o0, o1;
                        o0.x = DN_ALPHA * x0.x + g0.x * v[0]; o0.y = DN_ALPHA * x0.y + g0.y * v[1]; o0.z = DN_ALPHA * x0.z + g0.z * v[2]; o0.w = DN_ALPHA * x0.w + g0.w * v[3];
                        o1.x = DN_ALPHA * x1.x + g1.x * v[4]; o1.y = DN_ALPHA * x1.y + g1.y * v[5]; o1.z = DN_ALPHA * x1.z + g1.z * v[6]; o1.w = DN_ALPHA * x1.w + g1.w * v[7];
                        *(f32x4*)(OF + idx) = o0; *(f32x4*)(OF + idx + 4) = o1;
                    }
                    if (MODE != 3) { v4u w; w.x = cvtpk(v[0], v[1]); w.y = cvtpk(v[2], v[3]); w.z = cvtpk(v[4], v[5]); w.w = cvtpk(v[6], v[7]); *(v4u*)(O + idx) = w; }
                }
            }
    }
};

__device__ __forceinline__ int win_src_col(int n) { return n < 2560 ? n : (n < 9728 ? n + 48 : (n < 9776 ? n - 9728 + 2560 : -1)); }
template <bool WIN>
__device__ __forceinline__ void transpose_item(const float* W, int K, int N, int NP, bf16* WT, LAS float* scr, int item, int lane) {
    const int nblk = NP / 32, kb = item / nblk, nb = item % nblk, k0 = 64 * kb, n0 = 32 * nb;
    const int nn = n0 + (lane & 31); const int sc = WIN ? win_src_col(nn) : nn;
#pragma unroll 8
    for (int i = 0; i < 32; ++i) { const int kk = 2 * i + (lane >> 5); scr[kk * 33 + (lane & 31)] = (sc >= 0) ? W[(size_t)(k0 + kk) * N + sc] : 0.f; }
    LDS_WAIT(); asm volatile("" ::: "memory");
    const int c = lane & 7;
#pragma unroll
    for (int j = 0; j < 4; ++j) { const int n = (lane >> 3) + 8 * j; const LAS float* s = scr + (8 * c) * 33 + n;
        v4u o; o.x = cvtpk(s[0 * 33], s[1 * 33]); o.y = cvtpk(s[2 * 33], s[3 * 33]); o.z = cvtpk(s[4 * 33], s[5 * 33]); o.w = cvtpk(s[6 * 33], s[7 * 33]);
        *(v4u*)(WT + (size_t)(n0 + n) * K + k0 + 8 * c) = o; }
    LDS_WAIT(); asm volatile("" ::: "memory");
}

__device__ __forceinline__ void phase0(const Ctx& C) {
    LAS float* scr = (LAS float*)(C.lds + C.wave * 16384);
    const int gw = C.bid * NWAVES + C.wave, NGW = C.G * NWAVES, lane = C.lane;
    {
        const float* cvec = inp(C, 1); const float* wada = inp(C, 2); const float* bada = inp(C, 3); float* mod = WSP(float, WS_MOD);
        for (int it = gw; it < 16 * 24; it += NGW) {
            const int kc = it / 24, nc = it % 24, n0 = nc * 256 + 4 * lane;
            f32x4 a0 = {0, 0, 0, 0}, a1 = a0, a2 = a0, a3 = a0;
#pragma unroll 8
            for (int k = kc * 128; k < kc * 128 + 128; ++k) {
                const f32x4 w = *(const f32x4*)(wada + (size_t)k * 6144 + n0);
                a0 += w * cvec[k]; a1 += w * cvec[2048 + k]; a2 += w * cvec[4096 + k]; a3 += w * cvec[6144 + k];
            }
            if (kc == 0) { const f32x4 bb = *(const f32x4*)(bada + n0); a0 += bb; a1 += bb; a2 += bb; a3 += bb; }
            const f32x4 aa[4] = {a0, a1, a2, a3};
#pragma unroll
            for (int b = 0; b < 4; ++b) { atomicAdd(mod + b * 6144 + n0 + 0, aa[b].x); atomicAdd(mod + b * 6144 + n0 + 1, aa[b].y); atomicAdd(mod + b * 6144 + n0 + 2, aa[b].z); atomicAdd(mod + b * 6144 + n0 + 3, aa[b].w); }
        }
    }
    {
        constexpr int I_IN = 32 * (INWP / 32), I_GLU = 16 * 32, I_BN = 16 * 64, I_OUT = 32 * 64, I_C1 = 32 * 4, I_C2 = 2 * 2;
        constexpr int NIT = I_IN + I_GLU + 2 * I_BN + I_OUT + 2 * I_C1 + 2 * I_C2;
        for (int it = gw; it < NIT; it += NGW) {
            int r = it;
            if (r < I_IN) { transpose_item<true>(inp(C, 4), 2048, INW, INWP, WSP(bf16, WS_WIN), scr, r, lane); continue; } r -= I_IN;
            if (r < I_GLU) { transpose_item<false>(inp(C, 20), 1024, 1024, 1024, WSP(bf16, WS_WGLU), scr, r, lane); continue; } r -= I_GLU;
            if (r < I_BN) { transpose_item<false>(inp(C, 22), 1024, 2048, 2048, WSP(bf16, WS_WBN), scr, r, lane); continue; } r -= I_BN;
            if (r < I_BN) { transpose_item<false>(inp(C, 23), 1024, 2048, 2048, WSP(bf16, WS_WBS), scr, r, lane); continue; } r -= I_BN;
            if (r < I_OUT) { transpose_item<false>(inp(C, 24), 2048, 2048, 2048, WSP(bf16, WS_WOUT), scr, r, lane); continue; } r -= I_OUT;
            if (r < I_C1) { transpose_item<false>(inp(C, 8), 2048, 128, 128, WSP(bf16, WS_WK1), scr, r, lane); continue; } r -= I_C1;
            if (r < I_C1) { transpose_item<false>(inp(C, 10), 2048, 128, 128, WSP(bf16, WS_WV1), scr, r, lane); continue; } r -= I_C1;
            if (r < I_C2) { transpose_item<false>(inp(C, 9), 128, 64, 64, WSP(bf16, WS_WK2), scr, r, lane); continue; } r -= I_C2;
            transpose_item<false>(inp(C, 11), 128, 64, 64, WSP(bf16, WS_WV2), scr, r, lane);
        }
    }
    if (C.bid == C.G - 1) {
        const float* rb = inp(C, 5); float* lut = WSP(float, WS_LUT);
        for (int i = C.tid; i < 16 * 128; i += NTHR) {
            const int h = i >> 7, d = i & 127; int bk;
            if (d < 16) bk = d; else { const float v = logf((float)d / 16.f) / 2.0794415416798357f * 16.f; bk = 16 + (int)v; if (bk > 31) bk = 31; }
            lut[i] = rb[bk * 16 + h];
        }
    }
}

__device__ __forceinline__ void phase1(const Ctx& C) {
    const int gw = C.bid * NWAVES + C.wave, NGW = C.G * NWAVES, lane = C.lane;
    const float* x = inp(C, 0); const float* mod = WSP(float, WS_MOD); bf16* H = WSP(bf16, WS_H);
    for (int m = gw; m < MTOK; m += NGW) {
        const int b = m >> 12;
        const f32x4* xr = (const f32x4*)(x + (size_t)m * DM) + lane;
        f32x4 v[8]; float s = 0.f;
#pragma unroll
        for (int j = 0; j < 8; ++j) { v[j] = xr[64 * j]; s += (v[j].x + v[j].y) + (v[j].z + v[j].w); }
        const float mean = wave_sum(s) * (1.f / DM); float s2 = 0.f;
#pragma unroll
        for (int j = 0; j < 8; ++j) { v[j] = v[j] - mean; s2 += (v[j].x * v[j].x + v[j].y * v[j].y) + (v[j].z * v[j].z + v[j].w * v[j].w); }
        const float rstd = 1.f / sqrtf(wave_sum(s2) * (1.f / DM) + LN_EPS);
        const f32x4* sh = (const f32x4*)(mod + b * 6144) + lane; const f32x4* sc = (const f32x4*)(mod + b * 6144 + 2048) + lane;
        u32x2* o8 = (u32x2*)(H + (size_t)m * DM) + lane;
#pragma unroll
        for (int j = 0; j < 8; ++j) {
            const f32x4 a = sh[64 * j], g = sc[64 * j];
            const float h0 = v[j].x * rstd * (1.f + g.x) + a.x, h1 = v[j].y * rstd * (1.f + g.y) + a.y, h2 = v[j].z * rstd * (1.f + g.z) + a.z, h3 = v[j].w * rstd * (1.f + g.w) + a.w;
            u32x2 w; w.x = cvtpk(h0, h1); w.y = cvtpk(h2, h3); o8[64 * j] = w;
        }
    }
    for (int it = gw; it < 256; it += NGW) {
        const int kv = it >> 7, uu = it & 127; const float* pos = inp(C, kv ? 7 : 6); const float* w1 = inp(C, kv ? 10 : 8);
        float s = 0.f;
        for (int k = lane; k < 2048; k += 64) s += pos[k] * w1[(size_t)k * 128 + uu];
        s = wave_sum(s);
        if (lane == 0) WSP(float, WS_BP)[it] = s;
    }
}

__device__ __forceinline__ void phase_ln_out(const Ctx& C) {
    const int gw = C.bid * NWAVES + C.wave, NGW = C.G * NWAVES, lane = C.lane;
    const float* lg = inp(C, 25); const float* lb = inp(C, 26);
    for (int m = gw; m < MTOK; m += NGW) {
        f32x4* zr = (f32x4*)(C.out + (size_t)m * DM) + lane;
        f32x4 v[8]; float s = 0.f;
#pragma unroll
        for (int j = 0; j < 8; ++j) { v[j] = zr[64 * j]; s += (v[j].x + v[j].y) + (v[j].z + v[j].w); }
        const float mean = wave_sum(s) * (1.f / DM); float s2 = 0.f;
#pragma unroll
        for (int j = 0; j < 8; ++j) { v[j] = v[j] - mean; s2 += (v[j].x * v[j].x + v[j].y * v[j].y) + (v[j].z * v[j].z + v[j].w * v[j].w); }
        const float rstd = 1.f / sqrtf(wave_sum(s2) * (1.f / DM) + LN_EPS);
#pragma unroll
        for (int j = 0; j < 8; ++j) {
            const f32x4 g = ((const f32x4*)lg)[lane + 64 * j], bb = ((const f32x4*)lb)[lane + 64 * j];
            f32x4 o; o.x = v[j].x * rstd * g.x + bb.x; o.y = v[j].y * rstd * g.y + bb.y; o.z = v[j].z * rstd * g.z + bb.z; o.w = v[j].w * rstd * g.w + bb.w;
            zr[64 * j] = o;
        }
    }
}

constexpr int XS = 132;
constexpr int HS = 136;
constexpr int SSM_WAVE_LDS = 16 * XS * 4 + 16 * HS * 2;
template <bool FINAL>
__device__ __forceinline__ void ssm_item(const Ctx& C, int item, LAS unsigned char* wl) {
    const int lane = C.lane, c16 = lane & 15, q = lane >> 4;
    const int chunk = item & (NCHUNK - 1), g = (item >> 4) & 63, b = item >> 10;
    if (!FINAL && chunk == NCHUNK - 1) return;
    const float* a_re = inp(C, 12); const float* a_im = inp(C, 13); const float* log_dt = inp(C, 14);
    const float* b_re = inp(C, 15); const float* b_im = inp(C, 16); const float* c_re = inp(C, 17); const float* c_im = inp(C, 18); const float* dsk = inp(C, 19);
    const bf16* US = WSP(bf16, WS_US); float* E = WSP(float, WS_E);
    LAS float* Xs = (LAS float*)wl; LAS bf16* Hs = (LAS bf16*)(wl + 16 * XS * 4);
    const float dt = expf(log_dt[g]);
    float lr, li;
    { const float ar = a_re[g * 64 + lane], ai = a_im[g * 64 + lane]; const float mag = expf(ar * dt); lr = mag * cosf(ai * dt); li = mag * sinf(ai * dt); }
    bf16x8 Bf[8];
#pragma unroll
    for (int s = 0; s < 4; ++s) {
        const int ps = g * 64 + 16 * s + c16;
        const float ar = a_re[ps], ai = a_im[ps]; const float mag = expf(ar * dt), l_r = mag * cosf(ai * dt), l_i = mag * sinf(ai * dt);
        const float den = ar * ar + ai * ai, nr = l_r - 1.f, ni = l_i;
        const float fr = (nr * ar + ni * ai) / den, fi = (ni * ar - nr * ai) / den;
        if (q < 2) {
            const f32x4 r0 = *(const f32x4*)(b_re + (size_t)ps * 16 + 8 * q), r1 = *(const f32x4*)(b_re + (size_t)ps * 16 + 8 * q + 4);
            const f32x4 i0 = *(const f32x4*)(b_im + (size_t)ps * 16 + 8 * q), i1 = *(const f32x4*)(b_im + (size_t)ps * 16 + 8 * q + 4);
            Bf[s] = pack8(fr * r0.x - fi * i0.x, fr * r0.y - fi * i0.y, fr * r0.z - fi * i0.z, fr * r0.w - fi * i0.w, fr * r1.x - fi * i1.x, fr * r1.y - fi * i1.y, fr * r1.z - fi * i1.z, fr * r1.w - fi * i1.w);
            Bf[4 + s] = pack8(fr * i0.x + fi * r0.x, fr * i0.y + fi * r0.y, fr * i0.z + fi * r0.z, fr * i0.w + fi * r0.w, fr * i1.x + fi * r1.x, fr * i1.y + fi * r1.y, fr * i1.z + fi * r1.z, fr * i1.w + fi * r1.w);
        } else { Bf[s] = (bf16x8){0, 0, 0, 0, 0, 0, 0, 0}; Bf[4 + s] = (bf16x8){0, 0, 0, 0, 0, 0, 0, 0}; }
    }
    bf16x8 Cf[4]; float dskip = 0.f;
    if (FINAL) {
#pragma unroll
        for (int ks = 0; ks < 4; ++ks) {
            const int k0 = 32 * ks + 8 * q; const float* src = (k0 < 64) ? (c_re + (size_t)(g * 16 + c16) * 64 + k0) : (c_im + (size_t)(g * 16 + c16) * 64 + (k0 - 64));
            const float sg = (k0 < 64) ? 1.f : -1.f;
            const f32x4 v0 = *(const f32x4*)src, v1 = *(const f32x4*)(src + 4);
            Cf[ks] = pack8(sg * v0.x, sg * v0.y, sg * v0.z, sg * v0.w, sg * v1.x, sg * v1.y, sg * v1.z, sg * v1.w);
        }
        dskip = dsk[g * 16 + c16];
    }
    float hr = 0.f, hi = 0.f;
    if (FINAL && chunk > 0) {
        float Lr = lr, Li = li;
#pragma unroll
        for (int s = 0; s < 8; ++s) { const float t = Lr * Lr - Li * Li; Li = 2.f * Lr * Li; Lr = t; }
        const float* e = E + ((size_t)((b * 64 + g) * NCHUNK) * 64 + lane) * 2;
        for (int cc = 0; cc < chunk; ++cc) {
            const float er = e[(size_t)cc * 128], ei = e[(size_t)cc * 128 + 1];
            const float t = Lr * hr - Li * hi + er; hi = Lr * hi + Li * hr + ei; hr = t;
        }
    }
    const int tbase = b * SEQ + chunk * CHUNK;
    for (int st = 0; st < CHUNK / 16; ++st) {
        const int t0 = tbase + st * 16;
        bf16x8 Af = (bf16x8){0, 0, 0, 0, 0, 0, 0, 0};
        if (q < 2) Af = *(const bf16x8*)(US + (size_t)(t0 + c16) * 1024 + g * 16 + 8 * q);
#pragma unroll
        for (int nt = 0; nt < 8; ++nt) {
            const f32x4 d = mfma16(Af, Bf[nt], (f32x4){0.f, 0.f, 0.f, 0.f});
#pragma unroll
            for (int i = 0; i < 4; ++i) Xs[(4 * q + i) * XS + 16 * nt + c16] = d[i];
        }
        LDS_WAIT(); asm volatile("" ::: "memory");
#pragma unroll
        for (int t = 0; t < 16; ++t) {
            const float xr = Xs[t * XS + lane], xi = Xs[t * XS + 64 + lane];
            const float tr = lr * hr - li * hi + xr; hi = lr * hi + li * hr + xi; hr = tr;
            if (FINAL) { Hs[t * HS + lane] = (bf16)(cvtpk(hr, 0.f) & 0xffffu); Hs[t * HS + 64 + lane] = (bf16)(cvtpk(hi, 0.f) & 0xffffu); }
        }
        LDS_WAIT(); asm volatile("" ::: "memory");
        if (FINAL) {
            f32x4 y = {0.f, 0.f, 0.f, 0.f};
#pragma unroll
            for (int ks = 0; ks < 4; ++ks) { const bf16x8 a = *(const LAS bf16x8*)(Hs + c16 * HS + 32 * ks + 8 * q); y = mfma16(a, Cf[ks], y); }
            bf16* YG = WSP(bf16, WS_H);
#pragma unroll
            for (int i = 0; i < 4; ++i) {
                const size_t idx = (size_t)(t0 + 4 * q + i) * 1024 + g * 16 + c16;
                const float uu = bf2f(US[idx]);
                YG[idx] = (bf16)(cvtpk(gelu_tanh(y[i] + dskip * uu), 0.f) & 0xffffu);
            }
            LDS_WAIT(); asm volatile("" ::: "memory");
        }
    }
    if (!FINAL) { float* e = E + ((size_t)((b * 64 + g) * NCHUNK + chunk) * 64 + lane) * 2; e[0] = hr; e[1] = hi; }
}

__device__ __forceinline__ void compress_item(const Ctx& C, int item) {
    const int lane = C.lane, w = C.wave, c16 = lane & 15, q = lane >> 4;
    const int nt = item & 15, g = (item >> 4) & 3, b = (item >> 6) & 3, kv = item >> 8;
    const bf16* SRC = kv ? WSP(bf16, WS_VCI) : WSP(bf16, WS_KCI);
    const bf16* W1 = kv ? WSP(bf16, WS_WV1) : WSP(bf16, WS_WK1);
    const bf16* W2 = kv ? WSP(bf16, WS_WV2) : WSP(bf16, WS_WK2);
    const float* bp = WSP(float, WS_BP) + kv * 128;
    LAS bf16* Hid = (LAS bf16*)C.lds;
    const int n = 16 * nt + c16;
    const bf16* arow = SRC + (size_t)(b * SEQ) * 256 + g * 64 + 8 * q;
    const bf16* brow = W1 + (size_t)(16 * w + c16) * 2048 + 8 * q;
    f32x4 acc = {0.f, 0.f, 0.f, 0.f};
#pragma unroll 8
    for (int ks = 0; ks < 64; ++ks) {
        int tok = 16 * n + (ks >> 1); tok = tok > SEQ - 1 ? SEQ - 1 : tok;
        const bf16x8 a = *(const bf16x8*)(arow + (size_t)tok * 256 + 32 * (ks & 1));
        const bf16x8 bb = *(const bf16x8*)(brow + 32 * ks);
        acc = mfma16(a, bb, acc);
    }
    { const float bias = bp[16 * w + c16];
#pragma unroll
      for (int i = 0; i < 4; ++i) Hid[(4 * q + i) * HS + 16 * w + c16] = (bf16)(cvtpk(gelu_tanh(acc[i] + bias), 0.f) & 0xffffu); }
    __syncthreads();
    if (w < 4) {
        f32x4 o = {0.f, 0.f, 0.f, 0.f};
#pragma unroll
        for (int ks = 0; ks < 4; ++ks) {
            const bf16x8 a = *(const LAS bf16x8*)(Hid + c16 * HS + 32 * ks + 8 * q);
            const bf16x8 bb = *(const bf16x8*)(W2 + (size_t)(16 * w + c16) * 128 + 32 * ks + 8 * q);
            o = mfma16(a, bb, o);
        }
        const int dim = 16 * w + c16, n0 = 16 * nt + 4 * q;
        float ov[4];
#pragma unroll
        for (int i = 0; i < 4; ++i) ov[i] = (n0 + i < 255) ? o[i] : 0.f;
        if (kv == 0) {
            bf16* kc = WSP(bf16, WS_KC) + (size_t)((b * 4 + g) * 256) * 64;
#pragma unroll
            for (int i = 0; i < 4; ++i) kc[(size_t)(n0 + i) * 64 + dim] = (bf16)(cvtpk(ov[i], 0.f) & 0xffffu);
        } else {
            bf16* vc = WSP(bf16, WS_VCT) + (size_t)((b * 4 + g) * 64 + dim) * 256 + n0;
            u32x2 wv; wv.x = cvtpk(ov[0], ov[1]); wv.y = cvtpk(ov[2], ov[3]); *(u32x2*)vc = wv;
        }
    }
    __syncthreads();
}

constexpr int A_KC = 0, A_VCT = 36864, A_KB = 70656, A_VB = 89088, A_IMP = 107520, A_LUT = 123904, A_SEL = 125952;
constexpr int KROW = 144, VCROW = 528, VROW = 144, KBUF = 64 * KROW, VBUF = 64 * VROW;
constexpr float NEG_BIG = -1e30f;

struct AttnState { float m[2], l[2]; f32x4 O[2][4]; };

template <bool LUTB>
__device__ __forceinline__ void attn_block(AttnState& S, const LAS unsigned char* kb, const LAS unsigned char* vb, const LAS float* lut, const bf16x8 (&Qf)[2][2],
                                           const int (&tq)[2], int kpos0, int dmax, bool on0, bool on1, bool act0, bool act1, float bfar, int c16, int q, int r) {
#pragma unroll
    for (int ct = 0; ct < 2; ++ct) {
        const bool act = ct ? act1 : act0; const bool on = ct ? on1 : on0;
        if (!act) continue;
        float p[4][4]; float mx = NEG_BIG;
#pragma unroll
        for (int kt = 0; kt < 4; ++kt) {
            const bf16x8 k0 = *(const LAS bf16x8*)(kb + (16 * kt + c16) * KROW + q * 16), k1 = *(const LAS bf16x8*)(kb + (16 * kt + c16) * KROW + 64 + q * 16);
            f32x4 s = mfma16(k0, Qf[ct][0], (f32x4){0.f, 0.f, 0.f, 0.f});
            s = mfma16(k1, Qf[ct][1], s);
#pragma unroll
            for (int i = 0; i < 4; ++i) {
                const int d = tq[ct] - (kpos0 + 16 * kt + 4 * q + i);
                const bool v = on && d >= 0 && d < dmax;
                float bias;
                if (LUTB) { const int dc = d < 0 ? 0 : (d > 127 ? 127 : d); bias = lut[r * 128 + dc]; } else bias = bfar;
                const float sv = v ? s[i] + bias : NEG_BIG;
                p[kt][i] = sv; mx = fmaxf(mx, sv);
            }
        }
        mx = fmaxf(mx, __shfl_xor(mx, 16)); mx = fmaxf(mx, __shfl_xor(mx, 32));
        const float mn = fmaxf(S.m[ct], mx), alpha = fexp(S.m[ct] - mn);
        S.m[ct] = mn;
        float ps = 0.f;
#pragma unroll
        for (int kt = 0; kt < 4; ++kt)
#pragma unroll
            for (int i = 0; i < 4; ++i) { const float e = p[kt][i] > -1e29f ? fexp(p[kt][i] - mn) : 0.f; p[kt][i] = e; ps += e; }
        S.l[ct] = S.l[ct] * alpha + ps;
#pragma unroll
        for (int mt = 0; mt < 4; ++mt) S.O[ct][mt] = S.O[ct][mt] * alpha;
        __builtin_amdgcn_sched_barrier(0);
#pragma unroll
        for (int u = 0; u < 2; ++u) {
            const bf16x8 Pf = pack8(p[2 * u][0], p[2 * u][1], p[2 * u][2], p[2 * u][3], p[2 * u + 1][0], p[2 * u + 1][1], p[2 * u + 1][2], p[2 * u + 1][3]);
#pragma unroll
            for (int mt = 0; mt < 4; ++mt) {
                const LAS unsigned char* vp = vb + (16 * mt + c16) * VROW + (32 * u + 4 * q) * 2;
                const u32x2 lo = *(const LAS u32x2*)vp, hi = *(const LAS u32x2*)(vp + 32);
                v4u av; av.x = lo.x; av.y = lo.y; av.z = hi.x; av.w = hi.y;
                S.O[ct][mt] = mfma16(__builtin_bit_cast(bf16x8, av), Pf, S.O[ct][mt]);
            }
        }
        __builtin_amdgcn_sched_barrier(0);
    }
}

__device__ __forceinline__ void attn_fold(AttnState& S, f32x4 (&Ot)[2][4], const float (&gate)[2]) {
#pragma unroll
    for (int ct = 0; ct < 2; ++ct) {
        float L = S.l[ct]; L += __shfl_xor(L, 16); L += __shfl_xor(L, 32);
        const float inv = L > 0.f ? gate[ct] / L : 0.f;
#pragma unroll
        for (int mt = 0; mt < 4; ++mt) { Ot[ct][mt] += S.O[ct][mt] * inv; S.O[ct][mt] = (f32x4){0.f, 0.f, 0.f, 0.f}; }
        S.m[ct] = NEG_BIG; S.l[ct] = 0.f;
    }
}

__device__ __forceinline__ void attn_item(const Ctx& C, int b, int g, int cur) {
    LAS unsigned char* lds = C.lds;
    const int tid = C.tid, lane = C.lane, w = C.wave, c16 = lane & 15, q = lane >> 4, r = c16 & 3;
    const int t0 = cur * 64;
    const bf16* Qg = WSP(bf16, WS_Q); const bf16* NGB = WSP(bf16, WS_NGB); const bf16* ZA = WSP(bf16, WS_ZA);
    LAS float* lut = (LAS float*)(lds + A_LUT); LAS float* imp = (LAS float*)(lds + A_IMP);
    LAS unsigned long long* selm = (LAS unsigned long long*)(lds + A_SEL);
    {
        const bf16* kcg = WSP(bf16, WS_KC) + (size_t)((b * 4 + g) * 256) * 64;
        const bf16* vcg = WSP(bf16, WS_VCT) + (size_t)((b * 4 + g) * 64) * 256;
#pragma unroll
        for (int i = 0; i < 4; ++i) {
            const int id = tid + 512 * i;
            { const int row = id >> 3, cc = id & 7; *(LAS v4u*)(lds + A_KC + row * KROW + cc * 16) = *(const v4u*)(kcg + row * 64 + cc * 8); }
            { const int dim = id >> 5, kc = id & 31; *(LAS v4u*)(lds + A_VCT + dim * VCROW + kc * 16) = *(const v4u*)(vcg + dim * 256 + kc * 8); }
        }
        lut[tid] = WSP(float, WS_LUT)[(g * 4 + (tid >> 7)) * 128 + (tid & 127)];
    }
    bf16x8 Qf[2][2]; int tq[2]; float gt[2][3];
#pragma unroll
    for (int ct = 0; ct < 2; ++ct) {
        tq[ct] = t0 + 8 * w + 4 * ct + (c16 >> 2);
        const size_t row = (size_t)(b * SEQ + tq[ct]);
#pragma unroll
        for (int ks = 0; ks < 2; ++ks) Qf[ct][ks] = *(const bf16x8*)(Qg + row * 1024 + (g * 4 + r) * 64 + 32 * ks + 8 * q);
#pragma unroll
        for (int br = 0; br < 3; ++br) gt[ct][br] = bf2f(NGB[row * 64 + (g * 4 + r) * 3 + br]);
    }
    const float bfar = WSP(float, WS_LUT)[(g * 4 + r) * 128 + 127];
    f32x4 Ot[2][4];
#pragma unroll
    for (int ct = 0; ct < 2; ++ct)
#pragma unroll
        for (int mt = 0; mt < 4; ++mt) Ot[ct][mt] = (f32x4){0.f, 0.f, 0.f, 0.f};
    __syncthreads();
    const int nch = (4 * cur + 3 + 31) >> 5;
    {
        float mA[2] = {NEG_BIG, NEG_BIG}, lA[2] = {0.f, 0.f};
        for (int kt = 0; kt < 2 * nch; ++kt) {
            const bf16x8 k0 = *(const LAS bf16x8*)(lds + A_KC + (16 * kt + c16) * KROW + q * 16), k1 = *(const LAS bf16x8*)(lds + A_KC + (16 * kt + c16) * KROW + 64 + q * 16);
#pragma unroll
            for (int ct = 0; ct < 2; ++ct) {
                f32x4 s = mfma16(k0, Qf[ct][0], (f32x4){0.f, 0.f, 0.f, 0.f}); s = mfma16(k1, Qf[ct][1], s);
                float sv[4]; float mx = NEG_BIG;
#pragma unroll
                for (int i = 0; i < 4; ++i) { const int d = tq[ct] - 31 - 16 * (16 * kt + 4 * q + i); const int dc = d < 0 ? 0 : (d > 127 ? 127 : d);
                    sv[i] = d >= 0 ? s[i] + lut[r * 128 + dc] : NEG_BIG; mx = fmaxf(mx, sv[i]); }
                const float mn = fmaxf(mA[ct], mx); float ps = 0.f;
#pragma unroll
                for (int i = 0; i < 4; ++i) ps += sv[i] > -1e29f ? fexp(sv[i] - mn) : 0.f;
                lA[ct] = lA[ct] * fexp(mA[ct] - mn) + ps; mA[ct] = mn;
            }
        }
        float Mx[2], invL[2];
#pragma unroll
        for (int ct = 0; ct < 2; ++ct) {
            float mm = mA[ct]; mm = fmaxf(mm, __shfl_xor(mm, 16)); mm = fmaxf(mm, __shfl_xor(mm, 32));
            float ll = lA[ct] * fexp(mA[ct] - mm); ll += __shfl_xor(ll, 16); ll += __shfl_xor(ll, 32);
            Mx[ct] = mm; invL[ct] = ll > 0.f ? 1.f / ll : 0.f;
        }
        f32x4 Oc[2][4];
#pragma unroll
        for (int ct = 0; ct < 2; ++ct)
#pragma unroll
            for (int mt = 0; mt < 4; ++mt) Oc[ct][mt] = (f32x4){0.f, 0.f, 0.f, 0.f};
        float carry[2] = {0.f, 0.f};
        for (int u = 0; u < nch; ++u) {
            float p[2][2][4];
#pragma unroll
            for (int hf = 0; hf < 2; ++hf) {
                const int kt = 2 * u + hf;
                const bf16x8 k0 = *(const LAS bf16x8*)(lds + A_KC + (16 * kt + c16) * KROW + q * 16), k1 = *(const LAS bf16x8*)(lds + A_KC + (16 * kt + c16) * KROW + 64 + q * 16);
#pragma unroll
                for (int ct = 0; ct < 2; ++ct) {
                    f32x4 s = mfma16(k0, Qf[ct][0], (f32x4){0.f, 0.f, 0.f, 0.f}); s = mfma16(k1, Qf[ct][1], s);
                    float own = 0.f;
#pragma unroll
                    for (int i = 0; i < 4; ++i) { const int d = tq[ct] - 31 - 16 * (16 * kt + 4 * q + i); const int dc = d < 0 ? 0 : (d > 127 ? 127 : d);
                        const float e = d >= 0 ? fexp(s[i] + lut[r * 128 + dc] - Mx[ct]) * invL[ct] : 0.f; p[ct][hf][i] = e; own += e; }
                    const float rot = __shfl(p[ct][hf][3], (lane + 48) & 63);
                    const float prev3 = (q == 0) ? carry[ct] : rot; carry[ct] = rot;
                    float v = own + prev3; v += __shfl_xor(v, 1); v += __shfl_xor(v, 2);
                    if (r == 0) imp[(8 * w + 4 * ct + (c16 >> 2)) * 64 + 4 * kt + q] = v;
                }
            }
            bf16x8 Pf[2];
#pragma unroll
            for (int ct = 0; ct < 2; ++ct) Pf[ct] = pack8(p[ct][0][0], p[ct][0][1], p[ct][0][2], p[ct][0][3], p[ct][1][0], p[ct][1][1], p[ct][1][2], p[ct][1][3]);
#pragma unroll
            for (int mt = 0; mt < 4; ++mt) {
                const LAS unsigned char* vp = lds + A_VCT + (16 * mt + c16) * VCROW + (32 * u + 4 * q) * 2;
                const u32x2 lo = *(const LAS u32x2*)vp, hi = *(const LAS u32x2*)(vp + 32);
                v4u av; av.x = lo.x; av.y = lo.y; av.z = hi.x; av.w = hi.y;
                const bf16x8 a = __builtin_bit_cast(bf16x8, av);
#pragma unroll
                for (int ct = 0; ct < 2; ++ct) Oc[ct][mt] = mfma16(a, Pf[ct], Oc[ct][mt]);
            }
        }
#pragma unroll
        for (int ct = 0; ct < 2; ++ct)
#pragma unroll
            for (int mt = 0; mt < 4; ++mt) Ot[ct][mt] = Oc[ct][mt] * gt[ct][0];
    }
    LDS_WAIT(); asm volatile("" ::: "memory");
    {
        const int ts = lane >> 3, sub = lane & 7;
        unsigned long long mask;
        if (cur <= 7) mask = (2ull << cur) - 1ull;
        else {
            float v[8];
#pragma unroll
            for (int i = 0; i < 8; ++i) { const int j = sub * 8 + i; v[i] = (j >= 1 && j <= cur - 2) ? imp[(8 * w + ts) * 64 + j] : -3e38f; }
            mask = 1ull | (1ull << cur) | (1ull << (cur - 1));
#pragma unroll 1
            for (int rd = 0; rd < 5; ++rd) {
                float best = v[0]; int bi = 0;
#pragma unroll
                for (int i = 1; i < 8; ++i) if (v[i] > best) { best = v[i]; bi = i; }
                int bj = sub * 8 + bi;
#pragma unroll
                for (int off = 1; off < 8; off <<= 1) { const float ov = __shfl_xor(best, off); const int oj = __shfl_xor(bj, off); if (ov > best || (ov == best && oj < bj)) { best = ov; bj = oj; } }
                mask |= 1ull << bj;
#pragma unroll
                for (int i = 0; i < 8; ++i) if (bj == sub * 8 + i) v[i] = -3e38f;
            }
        }
        if (sub == 0) selm[8 * w + ts] = mask;
    }
    LDS_WAIT(); asm volatile("" ::: "memory");
    unsigned mlo[2], mhi[2], ulo[2], uhi[2];
#pragma unroll
    for (int ct = 0; ct < 2; ++ct) {
        const unsigned long long mk = selm[8 * w + 4 * ct + (c16 >> 2)];
        mlo[ct] = (unsigned)mk; mhi[ct] = (unsigned)(mk >> 32);
        ulo[ct] = __builtin_amdgcn_readlane(mlo[ct], 0) | __builtin_amdgcn_readlane(mlo[ct], 4) | __builtin_amdgcn_readlane(mlo[ct], 8) | __builtin_amdgcn_readlane(mlo[ct], 12);
        uhi[ct] = __builtin_amdgcn_readlane(mhi[ct], 0) | __builtin_amdgcn_readlane(mhi[ct], 4) | __builtin_amdgcn_readlane(mhi[ct], 8) | __builtin_amdgcn_readlane(mhi[ct], 12);
    }
    AttnState S;
#pragma unroll
    for (int ct = 0; ct < 2; ++ct) { S.m[ct] = NEG_BIG; S.l[ct] = 0.f;
#pragma unroll
        for (int mt = 0; mt < 4; ++mt) S.O[ct][mt] = (f32x4){0.f, 0.f, 0.f, 0.f}; }
    const int srow = tid >> 3, scc = tid & 7;
#pragma unroll 1
    for (int br = 0; br < 2; ++br) {
        const bf16* Kg = br ? WSP(bf16, WS_KW) : WSP(bf16, WS_KS);
        const bf16* Vg = br ? WSP(bf16, WS_VWT) : WSP(bf16, WS_VST);
        const int jlo = br ? (cur >= 8 ? cur - 8 : 0) : 0, nb = cur - jlo + 1;
        const bf16* ksrc = Kg + (size_t)(b * SEQ + srow) * 256 + g * 64 + scc * 8;
        const bf16* vsrc = Vg + ((size_t)((b * 4 + g) * 64 + srow) << 12) + scc * 8;
        const int kdst = A_KB + srow * KROW + scc * 16, vdst = A_VB + srow * VROW + scc * 16;
        __syncthreads();
        { const v4u kr = *(const v4u*)(ksrc + (size_t)(64 * jlo) * 256), vr = *(const v4u*)(vsrc + 64 * jlo);
          *(LAS v4u*)(lds + kdst) = kr; *(LAS v4u*)(lds + vdst) = vr; }
        __syncthreads();
#pragma unroll 1
        for (int ib = 0; ib < nb; ++ib) {
            const int j = jlo + ib, bufo = (ib & 1);
            v4u kr = {0, 0, 0, 0}, vr = {0, 0, 0, 0};
            if (ib + 1 < nb) { kr = *(const v4u*)(ksrc + (size_t)(64 * (j + 1)) * 256); vr = *(const v4u*)(vsrc + 64 * (j + 1)); }
            bool on0 = true, on1 = true, act0 = true, act1 = true;
            if (br == 0) {
                on0 = ((j < 32 ? (mlo[0] >> j) : (mhi[0] >> (j - 32))) & 1u) != 0u; on1 = ((j < 32 ? (mlo[1] >> j) : (mhi[1] >> (j - 32))) & 1u) != 0u;
                act0 = ((j < 32 ? (ulo[0] >> j) : (uhi[0] >> (j - 32))) & 1u) != 0u; act1 = ((j < 32 ? (ulo[1] >> j) : (uhi[1] >> (j - 32))) & 1u) != 0u;
            }
            const LAS unsigned char* kb = lds + A_KB + bufo * KBUF; const LAS unsigned char* vb = lds + A_VB + bufo * VBUF;
            const int dmax = br ? 512 : 0x7fffffff;
            if (cur - j <= 2) attn_block<true>(S, kb, vb, lut, Qf, tq, 64 * j, dmax, on0, on1, act0, act1, bfar, c16, q, r);
            else attn_block<false>(S, kb, vb, lut, Qf, tq, 64 * j, dmax, on0, on1, act0, act1, bfar, c16, q, r);
            if (ib + 1 < nb) { *(LAS v4u*)(lds + kdst + (bufo ^ 1) * KBUF) = kr; *(LAS v4u*)(lds + vdst + (bufo ^ 1) * VBUF) = vr; }
            __syncthreads();
        }
        const float gsel[2] = {gt[0][1 + br], gt[1][1 + br]};
        attn_fold(S, Ot, gsel);
    }
    bf16* OA = WSP(bf16, WS_Q);
#pragma unroll
    for (int ct = 0; ct < 2; ++ct) {
        const size_t base = (size_t)(b * SEQ + tq[ct]) * 1024 + (g * 4 + r) * 64 + 4 * q;
#pragma unroll
        for (int mt = 0; mt < 4; ++mt) {
            const u32x2 z = *(const u32x2*)(ZA + base + 16 * mt);
            u32x2 o; o.x = cvtpk(Ot[ct][mt].x * bflo(z.x), Ot[ct][mt].y * bfhi(z.x)); o.y = cvtpk(Ot[ct][mt].z * bflo(z.y), Ot[ct][mt].w * bfhi(z.y));
            *(u32x2*)(OA + base + 16 * mt) = o;
        }
    }
    __syncthreads();
}

#ifndef PHMASK
#define PHMASK 0x1ff
#endif
struct Args { const float* in[27]; float* out; unsigned char* ws; int pad0, pad1; };

__global__ void __launch_bounds__(NTHR, 2) mega_fwd(Args args) {
    extern __shared__ __attribute__((aligned(16))) unsigned char lds_raw[];
    Ctx C;
    C.out = args.out; C.ws = args.ws; C.lds = (LAS unsigned char*)lds_raw;
    C.tid = threadIdx.x; C.lane = C.tid & 63; C.wave = __builtin_amdgcn_readfirstlane(C.tid >> 6); C.G = gridDim.x; C.bid = blockIdx.x;
    volatile LAS unsigned* MISC = (volatile LAS unsigned*)(C.lds + MISC_OFF);
    for (int u = C.tid; u < (LDS_BYTES - RING_BYTES) / 4; u += NTHR) ((LAS unsigned*)(C.lds + RING_BYTES))[u] = 0u;
    __syncthreads();
    if (C.tid < 27) { const unsigned long long pv = (unsigned long long)args.in[C.tid]; LAS unsigned* tab = (LAS unsigned*)(C.lds + PTR_OFF); tab[2 * C.tid] = (unsigned)pv; tab[2 * C.tid + 1] = (unsigned)(pv >> 32); }
    __syncthreads();
    XcdBarrier bar = xcd_barrier_post((unsigned*)(C.ws + WS_CTL) + CW_BAR, MISC + 8);
#define GRID_BAR() xcd_barrier(bar)
    LAS unsigned char* ring = C.lds;

    if (PHMASK & (1 << 0))
    phase0(C);
    GRID_BAR();
    if (PHMASK & (1 << 1))
    phase1(C);
    GRID_BAR();
    if (PHMASK & (1 << 2))
    {
        pg8::Gemm g{WSP(const bf16, WS_H), WSP(const bf16, WS_WIN), MTOK, INWP, DM}; pg8::StaticOrder S; S.init(MTOK, INWP, C.G, C.bid);
        EpiIn E{C.ws};
        pg8::gemm_phase<EpiIn, pg8::StaticOrder, true, true>(ring, g, S, E);
    }
    GRID_BAR();
    if (PHMASK & (1 << 3))
    {
        for (int it = C.bid; it < 512; it += C.G) compress_item(C, it);
        LAS unsigned char* wl = C.lds + C.wave * SSM_WAVE_LDS;
        for (int it = C.bid; it < 512; it += C.G) ssm_item<false>(C, it * 8 + C.wave, wl);
    }
    GRID_BAR();
    if (PHMASK & (1 << 4))
    {
        LAS unsigned char* wl = C.lds + C.wave * SSM_WAVE_LDS;
#ifndef NO_SSMF
        for (int it = C.bid; it < 512; it += C.G) ssm_item<true>(C, it * 8 + C.wave, wl);
#endif
        __syncthreads();
#ifndef NO_ATTN
        for (int k = C.bid; k < 1024; k += C.G) {
            const int rd = k >> 8, kk = k & 255, bg = kk & 15, jj = kk >> 4;
            const int cur = (rd == 0) ? 63 - jj : (rd == 1) ? 32 + jj : (rd == 2) ? 31 - jj : jj;
            attn_item(C, bg >> 2, bg & 3, cur);
        }
#endif
    }
    GRID_BAR();
    if (PHMASK & (1 << 5))
    {
        pg8::Gemm g{WSP(const bf16, WS_H), WSP(const bf16, WS_WGLU), MTOK, 1024, 1024}; pg8::StaticOrder S; S.init(MTOK, 1024, C.G, C.bid);
        EpiMix<0> E{WSP(const bf16, WS_H), WSP(const bf16, WS_ZB), WSP(bf16, WS_US), inp(C, 21), nullptr, nullptr, 1024};
        pg8::gemm_phase<EpiMix<0>, pg8::StaticOrder, false, true>(ring, g, S, E);
    }
    GRID_BAR();
    if (PHMASK & (1 << 6))
    {
        { pg8::Gemm g{WSP(const bf16, WS_Q), WSP(const bf16, WS_WBN), MTOK, 2048, 1024}; pg8::StaticOrder S; S.init(MTOK, 2048, C.G, C.bid);
          EpiMix<1> E{WSP(const bf16, WS_GA), nullptr, WSP(bf16, WS_H), nullptr, nullptr, nullptr, 2048};
          pg8::gemm_phase<EpiMix<1>, pg8::StaticOrder, true, true>(ring, g, S, E); }
        { pg8::Gemm g{WSP(const bf16, WS_US), WSP(const bf16, WS_WBS), MTOK, 2048, 1024}; pg8::StaticOrder S; S.init(MTOK, 2048, C.G, C.bid);
          EpiMix<2> E{WSP(const bf16, WS_GB), WSP(const bf16, WS_H), WSP(bf16, WS_H), nullptr, nullptr, nullptr, 2048};
          pg8::gemm_phase<EpiMix<2>, pg8::StaticOrder, true, true>(ring, g, S, E); }
    }
    GRID_BAR();
    if (PHMASK & (1 << 7))
    {
        pg8::Gemm g{WSP(const bf16, WS_H), WSP(const bf16, WS_WOUT), MTOK, 2048, 2048}; pg8::StaticOrder S; S.init(MTOK, 2048, C.G, C.bid);
        EpiMix<3> E{nullptr, nullptr, nullptr, inp(C, 0), WSP(const float, WS_MOD), C.out, 2048};
        pg8::gemm_phase<EpiMix<3>, pg8::StaticOrder, true, true>(ring, g, S, E);
    }
    GRID_BAR();
    if (PHMASK & (1 << 8))
    phase_ln_out(C);
}

extern "C" void kernel_launch(void* const* d_in, const int* in_sizes, int n_in, void* d_out, int out_size, void* d_ws, size_t ws_size, hipStream_t stream) {
    static int grid = 0;
    if (grid == 0) {
        if (n_in != 27 || out_size != MTOK * DM || ws_size < WS_END) { fprintf(stderr, "kernel_launch: unexpected problem (n_in %d, out %d, ws %zu)\n", n_in, out_size, ws_size); grid = -1; return; }
        int dev = 0, cus = 0, per_cu = 0;
        if (hipGetDevice(&dev) != hipSuccess || hipDeviceGetAttribute(&cus, hipDeviceAttributeMultiprocessorCount, dev) != hipSuccess) { grid = -1; return; }
        if (hipFuncSetAttribute((const void*)mega_fwd, hipFuncAttributeMaxDynamicSharedMemorySize, LDS_BYTES) != hipSuccess) { fprintf(stderr, "kernel_launch: hipFuncSetAttribute failed\n"); grid = -1; return; }
        if (hipOccupancyMaxActiveBlocksPerMultiprocessor(&per_cu, (const void*)mega_fwd, NTHR, LDS_BYTES) != hipSuccess || per_cu < 1) { fprintf(stderr, "kernel_launch: occupancy query says %d\n", per_cu); }
        (void)hipGetLastError();
        grid = cus;
    }
    if (grid < 0) return;
    if (hipMemsetAsync((char*)d_ws + WS_CTL, 0, CTL_ZERO_BYTES, stream) != hipSuccess) return;
    Args a{};
    for (int i = 0; i < 27; ++i) a.in[i] = (const float*)d_in[i];
    a.out = (float*)d_out; a.ws = (unsigned char*)d_ws;
    hipLaunchKernelGGL(mega_fwd, dim3(grid), dim3(NTHR), LDS_BYTES, stream, a);
}
```

```cpp
#include <hip/hip_runtime.h>
#include <cstdio>
#include <cstdint>
namespace pg8 {
#define PG8_LAS __attribute__((address_space(3)))
typedef unsigned short bf16_t;
typedef short bf16x8 __attribute__((ext_vector_type(8)));
typedef float f32x4 __attribute__((ext_vector_type(4)));
typedef unsigned u32x4 __attribute__((ext_vector_type(4)));
constexpr int BM = 256, BK = 64, HALF = 128, HTB = HALF * BK * 2  , STAGE_BYTES = 8 * HTB, NXCD = 8, WGM = 8;

__host__ __device__ __forceinline__ int lds_byte(int r, int c) { const int st = (r >> 4) * 2 + (c >> 5), rr = r & 15, cc = c & 31, ob = rr * 64 + cc * 2; return st * 1024 + (ob ^ (((ob >> 9) & 1) << 5)); }
__host__ __device__ __forceinline__ void stage_rc(int b, int& R, int& C) { const int st = b / 1024, sb = b % 1024, swz = sb ^ (((sb >> 9) & 1) << 5); R = (st >> 1) * 16 + swz / 64; C = (st & 1) * 32 + (swz % 64) / 2; }
__host__ __device__ __forceinline__ int perm32(int rho) { const int n = rho >> 4, i = rho & 15; return 8 * (i >> 2) + 4 * n + (i & 3); }

struct Unit { int pm, pn, kh; };
struct Gemm { const bf16_t* A; const bf16_t* Bt; int M, N, K, ld; };

struct StaticOrder {
    int nM, nN, nwg, G, c;
    __host__ __device__ void init(int M, int N, int G_, int c_) { nM = M / BM; nN = N / BM; nwg = nM * nN; G = G_; c = c_; }
    __host__ __device__ bool next(int i, Unit& u) const {
        const long L = (long)i * G + c; if (L >= nwg) return false;
        int wgid = (int)L; { const int q = nwg / NXCD, r = nwg % NXCD, xcd = wgid % NXCD, off = wgid / NXCD; wgid = (xcd < r ? xcd * (q + 1) : r * (q + 1) + (xcd - r) * q) + off; }
        const int nig = WGM * nN, gid = wgid / nig, fm = gid * WGM, gsz = (nM - fm) < WGM ? (nM - fm) : WGM;
        u.pm = fm + ((wgid % nig) % gsz); u.pn = (wgid % nig) / gsz; u.kh = 0; return true;
    }
    __device__ __forceinline__ void a_ready(const Unit&) const {}
    __device__ __forceinline__ void done(const Unit&) const {}
};
struct SplitKOrder {
    StaticOrder base;
    __host__ __device__ void init(int M, int N, int G_, int c_) { base.init(M, N, G_, c_); }
    __host__ __device__ bool next(int i, Unit& u) const { if (!base.next(i >> 1, u)) return false; u.kh = i & 1; return true; }
    __device__ __forceinline__ void a_ready(const Unit&) const {}
    __device__ __forceinline__ void done(const Unit&) const {}
};

__device__ __forceinline__ unsigned cvt_pk_bf16(float lo, float hi) { unsigned r; asm volatile("v_cvt_pk_bf16_f32 %0, %1, %2" : "=v"(r) : "v"(lo), "v"(hi)); return r; }
typedef float f32x2 __attribute__((ext_vector_type(2)));
__device__ __forceinline__ f32x2 gelu_pk(f32x2 v) {
    const f32x2 av = __builtin_elementwise_abs(v), d = av * 0.2316418882f + 1.0f;
    f32x2 t; t.x = __builtin_amdgcn_rcpf(d.x); t.y = __builtin_amdgcn_rcpf(d.y);
    f32x2 q = t * 0.5307027145f + (-0.7265760135f); q = q * t + 0.7107068705f; q = q * t + (-0.142248368f); q = q * t + 0.127414796f; q = q * t;
    const f32x2 s = (v * v) * (-0.72134752044f);
    f32x2 e; e.x = __builtin_amdgcn_exp2f(s.x); e.y = __builtin_amdgcn_exp2f(s.y);
    const f32x2 m = v * (q * e), r = v - m;
    f32x2 o; o.x = v.x < 0.f ? m.x : r.x; o.y = v.y < 0.f ? m.y : r.y; return o;
}

typedef int i32x4_t __attribute__((ext_vector_type(4)));
typedef int i32x8_t __attribute__((ext_vector_type(8)));
__device__ __forceinline__ i32x8_t cat8(bf16x8 lo, bf16x8 hi) { const i32x4_t a = __builtin_bit_cast(i32x4_t, lo), b = __builtin_bit_cast(i32x4_t, hi); return __builtin_shufflevector(a, b, 0, 1, 2, 3, 4, 5, 6, 7); }
template <class Epi, class Sched, bool ALIGN_EPI = false, bool SP2 = false, bool FP8 = false>
__device__ __forceinline__ void gemm_phase(PG8_LAS unsigned char* lds, const Gemm g, const Sched& S, const Epi& E, int tid_in) {
    int tid_ = tid_in; asm volatile("" : "+v"(tid_));
    const int tid = tid_, wid = __builtin_amdgcn_readfirstlane(tid >> 6), lane = tid & 63, wr = wid >> 2, wc = wid & 3, fr = lane & 15, fq = lane >> 4;
    int pg8_scale1 = 0x7F7F7F7F; asm volatile("" : "+v"(pg8_scale1));
    const int K = g.K, nt = K / BK, LD = g.ld ? g.ld : g.K;
    unsigned voffA[2], voffB[2];
#pragma unroll
    for (int i = 0; i < 2; ++i) { int R, C; stage_rc(tid * 16 + i * 8192, R, C); const int Rb = Epi::PERM ? ((R & ~31) + perm32(R & 31)) : R;
        voffA[i] = (unsigned)(R * LD + C) * 2u; voffB[i] = (unsigned)(Rb * LD + C) * 2u; }
    const size_t kstep = (size_t)(BK * 2);
    const size_t hstep = (size_t)HALF * LD * 2;
    const size_t tstep = 2 * hstep;
    const unsigned ldsw = (unsigned)wid * 1024u;
    const int aoff = lds_byte(wr * 64 + fr, fq * 8), boff = lds_byte(wc * 32 + fr, fq * 8);
#define PG8_SA(b, h) (((b) * 2 + (h)) * HTB)
#define PG8_SB(b, h) ((4 + (b) * 2 + (h)) * HTB)
#define PG8_STAGE(bufoff, gbase, voff) do { _Pragma("unroll") for (int _i = 0; _i < 2; ++_i) \
        __builtin_amdgcn_global_load_lds((const unsigned*)((const char*)(gbase) + (voff)[_i]), (PG8_LAS unsigned*)(lds + (bufoff) + ldsw + _i * 8192), 16, 0, 0); } while (0)
#define PG8_LDA(dst, b, h) do { _Pragma("unroll") for (int m = 0; m < 4; ++m) { dst[m].lo = *(const PG8_LAS i32x4_t*)(lds + PG8_SA(b, h) + aoff + m * 2048); dst[m].hi = *(const PG8_LAS i32x4_t*)(lds + PG8_SA(b, h) + aoff + m * 2048 + 1024); } } while (0)
#define PG8_LDB(dst, b, h) do { _Pragma("unroll") for (int n = 0; n < 2; ++n) { dst[n].lo = *(const PG8_LAS i32x4_t*)(lds + PG8_SB(b, h) + boff + n * 2048); dst[n].hi = *(const PG8_LAS i32x4_t*)(lds + PG8_SB(b, h) + boff + n * 2048 + 1024); } } while (0)
#define PG8_MMA(ai, bj, At, Bt) do { __builtin_amdgcn_s_setprio(1); if constexpr (FP8) { _Pragma("unroll") for (int m = 0; m < 4; ++m) _Pragma("unroll") for (int n = 0; n < 2; ++n) \
        asm volatile("v_mfma_scale_f32_16x16x128_f8f6f4 %0, %1, %2, %0, %3, %3 op_sel_hi:[0,0,0]" : "+v"(acc[ai][bj][m][n]) : "v"(Bt[n]), "v"(At[m]), "v"(pg8_scale1)); } else { \
        _Pragma("unroll") for (int m = 0; m < 4; ++m) _Pragma("unroll") for (int n = 0; n < 2; ++n) { \
        acc[ai][bj][m][n] = __builtin_amdgcn_mfma_f32_16x16x32_bf16(__builtin_bit_cast(bf16x8, (i32x4_t)Bt[n].lo), __builtin_bit_cast(bf16x8, (i32x4_t)At[m].lo), acc[ai][bj][m][n], 0, 0, 0); \
        acc[ai][bj][m][n] = __builtin_amdgcn_mfma_f32_16x16x32_bf16(__builtin_bit_cast(bf16x8, (i32x4_t)Bt[n].hi), __builtin_bit_cast(bf16x8, (i32x4_t)At[m].hi), acc[ai][bj][m][n], 0, 0, 0); } } __builtin_amdgcn_s_setprio(0); } while (0)
#define PG8_WAIT_V(n) asm volatile("s_waitcnt vmcnt(" #n ")" ::: "memory")
#define PG8_WAIT_L(n) asm volatile("s_waitcnt lgkmcnt(" #n ")" ::: "memory")
#define PG8_BAR __builtin_amdgcn_s_barrier()
#define PG8_SCHED __builtin_amdgcn_sched_barrier(0)
    Unit cur, nxt; int ui = 0;
    if (!S.next(0, cur)) return;
    f32x4 acc[2][2][4][2];
#pragma unroll
    for (int a = 0; a < 2; ++a)
#pragma unroll
        for (int b = 0; b < 2; ++b)
#pragma unroll
            for (int m = 0; m < 4; ++m)
#pragma unroll
                for (int n = 0; n < 2; ++n) acc[a][b][m][n] = (f32x4){0.f, 0.f, 0.f, 0.f};
    i32x8_t At[4], B0[2], B1[2];
    const size_t khstep = (size_t)K * 2;
    const char* cA = (const char*)g.A + (size_t)cur.pm * tstep + (size_t)cur.kh * khstep; const char* cB = (const char*)g.Bt + (size_t)cur.pn * tstep + (size_t)cur.kh * khstep;
    S.a_ready(cur);
    if constexpr (SP2) {
        PG8_STAGE(PG8_SB(0, 0), cB, voffB); PG8_STAGE(PG8_SB(0, 1), cB + hstep, voffB); PG8_STAGE(PG8_SA(0, 0), cA, voffA); PG8_STAGE(PG8_SA(0, 1), cA + hstep, voffA);
        if (wr == 1) PG8_BAR;
        PG8_WAIT_V(2); PG8_BAR;
        PG8_STAGE(PG8_SB(1, 0), cB + kstep, voffB); PG8_STAGE(PG8_SA(1, 0), cA + kstep, voffA); PG8_STAGE(PG8_SB(1, 1), cB + hstep + kstep, voffB);
        PG8_WAIT_V(6); PG8_BAR;
    } else {
        PG8_STAGE(PG8_SB(0, 0), cB, voffB); PG8_STAGE(PG8_SA(0, 0), cA, voffA); PG8_STAGE(PG8_SB(0, 1), cB + hstep, voffB); PG8_STAGE(PG8_SA(0, 1), cA + hstep, voffA);
        if (wr == 1) PG8_BAR;
        PG8_WAIT_V(4); PG8_BAR;
        PG8_STAGE(PG8_SB(1, 0), cB + kstep, voffB); PG8_STAGE(PG8_SA(1, 0), cA + kstep, voffA); PG8_STAGE(PG8_SB(1, 1), cB + hstep + kstep, voffB);
        PG8_WAIT_V(6); PG8_BAR;
    }
    for (;;) {
        const bool has_next = S.next(ui + 1, nxt);
        const char* nA = has_next ? (const char*)g.A + (size_t)nxt.pm * tstep + (size_t)nxt.kh * khstep : cA; const char* nB = has_next ? (const char*)g.Bt + (size_t)nxt.pn * tstep + (size_t)nxt.kh * khstep : cB;
        for (int t = 0; t < nt; t += 2) {
            const bool last = (t == nt - 2);
            const char* a1 = cA + (size_t)(t + 1) * kstep;
            const char* a2 = last ? nA : cA + (size_t)(t + 2) * kstep; const char* b2 = last ? nB : cB + (size_t)(t + 2) * kstep;
            const char* a3 = a2 + kstep; const char* b3 = b2 + kstep;
            if (last && has_next) S.a_ready(nxt);
            if constexpr (SP2) {
            PG8_LDB(B0, 0, 0); PG8_LDB(B1, 0, 1); PG8_SCHED; PG8_LDA(At, 0, 0); PG8_STAGE(PG8_SA(1, 1), a1 + hstep, voffA);
            PG8_WAIT_V(8); PG8_WAIT_L(0); PG8_BAR; PG8_MMA(0, 0, At, B0); PG8_MMA(0, 1, At, B1); PG8_BAR; PG8_SCHED;
            PG8_LDA(At, 0, 1); PG8_STAGE(PG8_SB(0, 0), b2, voffB); PG8_STAGE(PG8_SB(0, 1), b2 + hstep, voffB); PG8_STAGE(PG8_SA(0, 0), a2, voffA);
            PG8_WAIT_V(8); PG8_WAIT_L(0); PG8_BAR; PG8_MMA(1, 0, At, B0); PG8_MMA(1, 1, At, B1); PG8_BAR; PG8_SCHED;
            PG8_LDB(B0, 1, 0); PG8_LDB(B1, 1, 1); PG8_SCHED; PG8_LDA(At, 1, 0); PG8_STAGE(PG8_SA(0, 1), a2 + hstep, voffA);
            PG8_WAIT_V(8); PG8_WAIT_L(0); PG8_BAR; PG8_MMA(0, 0, At, B0); PG8_MMA(0, 1, At, B1); PG8_BAR; PG8_SCHED;
            PG8_LDA(At, 1, 1); PG8_STAGE(PG8_SB(1, 0), b3, voffB); PG8_STAGE(PG8_SB(1, 1), b3 + hstep, voffB); PG8_STAGE(PG8_SA(1, 0), a3, voffA);
            PG8_WAIT_V(8); PG8_WAIT_L(0); PG8_BAR; PG8_MMA(1, 0, At, B0); PG8_MMA(1, 1, At, B1); PG8_BAR; PG8_SCHED;
            } else {
            PG8_LDB(B0, 0, 0); PG8_SCHED; PG8_LDA(At, 0, 0); PG8_STAGE(PG8_SA(1, 1), a1 + hstep, voffA);
            PG8_WAIT_L(8); PG8_BAR; PG8_WAIT_L(0); PG8_MMA(0, 0, At, B0); PG8_BAR; PG8_SCHED;
            PG8_LDB(B1, 0, 1); PG8_STAGE(PG8_SB(0, 0), b2, voffB);
            PG8_BAR; PG8_WAIT_L(0); PG8_MMA(0, 1, At, B1); PG8_BAR;
            PG8_LDA(At, 0, 1); PG8_STAGE(PG8_SA(0, 0), a2, voffA);
            PG8_BAR; PG8_WAIT_L(0); PG8_MMA(1, 0, At, B0); PG8_BAR; PG8_SCHED;
            PG8_STAGE(PG8_SB(0, 1), b2 + hstep, voffB);
            PG8_WAIT_V(6); PG8_BAR; PG8_MMA(1, 1, At, B1); PG8_BAR;
            PG8_LDB(B0, 1, 0); PG8_SCHED; PG8_LDA(At, 1, 0); PG8_STAGE(PG8_SA(0, 1), a2 + hstep, voffA);
            PG8_WAIT_L(8); PG8_BAR; PG8_WAIT_L(0); PG8_MMA(0, 0, At, B0); PG8_BAR; PG8_SCHED;
            PG8_LDB(B1, 1, 1); PG8_STAGE(PG8_SB(1, 0), b3, voffB);
            PG8_BAR; PG8_WAIT_L(0); PG8_MMA(0, 1, At, B1); PG8_BAR;
            PG8_LDA(At, 1, 1); PG8_STAGE(PG8_SA(1, 0), a3, voffA);
            PG8_BAR; PG8_WAIT_L(0); PG8_MMA(1, 0, At, B0); PG8_BAR; PG8_SCHED;
            PG8_STAGE(PG8_SB(1, 1), b3 + hstep, voffB);
            PG8_WAIT_V(6); PG8_BAR; PG8_MMA(1, 1, At, B1); PG8_BAR;
            }
        }
        if constexpr (ALIGN_EPI) { if (wr == 0) PG8_BAR; }
        if constexpr (FP8) asm volatile("s_nop 15\n\ts_nop 15" ::: "memory");
        bool keep = false;
        if constexpr (Epi::HAS_MID) keep = (cur.kh == 0);
        if constexpr (!Epi::AFTER_DRAIN) { if constexpr (Epi::HAS_MID) { if (keep) E.mid(acc, cur, wr, wc, fr, fq); else E(acc, cur, wr, wc, fr, fq); } else E(acc, cur, wr, wc, fr, fq); S.done(cur); }
        if (!has_next) break;
        if (!keep)
#pragma unroll
        for (int a = 0; a < 2; ++a)
#pragma unroll
            for (int b = 0; b < 2; ++b)
#pragma unroll
                for (int m = 0; m < 4; ++m)
#pragma unroll
                    for (int n = 0; n < 2; ++n) acc[a][b][m][n] = (f32x4){0.f, 0.f, 0.f, 0.f};
        cur = nxt; cA = nA; cB = nB; ++ui;
        if constexpr (ALIGN_EPI) { if (wr == 1) PG8_BAR; }
    }
    PG8_WAIT_V(0);
    if constexpr (!ALIGN_EPI) { if (wr == 0) PG8_BAR; }
    PG8_BAR;
    if constexpr (Epi::AFTER_DRAIN) { E.fused(acc, cur, wr, wc, fr, fq, lds, wid, lane); S.done(cur); }
#undef PG8_SA
#undef PG8_SB
#undef PG8_STAGE
#undef PG8_LDA
#undef PG8_LDB
#undef PG8_MMA
#undef PG8_WAIT_V
#undef PG8_WAIT_L
#undef PG8_BAR
#undef PG8_SCHED
}
}
#define GAS __attribute__((address_space(1)))
#define LAS __attribute__((address_space(3)))
typedef unsigned short bf16;
typedef unsigned v4u __attribute__((ext_vector_type(4)));
typedef float f32x4 __attribute__((ext_vector_type(4)));
typedef short bf16x8 __attribute__((ext_vector_type(8)));
typedef GAS unsigned gu32;
typedef GAS unsigned long long gu64;
#define RLX_AGENT __ATOMIC_RELAXED, __HIP_MEMORY_SCOPE_AGENT
#define LDS_WAIT() asm volatile("s_waitcnt lgkmcnt(0)" ::: "memory")
#define VM_WAIT() asm volatile("s_waitcnt vmcnt(0)" ::: "memory")
__device__ __forceinline__ unsigned long long rt() { return __builtin_amdgcn_s_memrealtime(); }
__device__ __forceinline__ unsigned f2bf(float f) { unsigned u = __builtin_bit_cast(unsigned, f); return (u + 0x7fffu + ((u >> 16) & 1u)) >> 16; }
__device__ __forceinline__ unsigned pk2(float lo, float hi) { return f2bf(lo) | (f2bf(hi) << 16); }

#define XB_TMO      128
#define XB_XCNT(j)  (256  + 64 * (j))
#define XB_XSUB(j)  (1280 + 64 * (j))
#define XB_XGEN(j)  (2304 + 64 * (j))
#define XB_TOP      3328
#define XB_TOPGEN   3392
#define XCD_BAR_WORDS 3456
#define XB_SPIN_CAP (1u << 18)

__device__ __forceinline__ unsigned xb_ld(unsigned* p)              { return __hip_atomic_load(p, __ATOMIC_RELAXED, __HIP_MEMORY_SCOPE_AGENT); }
__device__ __forceinline__ unsigned xb_add(unsigned* p, unsigned v) { return __hip_atomic_fetch_add(p, v, __ATOMIC_RELAXED, __HIP_MEMORY_SCOPE_AGENT); }
__device__ __forceinline__ unsigned xb_xcc_id() { return (unsigned)__builtin_amdgcn_s_getreg((3 << 11) | 20) & 0xFu; }
#define XB_SPIN(cond, bar) do { unsigned _sp = 0; while (cond) { __builtin_amdgcn_s_sleep(1); \
    if ((++_sp & 255u) == 0u) { if (xb_ld(&(bar)[XB_TMO])) break; if (_sp > XB_SPIN_CAP) { atomicAdd(&(bar)[XB_TMO], 1u); break; } } } } while (0)

struct XcdBarrier {
    unsigned* bar; unsigned x;
    volatile LAS unsigned* st;
};

__device__ __forceinline__ XcdBarrier xcd_barrier_post(unsigned* bar, volatile LAS unsigned* st, bool is_t0) {
    XcdBarrier b; b.bar = bar; b.x = xb_xcc_id(); b.st = st;
    if (is_t0) (void)xb_add(&bar[XB_XCNT(b.x)], 1u);
    return b;
}
__device__ __forceinline__ void xcd_barrier_complete(unsigned* bar, unsigned x, unsigned& nloc, unsigned& nx) {
    const unsigned G = gridDim.x * gridDim.y * gridDim.z;
    unsigned sum, cnt, mine, sp = 0u;
    for (;;) {
        sum = 0u; cnt = 0u; mine = 0u;
#pragma unroll
        for (unsigned j = 0; j < 16; ++j) { const unsigned c = xb_ld(&bar[XB_XCNT(j)]); sum += c; cnt += (c > 0u) ? 1u : 0u; mine = (j == x) ? c : mine; }
        if (sum == G) break;
        __builtin_amdgcn_s_sleep(1);
        if ((++sp & 255u) == 0u) { if (xb_ld(&bar[XB_TMO])) break; if (sp > XB_SPIN_CAP) { atomicAdd(&bar[XB_TMO], 1u); break; } }
    }
    nloc = mine > 0u ? mine : 1u; nx = cnt > 0u ? cnt : 1u;
}

__device__ __forceinline__ void xcd_barrier(const XcdBarrier& b, bool is_t0) {
    asm volatile("s_waitcnt vmcnt(0)" ::: "memory");
    __syncthreads();
    if (is_t0) {
        unsigned* bar = b.bar;
        __builtin_amdgcn_s_waitcnt(0);
        unsigned nloc = b.st[0], nx = b.st[1];
        if (nloc == 0u) { xcd_barrier_complete(bar, b.x, nloc, nx); b.st[0] = nloc; b.st[1] = nx; }
        const unsigned old = xb_add(&bar[XB_XSUB(b.x)], 1u);
        const unsigned gen = old / nloc;
        if (old + 1u == (gen + 1u) * nloc) {
            __builtin_amdgcn_fence(__ATOMIC_RELEASE, "agent");
            asm volatile("s_waitcnt vmcnt(0)" ::: "memory");
            const unsigned og = xb_add(&bar[XB_TOP], 1u);
            const unsigned tg = og / nx;
            if (og + 1u == (tg + 1u) * nx) xb_add(&bar[XB_TOPGEN], 1u);
            else XB_SPIN(xb_ld(&bar[XB_TOPGEN]) == tg, bar);
            __builtin_amdgcn_fence(__ATOMIC_ACQUIRE, "agent");
            xb_add(&bar[XB_XGEN(b.x)], 1u);
            asm volatile("s_waitcnt vmcnt(0)" ::: "memory");
        } else {
            XB_SPIN(xb_ld(&bar[XB_XGEN(b.x)]) == gen, bar);
            __builtin_amdgcn_fence(__ATOMIC_ACQUIRE, "agent");
            asm volatile("s_waitcnt vmcnt(0)" ::: "memory");
        }
    }
    __syncthreads();
}

#ifndef DBGT
#define DBGT -1
#endif
#ifndef DBGS
#define DBGS 0.002f
#endif

constexpr int NB = 4, SEQ = 4096, DM = 2048, MTOK = NB * SEQ;
constexpr int NHEAD = 16, NGRP = 4, HDIM = 64, NSAW = 1024, KVW = 256;
constexpr int SSMW = 1024;
#ifndef KV8MASK
#define KV8MASK 0x0b
#endif
__host__ __device__ constexpr int kv_popc(int m) { return (m & 1) + ((m >> 1) & 1) + ((m >> 2) & 1) + ((m >> 3) & 1) + ((m >> 4) & 1); }
__host__ __device__ constexpr int kv_nth(int m, int k) { int c = 0; for (int i = 0; i < 5; ++i) if ((m >> i) & 1) { if (c == k) return i; ++c; } return 0; }
constexpr int NKV8 = kv_popc(KV8MASK), NKVB = 5 - NKV8;
constexpr int INW = 9776, INWP = 9984, INB = (18 + NKVB) * 256, ING = (16 + NKV8) * 256;
constexpr int CHUNK = 512, NCHUNK = SEQ / CHUNK;
constexpr float LN_EPS = 1e-5f;
constexpr float DN_ALPHA = 1.189207115002721f;
constexpr int NWAVES = 8, NTHR = 512;
#ifndef DBG
#define DBG 0
#endif
constexpr int LDS_BYTES = 159744, RING_BYTES = 155648, MISC_OFF = RING_BYTES + 320;

constexpr size_t MiB = 1u << 20;
constexpr size_t WS_CTL = 0, CTL_ZERO_BYTES = 1 * MiB;
constexpr int CW_BAR = 4096;
constexpr int CW_CMP = 7680;
constexpr int CW_SSM = 7680 + 16 * 16;
constexpr int CW_GEMV = CW_SSM + 16;
constexpr size_t WS_MOD = 32 * 1024;
constexpr size_t WS_MODP = 128 * 1024;
constexpr size_t WS_LUT = 512 * 1024;
constexpr size_t WS_BP = 520 * 1024;
constexpr size_t WS_KC = 1 * MiB;
constexpr size_t WS_VCT = 1 * MiB + 512 * 1024;
constexpr size_t WS_E = 2 * MiB;
constexpr size_t WS_WIN = 4 * MiB;
constexpr size_t WS_W8 = 28 * MiB;
constexpr size_t WS_WGLU = 43 * MiB;
constexpr size_t WS_WBN = 45 * MiB;
constexpr size_t WS_WBS = 49 * MiB;
constexpr size_t WS_WOUT = 53 * MiB;
constexpr size_t WS_WK1 = 61 * MiB;
constexpr size_t WS_WV1 = 61 * MiB + 512 * 1024;
constexpr size_t WS_WK2 = 62 * MiB;
constexpr size_t WS_WV2 = 62 * MiB + 64 * 1024;
constexpr size_t WS_H = 64 * MiB;
constexpr size_t WS_Q = 128 * MiB;
constexpr size_t WS_KCI = 160 * MiB, WS_VCI = 168 * MiB, WS_KS = 176 * MiB, WS_KW = 184 * MiB;
constexpr size_t WS_VST = 192 * MiB, WS_VWT = 200 * MiB;
constexpr size_t WS_NGB = 208 * MiB;
constexpr size_t WS_ZA = 212 * MiB;
constexpr size_t WS_US = 244 * MiB;
constexpr size_t WS_ZB = 276 * MiB;
constexpr size_t WS_GA = 308 * MiB, WS_GB = 372 * MiB;
constexpr size_t WS_OAB = 436 * MiB;
constexpr size_t WS_END = 500 * MiB;

typedef unsigned u32x2 __attribute__((ext_vector_type(2)));
typedef short s16x4 __attribute__((ext_vector_type(4)));

__device__ __forceinline__ float bflo(unsigned u) { return __builtin_bit_cast(float, u << 16); }
__device__ __forceinline__ float bfhi(unsigned u) { return __builtin_bit_cast(float, u & 0xffff0000u); }
__device__ __forceinline__ float bf2f(bf16 h) { return __builtin_bit_cast(float, (unsigned)h << 16); }
__device__ __forceinline__ unsigned cvtpk(float lo, float hi) { return pg8::cvt_pk_bf16(lo, hi); }
__device__ __forceinline__ float fexp(float x) { return __builtin_amdgcn_exp2f(x * 1.4426950408889634f); }
__device__ __forceinline__ float sigmoidf_(float v) { return __builtin_amdgcn_rcpf(1.f + fexp(-v)); }
__device__ __forceinline__ float siluf_(float v) { return v * sigmoidf_(v); }
__device__ __forceinline__ float gelu_tanh(float x) {
    const float z = 0.7978845608028654f * (x + 0.044715f * x * x * x);
    const float e = fexp(2.f * z);
    const float th = 1.f - 2.f * __builtin_amdgcn_rcpf(1.f + e);
    return 0.5f * x * (1.f + th);
}
__device__ __forceinline__ bf16x8 pack8(float a0, float a1, float a2, float a3, float a4, float a5, float a6, float a7) {
    v4u w; w.x = cvtpk(a0, a1); w.y = cvtpk(a2, a3); w.z = cvtpk(a4, a5); w.w = cvtpk(a6, a7);
    return __builtin_bit_cast(bf16x8, w);
}
__device__ __forceinline__ f32x4 mfma16(bf16x8 a, bf16x8 b, f32x4 c) { return __builtin_amdgcn_mfma_f32_16x16x32_bf16(a, b, c, 0, 0, 0); }
template <int CTRL> __device__ __forceinline__ float dppf(float x) { return __builtin_bit_cast(float, __builtin_amdgcn_mov_dpp(__builtin_bit_cast(int, x), CTRL, 0xf, 0xf, true)); }
template <int CTRL> __device__ __forceinline__ int dppi(int x) { return __builtin_amdgcn_mov_dpp(x, CTRL, 0xf, 0xf, true); }
constexpr int DPP_XOR1 = 0xB1, DPP_XOR2 = 0x4E, DPP_HMIRROR = 0x141;
__device__ __forceinline__ float xq_max(float x) {
    auto s = __builtin_amdgcn_permlane16_swap(__builtin_bit_cast(unsigned, x), __builtin_bit_cast(unsigned, x), false, false);
    x = fmaxf(__builtin_bit_cast(float, (unsigned)s[0]), __builtin_bit_cast(float, (unsigned)s[1]));
    auto t = __builtin_amdgcn_permlane32_swap(__builtin_bit_cast(unsigned, x), __builtin_bit_cast(unsigned, x), false, false);
    return fmaxf(__builtin_bit_cast(float, (unsigned)t[0]), __builtin_bit_cast(float, (unsigned)t[1]));
}
__device__ __forceinline__ float xq_sum(float x) {
    auto s = __builtin_amdgcn_permlane16_swap(__builtin_bit_cast(unsigned, x), __builtin_bit_cast(unsigned, x), false, false);
    x = __builtin_bit_cast(float, (unsigned)s[0]) + __builtin_bit_cast(float, (unsigned)s[1]);
    auto t = __builtin_amdgcn_permlane32_swap(__builtin_bit_cast(unsigned, x), __builtin_bit_cast(unsigned, x), false, false);
    return __builtin_bit_cast(float, (unsigned)t[0]) + __builtin_bit_cast(float, (unsigned)t[1]);
}

constexpr int DPP_RMIRROR = 0x140;
__device__ __forceinline__ float wave_sum(float v) {
    v += dppf<DPP_XOR1>(v); v += dppf<DPP_XOR2>(v); v += dppf<DPP_HMIRROR>(v); v += dppf<DPP_RMIRROR>(v);
    return xq_sum(v);
}

struct Ctx {
    float* out; unsigned char* ws;
    LAS unsigned char* lds;
    int tid, lane, wave, G, bid;
};
constexpr int PTR_OFF = RING_BYTES + 512;
__device__ __forceinline__ const float* inp(const Ctx& C, int i) {
    const LAS unsigned* tab = (const LAS unsigned*)(C.lds + PTR_OFF);
    const unsigned lo = __builtin_amdgcn_readfirstlane(tab[2 * i]), hi = __builtin_amdgcn_readfirstlane(tab[2 * i + 1]);
    return (const float*)(((unsigned long long)hi << 32) | lo);
}
#define WSP(T, off) ((T*)(C.ws + (off)))
__device__ __forceinline__ void counter_signal(const Ctx& C, int word) {
    if (C.tid == 0) { __builtin_amdgcn_fence(__ATOMIC_RELEASE, "agent"); asm volatile("s_waitcnt vmcnt(0)" ::: "memory");
        __hip_atomic_fetch_add((unsigned*)(C.ws + WS_CTL) + word, 1u, __ATOMIC_RELAXED, __HIP_MEMORY_SCOPE_AGENT); }
}
__device__ __forceinline__ void counter_wait(const Ctx& C, int word, unsigned target) {
    if (C.tid == 0) {
        unsigned* p = (unsigned*)(C.ws + WS_CTL) + word; unsigned sp = 0;
        while (__hip_atomic_load(p, __ATOMIC_RELAXED, __HIP_MEMORY_SCOPE_AGENT) < target) { __builtin_amdgcn_s_sleep(2); if (++sp > (1u << 22)) break; }
        __builtin_amdgcn_fence(__ATOMIC_ACQUIRE, "agent"); asm volatile("s_waitcnt vmcnt(0)" ::: "memory");
    }
    __syncthreads();
}

struct EpiIn {
    static constexpr bool PERM = true, AFTER_DRAIN = false, HAS_MID = false;
    unsigned char* ws; int gates;
    __device__ __forceinline__ void operator()(const pg8::f32x4 (&acc)[2][2][4][2], const pg8::Unit& u, int wr, int wc, int fr, int fq) const {
        const int pn = u.pn;
        int mode; size_t off; int ld; int cb;
        int kvid = -1;
        if (!gates) {
            if (pn < 4) { mode = 1; off = WS_Q; ld = 1024; cb = pn * 256; }
            else if (pn < 5) { mode = 0; off = WS_KCI; ld = 256; cb = 0; }
            else if (pn < 5 + NKVB) { kvid = kv_nth(0x1f & ~KV8MASK, pn - 5); }
            else if (pn < 9 + NKVB) { mode = 2; off = WS_ZA; ld = 1024; cb = (pn - 5 - NKVB) * 256; }
            else if (pn < 13 + NKVB) { mode = 0; off = WS_US; ld = 1024; cb = (pn - 9 - NKVB) * 256; }
            else if (pn < 17 + NKVB) { mode = 2; off = WS_ZB; ld = 1024; cb = (pn - 13 - NKVB) * 256; }
            else { mode = 5; off = WS_NGB; ld = 64; cb = 0; }
        } else {
            if (pn < NKV8) kvid = kv_nth(KV8MASK, pn);
            else { mode = 6; off = WS_GA; ld = 2048; cb = (pn - NKV8) * 128; }
        }
        if (kvid >= 0) { ld = 256; cb = 0; mode = (kvid == 2 || kvid == 4) ? 4 : 0;
            off = kvid == 0 ? WS_VCI : (kvid == 1 ? WS_KS : (kvid == 2 ? WS_VST : (kvid == 3 ? WS_KW : WS_VWT))); }
        const float gsc = gates ? 0.03125f : 1.f;
        bf16* base = (bf16*)(ws + off);
        const int row0 = u.pm * 256 + wr * 64 + fr;
        if (mode == 6) {
            bf16* gbp = (bf16*)(ws + WS_GB);
#pragma unroll
            for (int ai = 0; ai < 2; ++ai)
#pragma unroll
                for (int m = 0; m < 4; ++m) {
                    const size_t o = (size_t)(row0 + ai * 128 + m * 16) * 2048 + cb + wc * 32 + 8 * fq;
                    float ra[8], sb[8];
#pragma unroll
                    for (int e = 0; e < 8; ++e) {
                        const float a = acc[ai][0][m][e >> 2][e & 3] * gsc, bb = acc[ai][1][m][e >> 2][e & 3] * gsc;
                        const float A = 1.f + fexp(fminf(-a, 40.f)), B = 1.f + fexp(fminf(-bb, 40.f)), t = __builtin_amdgcn_rcpf(A * B);
                        ra[e] = t * B * B; sb[e] = t * A;
                    }
                    { v4u w; w.x = cvtpk(ra[0], ra[1]); w.y = cvtpk(ra[2], ra[3]); w.z = cvtpk(ra[4], ra[5]); w.w = cvtpk(ra[6], ra[7]); *(v4u*)(base + o) = w; }
                    { v4u w; w.x = cvtpk(sb[0], sb[1]); w.y = cvtpk(sb[2], sb[3]); w.z = cvtpk(sb[4], sb[5]); w.w = cvtpk(sb[6], sb[7]); *(v4u*)(gbp + o) = w; }
                }
            return;
        }
#pragma unroll
        for (int ai = 0; ai < 2; ++ai)
#pragma unroll
            for (int m = 0; m < 4; ++m) {
                const int row = row0 + ai * 128 + m * 16;
#pragma unroll
                for (int bj = 0; bj < 2; ++bj) {
                    const int cc = bj * 128 + wc * 32 + 8 * fq;
                    float v[8];
#pragma unroll
                    for (int e = 0; e < 4; ++e) { v[e] = acc[ai][bj][m][0][e] * gsc; v[4 + e] = acc[ai][bj][m][1][e] * gsc; }
                    if (mode == 1) {
#pragma unroll
                        for (int e = 0; e < 8; ++e) v[e] *= 0.125f;
                    } else if (mode == 2) {
#pragma unroll
                        for (int e = 0; e < 8; ++e) v[e] = siluf_(v[e]);
                    } else if (mode == 3 || mode == 5) {
#pragma unroll
                        for (int e = 0; e < 8; ++e) v[e] = sigmoidf_(v[e]);
                    }
                    if (mode == 4) {
                        const int b = row >> 12, t = row & 4095, g = cc >> 6, d0 = cc & 63, kk = t & 31;
                        const int pos = (t & 32) + 8 * ((kk & 15) >> 2) + 4 * (kk >> 4) + (kk & 3);
                        bf16* p = base + ((size_t)((b * 4 + g) * 64 + (t >> 6)) << 12) + d0 * 64 + pos;
#pragma unroll
                        for (int e = 0; e < 8; ++e) p[e * 64] = (bf16)(cvtpk(v[e], 0.f) & 0xffffu);
                    } else if (mode == 5) {
                        if (cc < 48) { v4u w; w.x = cvtpk(v[0], v[1]); w.y = cvtpk(v[2], v[3]); w.z = cvtpk(v[4], v[5]); w.w = cvtpk(v[6], v[7]);
                            *(v4u*)(base + (size_t)row * 64 + cc) = w; }
                    } else if (ld == 256) {
                        v4u w; w.x = cvtpk(v[0], v[1]); w.y = cvtpk(v[2], v[3]); w.z = cvtpk(v[4], v[5]); w.w = cvtpk(v[6], v[7]);
                        *(v4u*)(base + ((size_t)(((row >> 12) * 4 + (cc >> 6)) * 4096 + (row & 4095)) << 6) + (cc & 63)) = w;
                    } else {
                        v4u w; w.x = cvtpk(v[0], v[1]); w.y = cvtpk(v[2], v[3]); w.z = cvtpk(v[4], v[5]); w.w = cvtpk(v[6], v[7]);
                        *(v4u*)(base + (size_t)row * ld + cb + cc) = w;
                    }
                }
            }
    }
};

template <int MODE> struct EpiMix {
    static constexpr bool PERM = true, AFTER_DRAIN = false, HAS_MID = (MODE == 1);
    const bf16* P0; const bf16* P1; bf16* O; const float* F0; const float* F1; float* OF; int ld; int ldo;
    __device__ __forceinline__ void mid(pg8::f32x4 (&acc)[2][2][4][2], const pg8::Unit& u, int wr, int wc, int fr, int fq) const {
        const int row0 = u.pm * 256 + wr * 64 + fr;
#pragma unroll
        for (int ai = 0; ai < 2; ++ai) {
            v4u ga[4][2];
#pragma unroll
            for (int m = 0; m < 4; ++m)
#pragma unroll
                for (int bj = 0; bj < 2; ++bj) {
                    const size_t idx = (size_t)(row0 + ai * 128 + m * 16) * ld + u.pn * 256 + bj * 128 + wc * 32 + 8 * fq;
                    ga[m][bj] = *(const v4u*)(P0 + idx);
                }
#pragma unroll
            for (int m = 0; m < 4; ++m)
#pragma unroll
                for (int bj = 0; bj < 2; ++bj) {
                    const unsigned aa[4] = {ga[m][bj].x, ga[m][bj].y, ga[m][bj].z, ga[m][bj].w};
#pragma unroll
                    for (int e = 0; e < 4; ++e) { acc[ai][bj][m][e >> 1][(2 * e) & 3] *= bflo(aa[e]); acc[ai][bj][m][e >> 1][(2 * e + 1) & 3] *= bfhi(aa[e]); }
                }
            __builtin_amdgcn_sched_barrier(0);
        }
    }
    __device__ __forceinline__ void operator()(const pg8::f32x4 (&acc)[2][2][4][2], const pg8::Unit& u, int wr, int wc, int fr, int fq) const {
        const int row0 = u.pm * 256 + wr * 64 + fr;
        f32x4 cv[2][2];
        if (MODE == 0 || MODE == 3) {
#pragma unroll
            for (int bj = 0; bj < 2; ++bj) {
                const int col = u.pn * 256 + bj * 128 + wc * 32 + 8 * fq;
                const float* cp = MODE == 0 ? F0 + col : F1 + (u.pm >> 4) * 6144 + 4096 + col;
                cv[bj][0] = *(const f32x4*)cp; cv[bj][1] = *(const f32x4*)(cp + 4);
            }
        }
#pragma unroll
        for (int ai = 0; ai < 2; ++ai) {
            v4u la[4][2], lb[4][2];
            if (MODE != 3) {
#pragma unroll
                for (int m = 0; m < 4; ++m)
#pragma unroll
                    for (int bj = 0; bj < 2; ++bj) {
                        const size_t idx = (size_t)(row0 + ai * 128 + m * 16) * ld + u.pn * 256 + bj * 128 + wc * 32 + 8 * fq;
                        if (MODE == 0) { la[m][bj] = *(const v4u*)(P0 + idx); lb[m][bj] = *(const v4u*)(P1 + idx); }
                        else if (MODE == 1) { la[m][bj] = *(const v4u*)(P1 + idx); }
                        else { la[m][bj] = *(const v4u*)(P0 + idx); lb[m][bj] = *(const v4u*)(P1 + idx); }
                    }
            }
#pragma unroll
            for (int m = 0; m < 4; ++m) {
                const int row = row0 + ai * 128 + m * 16;
#pragma unroll
                for (int bj = 0; bj < 2; ++bj) {
                    const int col = u.pn * 256 + bj * 128 + wc * 32 + 8 * fq;
                    float v[8];
#pragma unroll
                    for (int e = 0; e < 4; ++e) { v[e] = acc[ai][bj][m][0][e]; v[4 + e] = acc[ai][bj][m][1][e]; }
                    if (MODE == 0) {
                        const v4u y = la[m][bj], z = lb[m][bj];
                        const f32x4 b0 = cv[bj][0], b1 = cv[bj][1];
                        const float bb[8] = {b0.x, b0.y, b0.z, b0.w, b1.x, b1.y, b1.z, b1.w};
                        const unsigned yy[4] = {y.x, y.y, y.z, y.w}, zz[4] = {z.x, z.y, z.z, z.w};
#pragma unroll
                        for (int e = 0; e < 4; ++e) {
                            v[2 * e] = bflo(yy[e]) * sigmoidf_(v[2 * e] + bb[2 * e]) * bflo(zz[e]);
                            v[2 * e + 1] = bfhi(yy[e]) * sigmoidf_(v[2 * e + 1] + bb[2 * e + 1]) * bfhi(zz[e]);
                        }
                    } else if (MODE == 1) {
                        const v4u g = la[m][bj]; const unsigned gg[4] = {g.x, g.y, g.z, g.w};
#pragma unroll
                        for (int e = 0; e < 4; ++e) { v[2 * e] *= bflo(gg[e]); v[2 * e + 1] *= bfhi(gg[e]); }
                    } else if (MODE == 2) {
                        const v4u g = la[m][bj], m1 = lb[m][bj];
                        const unsigned gg[4] = {g.x, g.y, g.z, g.w}, mm[4] = {m1.x, m1.y, m1.z, m1.w};
#pragma unroll
                        for (int e = 0; e < 4; ++e) { v[2 * e] = bflo(mm[e]) + v[2 * e] * bflo(gg[e]); v[2 * e + 1] = bfhi(mm[e]) + v[2 * e + 1] * bfhi(gg[e]); }
                    } else {
                        const f32x4 g0 = cv[bj][0], g1 = cv[bj][1];
                        v[0] *= g0.x; v[1] *= g0.y; v[2] *= g0.z; v[3] *= g0.w; v[4] *= g1.x; v[5] *= g1.y; v[6] *= g1.z; v[7] *= g1.w;
                        if (DBG == 1) {
#pragma unroll
                            for (int e = 0; e < 8; ++e) v[e] = 0.f; }
                    }
                    { v4u w; w.x = cvtpk(v[0], v[1]); w.y = cvtpk(v[2], v[3]); w.z = cvtpk(v[4], v[5]); w.w = cvtpk(v[6], v[7]); *(v4u*)(O + (size_t)row * ldo + col) = w; }
                }
            }
        }
    }
};

__device__ __forceinline__ int win_src_col(int n) {
    const int t = n >> 8, c = n & 255;
    if (n < INB) {
        if (t < 5) return n;
        if (t < 5 + NKVB) return 1280 + 256 * kv_nth(0x1f & ~KV8MASK, t - 5) + c;
        const int t2 = t - 5 - NKVB;
        if (t2 < 12) return 2608 + 256 * t2 + c;
        return c < 48 ? 2560 + c : -1;
    }
    const int t8 = t - INB / 256;
    if (t8 < NKV8) return 1280 + 256 * kv_nth(KV8MASK, t8) + c;
    { const int gt = t8 - NKV8; return c < 128 ? 5680 + 128 * gt + c : 7728 + 128 * gt + (c - 128); }
}
struct TItem { const float* src; unsigned char* dst; int N, sc; bool f8; };
__device__ __forceinline__ void titem_load(const TItem& T, f32x4 (&v)[16]) {
#pragma unroll
    for (int i = 0; i < 16; ++i) v[i] = (T.sc >= 0) ? *(const f32x4*)(T.src + (size_t)(4 * i) * T.N) : (f32x4){0.f, 0.f, 0.f, 0.f};
}
__device__ __forceinline__ void titem_store(const TItem& T, const f32x4 (&v)[16], LAS float* scr, int lane) {
    const int ksub = lane >> 4, n4 = 4 * (lane & 15);
    const bool f8 = T.f8;
    v4u o[8];
#pragma unroll
    for (int h = 0; h < 2; ++h) {
#pragma unroll
        for (int i = 0; i < 8; ++i) *(LAS f32x4*)(scr + (4 * i + ksub) * 68 + n4) = v[8 * h + i];
        LDS_WAIT(); asm volatile("" ::: "memory");
        if (f8) {
            unsigned wd[8];
#pragma unroll
            for (int c = 0; c < 8; ++c) { const LAS float* s = scr + (4 * c) * 68 + lane;
                int t = __builtin_amdgcn_cvt_pk_fp8_f32(s[0 * 68] * 32.f, s[1 * 68] * 32.f, 0, false); t = __builtin_amdgcn_cvt_pk_fp8_f32(s[2 * 68] * 32.f, s[3 * 68] * 32.f, t, true); wd[c] = (unsigned)t; }
            o[2 * h] = (v4u){wd[0], wd[1], wd[2], wd[3]}; o[2 * h + 1] = (v4u){wd[4], wd[5], wd[6], wd[7]};
        } else {
#pragma unroll
            for (int c = 0; c < 4; ++c) { const LAS float* s = scr + (8 * c) * 68 + lane;
                o[4 * h + c].x = cvtpk(s[0 * 68], s[1 * 68]); o[4 * h + c].y = cvtpk(s[2 * 68], s[3 * 68]); o[4 * h + c].z = cvtpk(s[4 * 68], s[5 * 68]); o[4 * h + c].w = cvtpk(s[6 * 68], s[7 * 68]); }
        }
        LDS_WAIT(); asm volatile("" ::: "memory");
    }
    v4u* wp = (v4u*)T.dst;
    if (f8) {
#pragma unroll
        for (int c = 0; c < 4; ++c) wp[c] = o[c];
    } else {
#pragma unroll
        for (int c = 0; c < 8; ++c) wp[c] = o[c];
    }
}

__device__ __forceinline__ void phase0(const Ctx& C) {
    LAS float* scr = (LAS float*)(C.lds + C.wave * 16384);
    const int gw = C.bid * NWAVES + C.wave, NGW = C.G * NWAVES, lane = C.lane;
    const int NGV = (C.G >= 192) ? 96 : 0;
    if (C.bid < 96 && (NGV || C.bid == 0)) {
        const float* cvec = inp(C, 1); const float* wada = inp(C, 2); float* modp = WSP(float, WS_MODP);
        for (int u = C.bid; u < 96; u += (NGV ? 96 : 1)) {
            const int nc = u % 24, kq = u / 24;
            const int n0 = nc * 256 + 4 * lane, kb = kq * 512 + C.wave * 64;
            f32x4 a0 = {0, 0, 0, 0}, a1 = a0, a2 = a0, a3 = a0;
#pragma unroll 16
            for (int k = kb; k < kb + 64; ++k) {
                const f32x4 w = *(const f32x4*)(wada + (size_t)k * 6144 + n0);
                a0 += w * cvec[k]; a1 += w * cvec[2048 + k]; a2 += w * cvec[4096 + k]; a3 += w * cvec[6144 + k];
            }
            LAS f32x4* part = (LAS f32x4*)C.lds;
            part[(C.wave * 4 + 0) * 64 + lane] = a0; part[(C.wave * 4 + 1) * 64 + lane] = a1; part[(C.wave * 4 + 2) * 64 + lane] = a2; part[(C.wave * 4 + 3) * 64 + lane] = a3;
            __syncthreads();
            if (C.wave < 4) {
                f32x4 s = part[C.wave * 64 + lane];
#pragma unroll
                for (int w8 = 1; w8 < 8; ++w8) s += part[(w8 * 4 + C.wave) * 64 + lane];
                *(f32x4*)(modp + (size_t)(kq * 4 + C.wave) * 6144 + n0) = s;
                asm volatile("s_waitcnt vmcnt(0)" ::: "memory");
            }
            __syncthreads();
            counter_signal(C, CW_GEMV);
        }
    }
    {
        constexpr int I_IN = 32 * (INWP / 64), I_GLU = 16 * 16, I_BN = 16 * 32, I_OUT = 32 * 32, I_C1 = 32 * 2, I_C2 = 2 * 1;
        constexpr int NIT = I_IN + I_GLU + 2 * I_BN + I_OUT + 2 * I_C1 + 2 * I_C2;
        constexpr int QG = 2;
        const int NGW_G = NGV * NWAVES, NGWC = (C.G - NGV) * NWAVES, NG_IT = QG * NGW_G;
        int it, iend, istep;
        if (C.bid >= NGV) { it = NG_IT + (C.bid - NGV) * NWAVES + C.wave; iend = NIT; istep = NGWC; }
        else { it = C.bid * NWAVES + C.wave; iend = NG_IT; istep = NGW_G; }
        auto decode = [&](int item) -> TItem {
            int r = item; const float* W; int N, NP, ldk, koff = 0; size_t wo; bool win = false;
            if (r < I_IN) { W = inp(C, 4); N = INW; NP = INWP; ldk = 2048; wo = WS_WIN; win = true; }
            else if ((r -= I_IN) < I_GLU) { W = inp(C, 20); N = 1024; NP = 1024; ldk = 1024; wo = WS_WGLU; }
            else if ((r -= I_GLU) < I_BN) { W = inp(C, 22); N = 2048; NP = 2048; ldk = 2048; wo = WS_WBN; }
            else if ((r -= I_BN) < I_BN) { W = inp(C, 23); N = 2048; NP = 2048; ldk = 2048; koff = 1024; wo = WS_WBN; }
            else if ((r -= I_BN) < I_OUT) { W = inp(C, 24); N = 2048; NP = 2048; ldk = 2048; wo = WS_WOUT; }
            else if ((r -= I_OUT) < I_C1) { W = inp(C, 8); N = 128; NP = 128; ldk = 2048; wo = WS_WK1; }
            else if ((r -= I_C1) < I_C1) { W = inp(C, 10); N = 128; NP = 128; ldk = 2048; wo = WS_WV1; }
            else if ((r -= I_C1) < I_C2) { W = inp(C, 9); N = 64; NP = 64; ldk = 128; wo = WS_WK2; }
            else { r -= I_C2; W = inp(C, 11); N = 64; NP = 64; ldk = 128; wo = WS_WV2; }
            const int nblk = NP / 64, kb = r / nblk, nb = r - kb * nblk, k0 = 64 * kb, n0 = 64 * nb;
            const int nn = n0 + 4 * (lane & 15); const int sc = win ? win_src_col(nn) : nn;
            TItem T; T.N = N; T.sc = sc; T.f8 = win && n0 >= INB;
            T.src = W + (size_t)(k0 + (lane >> 4)) * N + (sc >= 0 ? sc : 0);
            T.dst = T.f8 ? C.ws + WS_W8 + (size_t)(n0 - INB + lane) * 2048 + k0 : C.ws + wo + ((size_t)(n0 + lane) * ldk + koff + k0) * 2;
            return T;
        };
        if (it < iend) {
            TItem T = decode(it);
            f32x4 v[16];
            titem_load(T, v);
            for (; it < iend; it += istep) {
                const bool more = it + istep < iend;
                TItem Tn = T; f32x4 nv[16];
                if (more) { Tn = decode(it + istep); titem_load(Tn, nv); }
                titem_store(T, v, scr, lane);
                if (more) {
#pragma unroll
                    for (int i = 0; i < 16; ++i) v[i] = nv[i];
                    T = Tn;
                }
            }
        }
    }
    if (C.bid == C.G - 1) {
        const float* rb = inp(C, 5); float* lut = WSP(float, WS_LUT);
        for (int i = C.tid; i < 16 * 128; i += NTHR) {
            const int h = i >> 7, d = i & 127; int bk;
            if (d < 16) bk = d; else { const float v = logf((float)d / 16.f) / 2.0794415416798357f * 16.f; bk = 16 + (int)v; if (bk > 31) bk = 31; }
            lut[i] = rb[bk * 16 + h];
        }
    }
}

__device__ __forceinline__ void phase1(const Ctx& C) {
    const int gw = C.bid * NWAVES + C.wave, NGW = C.G * NWAVES, lane = C.lane;
    const float* x = inp(C, 0); bf16* H = WSP(bf16, WS_H);
    const float* modp = WSP(const float, WS_MODP); const float* bada = inp(C, 3);
#define MOD4(b_, o_) ({ const int o4_ = (o_); f32x4 s_ = *(const f32x4*)(bada + o4_); \
        s_ += *(const f32x4*)(modp + (size_t)(0 * 4 + (b_)) * 6144 + o4_); s_ += *(const f32x4*)(modp + (size_t)(1 * 4 + (b_)) * 6144 + o4_); \
        s_ += *(const f32x4*)(modp + (size_t)(2 * 4 + (b_)) * 6144 + o4_); s_ += *(const f32x4*)(modp + (size_t)(3 * 4 + (b_)) * 6144 + o4_); s_; })
    for (int gq = gw; gq < 32; gq += NGW) {
        const int b = gq >> 3, o = 4096 + (gq & 7) * 256 + 4 * lane;
        *(f32x4*)(WSP(float, WS_MOD) + b * 6144 + o) = MOD4(b, o);
    }
    if (NGW == 2048) {
        const int b = gw & 3, r0 = gw >> 2;
        f32x4 sh[8], sc[8];
#pragma unroll
        for (int j = 0; j < 8; ++j) { sh[j] = MOD4(b, 4 * (lane + 64 * j)); const f32x4 g = MOD4(b, 2048 + 4 * (lane + 64 * j)); sc[j] = g + 1.f; }
        f32x4 v[8];
        { const f32x4* xr = (const f32x4*)(x + (size_t)(b * SEQ + r0) * DM) + lane;
#pragma unroll
          for (int j = 0; j < 8; ++j) v[j] = __builtin_nontemporal_load(xr + 64 * j); }
        for (int k = 0; k < 8; ++k) {
            const int m = b * SEQ + r0 + 512 * k;
            f32x4 nv[8];
            { const int mn = (k < 7) ? m + 512 : m; const f32x4* xr = (const f32x4*)(x + (size_t)mn * DM) + lane;
#pragma unroll
              for (int j = 0; j < 8; ++j) nv[j] = __builtin_nontemporal_load(xr + 64 * j); }
            float s = 0.f;
#pragma unroll
            for (int j = 0; j < 8; ++j) s += (v[j].x + v[j].y) + (v[j].z + v[j].w);
            const float mean = wave_sum(s) * (1.f / DM); float s2 = 0.f;
#pragma unroll
            for (int j = 0; j < 8; ++j) { v[j] = v[j] - mean; s2 += (v[j].x * v[j].x + v[j].y * v[j].y) + (v[j].z * v[j].z + v[j].w * v[j].w); }
            const float rstd = 1.f / sqrtf(wave_sum(s2) * (1.f / DM) + LN_EPS);
            u32x2* o8 = (u32x2*)(H + (size_t)m * DM) + lane;
#pragma unroll
            for (int j = 0; j < 8; ++j) {
                const f32x4 hh = v[j] * rstd * sc[j] + sh[j];
                u32x2 w; w.x = cvtpk(hh.x, hh.y); w.y = cvtpk(hh.z, hh.w); o8[64 * j] = w;
                int t8 = __builtin_amdgcn_cvt_pk_fp8_f32(hh.x, hh.y, 0, false); t8 = __builtin_amdgcn_cvt_pk_fp8_f32(hh.z, hh.w, t8, true);
                ((unsigned*)(C.ws + WS_OAB + (size_t)m * DM))[lane + 64 * j] = (unsigned)t8;
            }
#pragma unroll
            for (int j = 0; j < 8; ++j) v[j] = nv[j];
        }
    } else
    {
        f32x4 v[8];
        if (gw < MTOK) { const f32x4* xr = (const f32x4*)(x + (size_t)gw * DM) + lane;
#pragma unroll
            for (int j = 0; j < 8; ++j) v[j] = xr[64 * j]; }
        for (int m = gw; m < MTOK; m += NGW) {
            const int b = m >> 12;
            f32x4 nv[8];
            { const int mn = (m + NGW < MTOK) ? m + NGW : m; const f32x4* xr = (const f32x4*)(x + (size_t)mn * DM) + lane;
#pragma unroll
              for (int j = 0; j < 8; ++j) nv[j] = xr[64 * j]; }
            float s = 0.f;
#pragma unroll
            for (int j = 0; j < 8; ++j) s += (v[j].x + v[j].y) + (v[j].z + v[j].w);
            const float mean = wave_sum(s) * (1.f / DM); float s2 = 0.f;
#pragma unroll
            for (int j = 0; j < 8; ++j) { v[j] = v[j] - mean; s2 += (v[j].x * v[j].x + v[j].y * v[j].y) + (v[j].z * v[j].z + v[j].w * v[j].w); }
            const float rstd = 1.f / sqrtf(wave_sum(s2) * (1.f / DM) + LN_EPS);

            u32x2* o8 = (u32x2*)(H + (size_t)m * DM) + lane;
#pragma unroll
            for (int j = 0; j < 8; ++j) {
                const f32x4 a = MOD4(b, 4 * (lane + 64 * j)), g = MOD4(b, 2048 + 4 * (lane + 64 * j));
                const float h0 = v[j].x * rstd * (1.f + g.x) + a.x, h1 = v[j].y * rstd * (1.f + g.y) + a.y, h2 = v[j].z * rstd * (1.f + g.z) + a.z, h3 = v[j].w * rstd * (1.f + g.w) + a.w;
                u32x2 w; w.x = cvtpk(h0, h1); w.y = cvtpk(h2, h3); o8[64 * j] = w;
            }
#pragma unroll
            for (int j = 0; j < 8; ++j) v[j] = nv[j];
        }
    }
    for (int it = C.bid; it < 256; it += C.G) {
        const int kv = it >> 7, uu = it & 127; const float* pos = inp(C, kv ? 7 : 6); const float* w1 = inp(C, kv ? 10 : 8);
        float s = 0.f;
#pragma unroll
        for (int i = 0; i < 4; ++i) { const int k = 256 * C.wave + lane + 64 * i; s += pos[k] * w1[(size_t)k * 128 + uu]; }
        s = wave_sum(s);
        LAS float* red = (LAS float*)C.lds;
        if (lane == 0) red[C.wave] = s;
        __syncthreads();
        if (C.tid == 0) { float t = red[0]; for (int w8 = 1; w8 < 8; ++w8) t += red[w8]; WSP(float, WS_BP)[it] = t; }
        __syncthreads();
    }
}

__device__ __forceinline__ void phase_ln_out(const Ctx& C) {
    const int gw = C.bid * NWAVES + C.wave, NGW = C.G * NWAVES, lane = C.lane;
    const float* x = inp(C, 0); const float* lg = inp(C, 25); const float* lb = inp(C, 26); const bf16* GY = WSP(bf16, WS_Q);
    f32x4 v[8]; u32x2 y[8];
    f32x4 lgv[8], lbv[8];
#pragma unroll
    for (int j = 0; j < 8; ++j) { lgv[j] = ((const f32x4*)lg)[lane + 64 * j]; lbv[j] = ((const f32x4*)lb)[lane + 64 * j]; }
    if (gw < MTOK) { const f32x4* xr = (const f32x4*)(x + (size_t)gw * DM) + lane; const u32x2* yr = (const u32x2*)(GY + (size_t)gw * DM) + lane;
#pragma unroll
        for (int j = 0; j < 8; ++j) { v[j] = __builtin_nontemporal_load(xr + 64 * j); y[j] = yr[64 * j]; } }
    for (int m = gw; m < MTOK; m += NGW) {
        f32x4* zr = (f32x4*)(C.out + (size_t)m * DM) + lane;
        f32x4 nv[8]; u32x2 ny[8];
        { const int mn = (m + NGW < MTOK) ? m + NGW : m; const f32x4* xn = (const f32x4*)(x + (size_t)mn * DM) + lane; const u32x2* yn = (const u32x2*)(GY + (size_t)mn * DM) + lane;
#pragma unroll
          for (int j = 0; j < 8; ++j) { nv[j] = __builtin_nontemporal_load(xn + 64 * j); ny[j] = yn[64 * j]; } }
        float s = 0.f;
#pragma unroll
        for (int j = 0; j < 8; ++j) { v[j].x = DN_ALPHA * v[j].x + bflo(y[j].x); v[j].y = DN_ALPHA * v[j].y + bfhi(y[j].x); v[j].z = DN_ALPHA * v[j].z + bflo(y[j].y); v[j].w = DN_ALPHA * v[j].w + bfhi(y[j].y);
            s += (v[j].x + v[j].y) + (v[j].z + v[j].w); }
        const float mean = wave_sum(s) * (1.f / DM); float s2 = 0.f;
#pragma unroll
        for (int j = 0; j < 8; ++j) { v[j] = v[j] - mean; s2 += (v[j].x * v[j].x + v[j].y * v[j].y) + (v[j].z * v[j].z + v[j].w * v[j].w); }
        const float rstd = 1.f / sqrtf(wave_sum(s2) * (1.f / DM) + LN_EPS);
#pragma unroll
        for (int j = 0; j < 8; ++j) {
            const f32x4 g = lgv[j], bb = lbv[j];
            f32x4 o; o.x = v[j].x * rstd * g.x + bb.x; o.y = v[j].y * rstd * g.y + bb.y; o.z = v[j].z * rstd * g.z + bb.z; o.w = v[j].w * rstd * g.w + bb.w;
            __builtin_nontemporal_store(o, zr + 64 * j);
        }
#pragma unroll
        for (int j = 0; j < 8; ++j) { v[j] = nv[j]; y[j] = ny[j]; }
    }
}

constexpr int HS = 136;
constexpr int SSM_HS_OFF = 0, SSM_EL_OFF = 8 * 16 * HS * 2, SSM_SH_OFF = SSM_EL_OFF + 32 * 64 * 8;
typedef float f32x2v __attribute__((ext_vector_type(2)));
template <bool FINAL>
__device__ __forceinline__ void ssm_pass(const Ctx& C, int b, int g, const bf16x8 (&Bf)[8], const bf16x8 (&Cf)[4], const float (&lr)[4], const float (&li)[4],
                                         float (&hr)[4], float (&hi)[4], const float (&dskip)[4]) {
    const int lane = C.lane, c16 = lane & 15, q = lane >> 4, w = C.wave;
    const bf16* US = WSP(bf16, WS_US);
    LAS unsigned* Hs = (LAS unsigned*)(C.lds + SSM_HS_OFF + w * (16 * HS * 2));
    const size_t row0 = (size_t)(b * SEQ + 512 * w + 128 * (c16 >> 2) + (c16 & 3));
    const bf16* uptr = US + row0 * 1024 + g * 16 + 8 * (q & 1);
    const bf16* qptr = US + row0 * 1024 + g * 16 + 4 * q;
    constexpr int PG = 4;
    bf16x8 An[PG]; u32x2 un[PG];
#pragma unroll
    for (int i = 0; i < PG; ++i) { An[i] = *(const bf16x8*)(uptr + (size_t)i * 4096); un[i] = FINAL ? *(const u32x2*)(qptr + (size_t)i * 4096) : (u32x2){0u, 0u}; }
#pragma unroll 1
    for (int sg = 0; sg < 32 / PG; ++sg) {
        bf16x8 Ac[PG]; u32x2 uc[PG];
#pragma unroll
        for (int i = 0; i < PG; ++i) { Ac[i] = An[i]; uc[i] = un[i]; }
        { const int sn = (sg + 1 < 32 / PG) ? sg + 1 : sg;
#pragma unroll
          for (int i = 0; i < PG; ++i) { An[i] = *(const bf16x8*)(uptr + (size_t)(PG * sn + i) * 4096); un[i] = FINAL ? *(const u32x2*)(qptr + (size_t)(PG * sn + i) * 4096) : (u32x2){0u, 0u}; } }
#pragma unroll
        for (int si = 0; si < PG; ++si) {
            bf16x8 Af = Ac[si];
            if (q >= 2) Af = (bf16x8){0, 0, 0, 0, 0, 0, 0, 0};
            f32x4 d[8];
#pragma unroll
            for (int nt = 0; nt < 8; ++nt) d[nt] = mfma16(Af, Bf[nt], (f32x4){0.f, 0.f, 0.f, 0.f});
#pragma unroll
            for (int i = 0; i < 4; ++i)
#pragma unroll
                for (int nt = 0; nt < 4; ++nt) {
                    const float tr = __builtin_fmaf(lr[nt], hr[nt], __builtin_fmaf(-li[nt], hi[nt], d[nt][i])); hi[nt] = __builtin_fmaf(lr[nt], hi[nt], __builtin_fmaf(li[nt], hr[nt], d[nt + 4][i])); hr[nt] = tr;
                    asm("" : "+v"(hr[nt]), "+v"(hi[nt]));
                    if (FINAL) Hs[(4 * q + i) * (HS / 2) + 16 * nt + c16] = cvtpk(hr[nt], hi[nt]);
                }
            if (FINAL) {
                LDS_WAIT(); asm volatile("" ::: "memory");
                f32x4 y = {0.f, 0.f, 0.f, 0.f};
#pragma unroll
                for (int ks = 0; ks < 4; ++ks) { const bf16x8 hb = *(const LAS bf16x8*)((const LAS unsigned char*)Hs + c16 * (HS * 2) + (32 * ks + 8 * q) * 2); y = mfma16(Cf[ks], hb, y); }
                const u32x2 uq = uc[si];
                const float o0 = gelu_tanh(y[0] + dskip[0] * bflo(uq.x)), o1 = gelu_tanh(y[1] + dskip[1] * bfhi(uq.x));
                const float o2 = gelu_tanh(y[2] + dskip[2] * bflo(uq.y)), o3 = gelu_tanh(y[3] + dskip[3] * bfhi(uq.y));
                u32x2 ov; ov.x = cvtpk(o0, o1); ov.y = cvtpk(o2, o3);
                *(u32x2*)(WSP(bf16, WS_H) + (row0 + (size_t)(4 * (PG * sg + si))) * 1024 + g * 16 + 4 * q) = ov;
                LDS_WAIT(); asm volatile("" ::: "memory");
            }
        }
    }
}

__device__ __forceinline__ void ssm_item(const Ctx& C, int item) {
    const int lane = C.lane, c16 = lane & 15, q = lane >> 4, w = C.wave;
    const int g = item & 63, b = item >> 6;
    if (DBGT >= 40 && C.bid == 0 && C.tid == 0) { volatile LAS unsigned long long* TSX = (volatile LAS unsigned long long*)(C.lds + RING_BYTES + 1024); TSX[47] = __builtin_amdgcn_s_memrealtime(); }
    const float* a_re = inp(C, 12); const float* a_im = inp(C, 13); const float* log_dt = inp(C, 14);
    const float* b_re = inp(C, 15); const float* b_im = inp(C, 16); const float* c_re = inp(C, 17); const float* c_im = inp(C, 18); const float* dsk = inp(C, 19);
    LAS f32x2v* EL = (LAS f32x2v*)(C.lds + SSM_EL_OFF); LAS bf16x8* SH = (LAS bf16x8*)(C.lds + SSM_SH_OFF);
    const float ldt = log_dt[g];
    float ar[4], ai[4];
#pragma unroll
    for (int nt = 0; nt < 4; ++nt) { ar[nt] = a_re[g * 64 + 16 * nt + c16]; ai[nt] = a_im[g * 64 + 16 * nt + c16]; }
    const int ntw = w & 3, ps = g * 64 + 16 * ntw + c16;
    f32x4 r0 = {0.f, 0.f, 0.f, 0.f}, r1 = r0, i0 = r0, i1 = r0;
    if (q < 2) { r0 = *(const f32x4*)(b_re + (size_t)ps * 16 + 8 * q); r1 = *(const f32x4*)(b_re + (size_t)ps * 16 + 8 * q + 4);
                 i0 = *(const f32x4*)(b_im + (size_t)ps * 16 + 8 * q); i1 = *(const f32x4*)(b_im + (size_t)ps * 16 + 8 * q + 4); }
    f32x4 vr = {0.f, 0.f, 0.f, 0.f}, vi = vr;
    if (w < 4) { const size_t o = (size_t)(g * 16 + c16) * 64 + 16 * w + 4 * q; vr = *(const f32x4*)(c_re + o); vi = *(const f32x4*)(c_im + o); }
    const f32x4 dv = *(const f32x4*)(dsk + g * 16 + 4 * q);
    const float dt = __expf(ldt);
    float lr[4], li[4], fr[4], fi[4];
#pragma unroll
    for (int nt = 0; nt < 4; ++nt) {
        const float mag = __expf(ar[nt] * dt); lr[nt] = mag * __cosf(ai[nt] * dt); li[nt] = mag * __sinf(ai[nt] * dt);
        const float den = ar[nt] * ar[nt] + ai[nt] * ai[nt], nr = lr[nt] - 1.f, ni = li[nt];
        fr[nt] = (nr * ar[nt] + ni * ai[nt]) / den; fi[nt] = (ni * ar[nt] - nr * ai[nt]) / den;
    }
    {
        float frw = fr[0], fiw = fi[0];
#pragma unroll
        for (int nt = 1; nt < 4; ++nt) if (ntw == nt) { frw = fr[nt]; fiw = fi[nt]; }
        const float ca = (w >= 4) ? fiw : frw, cb = (w >= 4) ? frw : -fiw;
        bf16x8 f = pack8(ca * r0.x + cb * i0.x, ca * r0.y + cb * i0.y, ca * r0.z + cb * i0.z, ca * r0.w + cb * i0.w, ca * r1.x + cb * i1.x, ca * r1.y + cb * i1.y, ca * r1.z + cb * i1.z, ca * r1.w + cb * i1.w);
        if (q >= 2) f = (bf16x8){0, 0, 0, 0, 0, 0, 0, 0};
        SH[w * 64 + lane] = f;
        if (w < 4) SH[(8 + w) * 64 + lane] = pack8(vr.x, -vi.x, vr.y, -vi.y, vr.z, -vi.z, vr.w, -vi.w);
    }
    __syncthreads();
    bf16x8 Bf[8], Cf[4];
#pragma unroll
    for (int nt = 0; nt < 8; ++nt) Bf[nt] = SH[nt * 64 + lane];
#pragma unroll
    for (int ks = 0; ks < 4; ++ks) Cf[ks] = SH[(8 + ks) * 64 + lane];
    const float dskip[4] = {dv.x, dv.y, dv.z, dv.w};
    float hr[4] = {0.f, 0.f, 0.f, 0.f}, hi[4] = {0.f, 0.f, 0.f, 0.f};
    if (DBGT >= 40 && C.bid == 0 && C.tid == 0) { volatile LAS unsigned long long* TSX = (volatile LAS unsigned long long*)(C.lds + RING_BYTES + 1024); const unsigned long long tn = __builtin_amdgcn_s_memrealtime(); TSX[42] += tn - TSX[47]; TSX[47] = tn; }
    ssm_pass<false>(C, b, g, Bf, Cf, lr, li, hr, hi, dskip);
    if (DBGT >= 40 && C.bid == 0 && C.tid == 0) { volatile LAS unsigned long long* TSX = (volatile LAS unsigned long long*)(C.lds + RING_BYTES + 1024); const unsigned long long tn = __builtin_amdgcn_s_memrealtime(); TSX[43] += tn - TSX[47]; TSX[47] = tn; }
    const int sc = 4 * w + q;
#pragma unroll
    for (int nt = 0; nt < 4; ++nt) EL[sc * 64 + 16 * nt + c16] = (f32x2v){hr[nt], hi[nt]};
    __syncthreads();
    {
        float Lr[4], Li[4];
#pragma unroll
        for (int nt = 0; nt < 4; ++nt) { Lr[nt] = lr[nt]; Li[nt] = li[nt];
#pragma unroll
            for (int s = 0; s < 7; ++s) { const float t = Lr[nt] * Lr[nt] - Li[nt] * Li[nt]; Li[nt] = 2.f * Lr[nt] * Li[nt]; Lr[nt] = t; } }
#pragma unroll
        for (int nt = 0; nt < 4; ++nt) { hr[nt] = 0.f; hi[nt] = 0.f; }
        for (int cc = 0; cc < 31; ++cc) {
            if (cc < sc) {
#pragma unroll
                for (int nt = 0; nt < 4; ++nt) { const f32x2v e = EL[cc * 64 + 16 * nt + c16];
                    const float t = Lr[nt] * hr[nt] - Li[nt] * hi[nt] + e.x; hi[nt] = Lr[nt] * hi[nt] + Li[nt] * hr[nt] + e.y; hr[nt] = t; }
            }
        }
    }
    if (DBGT >= 40 && C.bid == 0 && C.tid == 0) { volatile LAS unsigned long long* TSX = (volatile LAS unsigned long long*)(C.lds + RING_BYTES + 1024); const unsigned long long tn = __builtin_amdgcn_s_memrealtime(); TSX[44] += tn - TSX[47]; TSX[47] = tn; }
    ssm_pass<true>(C, b, g, Bf, Cf, lr, li, hr, hi, dskip);
    asm volatile("s_waitcnt vmcnt(0)" ::: "memory");
    __syncthreads();
    counter_signal(C, CW_SSM);
    if (DBGT >= 40 && C.bid == 0 && C.tid == 0) { volatile LAS unsigned long long* TSX = (volatile LAS unsigned long long*)(C.lds + RING_BYTES + 1024); const unsigned long long tn = __builtin_amdgcn_s_memrealtime(); TSX[45] += tn - TSX[47]; TSX[47] = tn; }
}

__device__ __forceinline__ void compress_item(const Ctx& C, int item) {
    const int lane = C.lane, w = C.wave, c16 = lane & 15, q = lane >> 4, tid = C.tid;
    const int ntp = item & 7, g = (item >> 3) & 3, b = (item >> 5) & 3, kv = item >> 7;
    const bf16* SRC = kv ? WSP(bf16, WS_VCI) : WSP(bf16, WS_KCI);
    const bf16* W1 = kv ? WSP(bf16, WS_WV1) : WSP(bf16, WS_WK1);
    const bf16* W2 = kv ? WSP(bf16, WS_WV2) : WSP(bf16, WS_WK2);
    const float* bp = WSP(float, WS_BP) + kv * 128;
    LAS bf16* Hid = (LAS bf16*)C.lds;
    LAS unsigned char* As = C.lds + 8960;
    {
        const bf16* src = SRC + ((size_t)((b * 4 + g) * 4096) << 6);
#pragma unroll
        for (int i = 0; i < 9; ++i) {
            const int id = tid + 512 * i;
            if (id < 528 * 8) { const int r = id >> 3, cc = id & 7; int tok = 512 * ntp + r; tok = tok > SEQ - 1 ? SEQ - 1 : tok;
                *(LAS v4u*)(As + r * 128 + ((cc ^ ((r >> 4) & 7)) << 4)) = *(const v4u*)(src + (size_t)tok * 64 + cc * 8); }
        }
    }
    const bf16* brow = W1 + (size_t)(16 * w + c16) * 2048 + 8 * q;
    f32x4 acc0 = {0.f, 0.f, 0.f, 0.f}, acc1 = acc0;
    __syncthreads();
#pragma unroll 1
    for (int kb = 0; kb < 2; ++kb) {
        bf16x8 bb[32];
#pragma unroll
        for (int k2 = 0; k2 < 32; ++k2) bb[k2] = *(const bf16x8*)(brow + 32 * (32 * kb + k2));
#pragma unroll
        for (int k2 = 0; k2 < 32; ++k2) {
            const int ks = 32 * kb + k2, cc = 4 * (ks & 1) + q;
            const int r0 = 16 * c16 + (ks >> 1), r1 = r0 + 256;
            const bf16x8 a0 = *(const LAS bf16x8*)(As + r0 * 128 + ((cc ^ ((r0 >> 4) & 7)) << 4));
            const bf16x8 a1 = *(const LAS bf16x8*)(As + r1 * 128 + ((cc ^ ((r1 >> 4) & 7)) << 4));
            acc0 = mfma16(a0, bb[k2], acc0); acc1 = mfma16(a1, bb[k2], acc1);
        }
    }
    { const float bias = bp[16 * w + c16];
#pragma unroll
      for (int i = 0; i < 4; ++i) { Hid[(4 * q + i) * HS + 16 * w + c16] = (bf16)(cvtpk(gelu_tanh(acc0[i] + bias), 0.f) & 0xffffu);
                                    Hid[(16 + 4 * q + i) * HS + 16 * w + c16] = (bf16)(cvtpk(gelu_tanh(acc1[i] + bias), 0.f) & 0xffffu); } }
    __syncthreads();
    {
        const int rt = w >> 2, ct = w & 3;
        f32x4 o = {0.f, 0.f, 0.f, 0.f};
#pragma unroll
        for (int ks = 0; ks < 4; ++ks) {
            const bf16x8 a = *(const LAS bf16x8*)(Hid + (16 * rt + c16) * HS + 32 * ks + 8 * q);
            const bf16x8 bb = *(const bf16x8*)(W2 + (size_t)(16 * ct + c16) * 128 + 32 * ks + 8 * q);
            o = mfma16(a, bb, o);
        }
        const int dim = 16 * ct + c16, n0 = 32 * ntp + 16 * rt + 4 * q;
        float ov[4];
#pragma unroll
        for (int i = 0; i < 4; ++i) ov[i] = (n0 + i < 255) ? o[i] : 0.f;
        if (kv == 0) {
            bf16* kc = WSP(bf16, WS_KC) + (size_t)((b * 4 + g) * 256) * 64;
#pragma unroll
            for (int i = 0; i < 4; ++i) kc[(size_t)(n0 + i) * 64 + dim] = (bf16)(cvtpk(ov[i], 0.f) & 0xffffu);
        } else {
            bf16* vc = WSP(bf16, WS_VCT) + (size_t)((b * 4 + g) * 64 + dim) * 256 + n0;
            u32x2 wv; wv.x = cvtpk(ov[0], ov[1]); wv.y = cvtpk(ov[2], ov[3]); *(u32x2*)vc = wv;
        }
    }
    asm volatile("s_waitcnt vmcnt(0)" ::: "memory");
    __syncthreads();
    counter_signal(C, CW_CMP + 16 * (b * 4 + g));
}

constexpr int A_KC = 0, A_VCT = 36864;
constexpr int A_OS = 0;
constexpr int A_IMP = 70656, A_QS = 70656;
constexpr int A_KB = 107520, A_VB = 125952;
constexpr int A_ML = 144384;
#ifndef NOLOCK
#define NOLOCK 0
#endif
constexpr int A_LOCK = RING_BYTES + 768, A_TKT = RING_BYTES + 776;
constexpr int A_LUT = 152576, A_SEL = A_LUT + 2112, A_END = A_SEL + 512;
static_assert(A_ML + 8192 <= A_LUT && A_END <= RING_BYTES, "attention LDS map");
constexpr int KROW = 144, VCROW = 528, VROW = 144, KBUF = 64 * KROW, VBUF = 64 * VROW, LUTS = 132, OSROW = 272;
constexpr float NEG_BIG = -1e30f, LOG2E = 1.4426950408889634f;
#define NEG_INF (-__builtin_inff())

__device__ __forceinline__ float max16(const f32x4 (&s)[4]) {
    float a = fmaxf(fmaxf(s[0].x, s[0].y), fmaxf(s[0].z, s[0].w)), b = fmaxf(fmaxf(s[1].x, s[1].y), fmaxf(s[1].z, s[1].w));
    float c = fmaxf(fmaxf(s[2].x, s[2].y), fmaxf(s[2].z, s[2].w)), d = fmaxf(fmaxf(s[3].x, s[3].y), fmaxf(s[3].z, s[3].w));
    return fmaxf(fmaxf(a, b), fmaxf(c, d));
}

template <int MODE>
__device__ __forceinline__ void far_unit(LAS unsigned char* lds, const bf16x8 (&Kf)[4][2], const bf16x8 (&Vf)[2][4], const LAS float* lutx,
                                         int qi, int tqv, bool valid, int kpos0, float bfar, int q, int r, unsigned long long lockbits, bool lane0) {
    const bf16x8 q0 = *(const LAS bf16x8*)(lds + A_QS + qi * KROW + q * 16), q1 = *(const LAS bf16x8*)(lds + A_QS + qi * KROW + 64 + q * 16);
    LAS float* ml = (LAS float*)(lds + A_ML) + qi * 8;
    LAS float* os = (LAS float*)(lds + A_OS + qi * OSROW + q * 16);
    const float m_ref = ml[4];
    f32x4 s[4];
#pragma unroll
    for (int kt = 0; kt < 4; ++kt) { s[kt] = mfma16(Kf[kt][0], q0, (f32x4){0.f, 0.f, 0.f, 0.f}); s[kt] = mfma16(Kf[kt][1], q1, s[kt]); }
    float cadd = valid ? 0.f : NEG_INF;
    if (MODE == 0) cadd += bfar * LOG2E;
    else {
        const int dq = tqv - kpos0 - 4 * q;
#pragma unroll
        for (int kt = 0; kt < 4; ++kt)
#pragma unroll
            for (int i = 0; i < 4; ++i) { const int d = dq - 16 * kt - i; int dc = d < -1 ? -1 : d; dc = dc > 127 ? 127 : dc; s[kt][i] += lutx[r * LUTS + 1 + dc]; }
    }
    const float cc = cadd - m_ref * LOG2E;
    float ps = 0.f;
#pragma unroll
    for (int kt = 0; kt < 4; ++kt)
#pragma unroll
        for (int i = 0; i < 4; ++i) { const float e = __builtin_amdgcn_exp2f(fminf(__builtin_fmaf(s[kt][i], LOG2E, cc), 80.f)); s[kt][i] = e; ps += e; }
    f32x4 O[4];
#pragma unroll
    for (int mt = 0; mt < 4; ++mt) O[mt] = (f32x4){0.f, 0.f, 0.f, 0.f};
#pragma unroll
    for (int u = 0; u < 2; ++u) {
        const bf16x8 Pf = pack8(s[2 * u][0], s[2 * u][1], s[2 * u][2], s[2 * u][3], s[2 * u + 1][0], s[2 * u + 1][1], s[2 * u + 1][2], s[2 * u + 1][3]);
#pragma unroll
        for (int mt = 0; mt < 4; ++mt) O[mt] = mfma16(Vf[u][mt], Pf, O[mt]);
    }
    LAS unsigned long long* lockw = (LAS unsigned long long*)(lds + A_LOCK);
    asm volatile("" :: "v"(O[0]), "v"(O[1]), "v"(O[2]), "v"(O[3]), "v"(ps) : "memory");
    if (!NOLOCK) {
        unsigned long long old = 0ull;
        if (lane0) old = __hip_atomic_fetch_or(lockw, lockbits, __ATOMIC_ACQUIRE, __HIP_MEMORY_SCOPE_WORKGROUP);
        unsigned long long olds = ((unsigned long long)(unsigned)__builtin_amdgcn_readfirstlane((int)(unsigned)(old >> 32)) << 32) | (unsigned)__builtin_amdgcn_readfirstlane((int)(unsigned)old);
        if (olds & lockbits) {
            const unsigned long long mine = lockbits & ~olds;
            if (mine != 0ull && lane0) __hip_atomic_fetch_and(lockw, ~mine, __ATOMIC_RELAXED, __HIP_MEMORY_SCOPE_WORKGROUP);
            unsigned long long guess = olds & ~lockbits;
#pragma unroll 1
            for (;;) {
                __builtin_amdgcn_s_sleep(1);
                old = guess;
                if (lane0) __hip_atomic_compare_exchange_strong(lockw, &old, guess | lockbits, __ATOMIC_ACQUIRE, __ATOMIC_RELAXED, __HIP_MEMORY_SCOPE_WORKGROUP);
                olds = ((unsigned long long)(unsigned)__builtin_amdgcn_readfirstlane((int)(unsigned)(old >> 32)) << 32) | (unsigned)__builtin_amdgcn_readfirstlane((int)(unsigned)old);
                if (olds == guess) break;
                guess = olds & ~lockbits;
            }
        }
    }
    asm volatile("" ::: "memory");
    if (valid) {
        LAS f32x4* p = (LAS f32x4*)os;
        const f32x4 c0 = p[0], c1 = p[4], c2 = p[8], c3 = p[12]; const float lq = ml[q];
        p[0] = c0 + O[0]; p[4] = c1 + O[1]; p[8] = c2 + O[2]; p[12] = c3 + O[3]; ml[q] = lq + ps;
    }
    LDS_WAIT(); asm volatile("" ::: "memory");
    if (!NOLOCK && lane0) __hip_atomic_fetch_and(lockw, ~lockbits, __ATOMIC_RELEASE, __HIP_MEMORY_SCOPE_WORKGROUP);
}

struct AttnState { float m[2], l[2]; f32x4 O[2][4]; };
constexpr float RESCALE_THR = 8.f;
template <int MODE>
__device__ __forceinline__ void attn_block2(AttnState& S, const LAS unsigned char* kb, const LAS unsigned char* vb, const LAS float* lutx, const bf16x8 (&Qf)[2][2],
                                           const int (&tq)[2], int kpos0, bool on0, bool on1, bool act0, bool act1, float bfar, int c16, int q, int r) {
    bf16x8 Kf[4][2], Vf[2][4];
#pragma unroll
    for (int kt = 0; kt < 4; ++kt)
#pragma unroll
        for (int ks = 0; ks < 2; ++ks) Kf[kt][ks] = *(const LAS bf16x8*)(kb + (16 * kt + c16) * KROW + ks * 64 + q * 16);
#pragma unroll
    for (int u = 0; u < 2; ++u)
#pragma unroll
        for (int mt = 0; mt < 4; ++mt) Vf[u][mt] = *(const LAS bf16x8*)(vb + (16 * mt + c16) * VROW + 64 * u + 16 * q);
    f32x4 s[2][4];
#pragma unroll
    for (int ct = 0; ct < 2; ++ct) {
        if (!(ct ? act1 : act0)) continue;
#pragma unroll
        for (int kt = 0; kt < 4; ++kt) {
            s[ct][kt] = mfma16(Kf[kt][0], Qf[ct][0], (f32x4){0.f, 0.f, 0.f, 0.f});
            s[ct][kt] = mfma16(Kf[kt][1], Qf[ct][1], s[ct][kt]);
        }
    }
#pragma unroll
    for (int ct = 0; ct < 2; ++ct) {
        const bool act = ct ? act1 : act0; const bool on = ct ? on1 : on0;
        if (!act) continue;
        float cadd, mx;
        if (MODE == 0) {
            const float bl = on ? bfar : NEG_INF;
            mx = max16(s[ct]) + bl; cadd = bl * LOG2E;
        } else {
            const int dq = tq[ct] - kpos0 - 4 * q;
            const float offb = on ? 0.f : NEG_INF;
#pragma unroll
            for (int kt = 0; kt < 4; ++kt)
#pragma unroll
                for (int i = 0; i < 4; ++i) {
                    const int d = dq - 16 * kt - i;
                    if (MODE == 1) { int dc = d < -1 ? -1 : d; dc = dc > 127 ? 127 : dc; s[ct][kt][i] += lutx[r * LUTS + 1 + dc] + offb; }
                    else s[ct][kt][i] = d < 512 ? s[ct][kt][i] + bfar : NEG_INF;
                }
            mx = max16(s[ct]); cadd = 0.f;
        }
        mx = xq_max(mx);
        if (__any(mx > S.m[ct] + RESCALE_THR)) {
            const float mn = fmaxf(S.m[ct], mx), alpha = __builtin_amdgcn_exp2f((S.m[ct] - mn) * LOG2E);
            S.m[ct] = mn; S.l[ct] *= alpha;
#pragma unroll
            for (int mt = 0; mt < 4; ++mt) S.O[ct][mt] = S.O[ct][mt] * alpha;
        }
        const float cc = cadd - S.m[ct] * LOG2E;
        float ps = 0.f;
#pragma unroll
        for (int kt = 0; kt < 4; ++kt)
#pragma unroll
            for (int i = 0; i < 4; ++i) { const float e = __builtin_amdgcn_exp2f(__builtin_fmaf(s[ct][kt][i], LOG2E, cc)); s[ct][kt][i] = e; ps += e; }
        S.l[ct] += ps;
#pragma unroll
        for (int u = 0; u < 2; ++u) {
            const bf16x8 Pf = pack8(s[ct][2 * u][0], s[ct][2 * u][1], s[ct][2 * u][2], s[ct][2 * u][3], s[ct][2 * u + 1][0], s[ct][2 * u + 1][1], s[ct][2 * u + 1][2], s[ct][2 * u + 1][3]);
#pragma unroll
            for (int mt = 0; mt < 4; ++mt) S.O[ct][mt] = mfma16(Vf[u][mt], Pf, S.O[ct][mt]);
        }
    }
}

__device__ __forceinline__ void vt_store(LAS unsigned char* rowp, int k0, v4u v) {
    const int u = k0 >> 5, kk = k0 & 31, qq = (kk & 15) >> 2, hh = kk >> 4;
    LAS unsigned char* p = rowp + (32 * u + 8 * qq + 4 * hh) * 2;
    u32x2 a; a.x = v.x; a.y = v.y; u32x2 bq; bq.x = v.z; bq.y = v.w;
    *(LAS u32x2*)p = a; *(LAS u32x2*)(p + 16) = bq;
}

__device__ __forceinline__ int nth_bit(unsigned long long m, int k) { for (int i = 0; i < k; ++i) m &= m - 1ull; return __builtin_ctzll(m); }

__device__ __forceinline__ void attn_item(const Ctx& C, int b, int g, int cur) {
    LAS unsigned char* lds = C.lds;
    int lane_ = C.lane; asm volatile("" : "+v"(lane_));
    const int lane = lane_, w = C.wave, tid = w * 64 + lane, c16 = lane & 15, q = lane >> 4, r = c16 & 3;
    const int t0 = cur * 64;
    const bf16* Qg = WSP(bf16, WS_Q); const bf16* NGB = WSP(bf16, WS_NGB); const bf16* ZA = WSP(bf16, WS_ZA);
    LAS float* lutx = (LAS float*)(lds + A_LUT); LAS float* imp = (LAS float*)(lds + A_IMP);
    LAS unsigned long long* selm = (LAS unsigned long long*)(lds + A_SEL);
    const int srow = tid >> 3, scc = tid & 7, kdst = A_KB + srow * KROW + scc * 16, vdst = A_VB + srow * VROW + scc * 16;
    counter_wait(C, CW_CMP + 16 * (b * 4 + g), 16u);
    {
        const bf16* kcg = WSP(bf16, WS_KC) + (size_t)((b * 4 + g) * 256) * 64;
        const bf16* vcg = WSP(bf16, WS_VCT) + (size_t)((b * 4 + g) * 64) * 256;
#pragma unroll
        for (int i = 0; i < 4; ++i) {
            const int id = tid + 512 * i;
            { const int row = id >> 3, cc = id & 7; *(LAS v4u*)(lds + A_KC + row * KROW + cc * 16) = *(const v4u*)(kcg + row * 64 + cc * 8); }
            { const int dim = id >> 5, kc = id & 31; vt_store(lds + A_VCT + dim * VCROW, 8 * kc, *(const v4u*)(vcg + dim * 256 + kc * 8)); }
        }
        lutx[(tid >> 7) * LUTS + 1 + (tid & 127)] = WSP(float, WS_LUT)[(g * 4 + (tid >> 7)) * 128 + (tid & 127)];
        if (tid < 4) lutx[tid * LUTS] = NEG_INF;
        *(LAS v4u*)(lds + kdst) = *(const v4u*)(WSP(bf16, WS_KS) + ((size_t)((b * 4 + g) * 4096 + srow) << 6) + scc * 8);
        *(LAS v4u*)(lds + vdst) = *(const v4u*)(WSP(bf16, WS_VST) + ((size_t)((b * 4 + g) * 64) << 12) + srow * 64 + scc * 8);
    }
    bf16x8 Qf[2][2]; int tq[2];
#pragma unroll
    for (int ct = 0; ct < 2; ++ct) {
        tq[ct] = t0 + 8 * w + 4 * ct + (c16 >> 2);
        const size_t row = (size_t)(b * SEQ + tq[ct]);
#pragma unroll
        for (int ks = 0; ks < 2; ++ks) Qf[ct][ks] = *(const bf16x8*)(Qg + row * 1024 + (g * 4 + r) * 64 + 32 * ks + 8 * q);
    }
    unsigned gpk[2][2];
#pragma unroll
    for (int ct = 0; ct < 2; ++ct) { const bf16* gp = NGB + (size_t)(b * SEQ + tq[ct]) * 64 + (g * 4 + r) * 3;
        gpk[ct][0] = (unsigned)gp[0] | ((unsigned)gp[1] << 16); gpk[ct][1] = (unsigned)gp[2]; }
#define GATE(ct, br) ((DBG == 4 + (br)) ? 0.f : ((br) == 0 ? bflo(gpk[ct][0]) : ((br) == 1 ? bfhi(gpk[ct][0]) : bflo(gpk[ct][1]))))
    const float bfar = WSP(float, WS_LUT)[(g * 4 + r) * 128 + 127];
    f32x4 Ot[2][4];
    __syncthreads();
    const int nch = (4 * cur + 3 + 31) >> 5;
    {
        float mA[2] = {NEG_BIG, NEG_BIG}, lA[2] = {0.f, 0.f};
#define CMP_PASS1(kt, FARB) do { \
            const bf16x8 k0 = *(const LAS bf16x8*)(lds + A_KC + (16 * (kt) + c16) * KROW + q * 16), k1 = *(const LAS bf16x8*)(lds + A_KC + (16 * (kt) + c16) * KROW + 64 + q * 16); \
            _Pragma("unroll") for (int ct = 0; ct < 2; ++ct) { \
                f32x4 s = mfma16(k0, Qf[ct][0], (f32x4){0.f, 0.f, 0.f, 0.f}); s = mfma16(k1, Qf[ct][1], s); \
                if (FARB) { s[0] += bfar; s[1] += bfar; s[2] += bfar; s[3] += bfar; } \
                else { const int dq = tq[ct] - 31 - 64 * q - 256 * (kt); \
                    _Pragma("unroll") for (int i = 0; i < 4; ++i) { int dc = dq - 16 * i; dc = dc < -1 ? -1 : dc; dc = dc > 127 ? 127 : dc; s[i] += lutx[r * LUTS + 1 + dc]; } } \
                const float mx = fmaxf(fmaxf(s[0], s[1]), fmaxf(s[2], s[3])); \
                const float mn = fmaxf(mA[ct], mx); const float cc = -mn * LOG2E; \
                const float ps = (__builtin_amdgcn_exp2f(__builtin_fmaf(s[0], LOG2E, cc)) + __builtin_amdgcn_exp2f(__builtin_fmaf(s[1], LOG2E, cc))) + \
                                 (__builtin_amdgcn_exp2f(__builtin_fmaf(s[2], LOG2E, cc)) + __builtin_amdgcn_exp2f(__builtin_fmaf(s[3], LOG2E, cc))); \
                lA[ct] = lA[ct] * __builtin_amdgcn_exp2f((mA[ct] - mn) * LOG2E) + ps; mA[ct] = mn; } } while (0)
        const int tqmin = t0 + 8 * w;
        int kfar = tqmin >= 142 ? (tqmin - 142) >> 8 : 0; kfar = kfar < 2 * nch ? kfar : 2 * nch; kfar &= ~1;
#pragma unroll 1
        for (int kt = 0; kt < kfar; kt += 2) { CMP_PASS1(kt, true); CMP_PASS1(kt + 1, true); }
#pragma unroll 1
        for (int kt = kfar; kt < 2 * nch; kt += 2) { CMP_PASS1(kt, false); CMP_PASS1(kt + 1, false); }
#undef CMP_PASS1
        float Mc[2], invL[2];
#pragma unroll
        for (int ct = 0; ct < 2; ++ct) {
            const float mm = xq_max(mA[ct]);
            const float ll = xq_sum(lA[ct] * __builtin_amdgcn_exp2f((mA[ct] - mm) * LOG2E));
            Mc[ct] = -mm * LOG2E; invL[ct] = ll > 0.f ? 1.f / ll : 0.f;
        }
        f32x4 Oc[2][4];
#pragma unroll
        for (int ct = 0; ct < 2; ++ct)
#pragma unroll
            for (int mt = 0; mt < 4; ++mt) Oc[ct][mt] = (f32x4){0.f, 0.f, 0.f, 0.f};
        float carry[2] = {0.f, 0.f};
#define CMP_PASS2(u, FARB) do { \
            float p[2][2][4]; \
            _Pragma("unroll") for (int hf = 0; hf < 2; ++hf) { \
                const int kt = 2 * (u) + hf; \
                const bf16x8 k0 = *(const LAS bf16x8*)(lds + A_KC + (16 * kt + c16) * KROW + q * 16), k1 = *(const LAS bf16x8*)(lds + A_KC + (16 * kt + c16) * KROW + 64 + q * 16); \
                _Pragma("unroll") for (int ct = 0; ct < 2; ++ct) { \
                    f32x4 s = mfma16(k0, Qf[ct][0], (f32x4){0.f, 0.f, 0.f, 0.f}); s = mfma16(k1, Qf[ct][1], s); \
                    const int dq = tq[ct] - 31 - 64 * q - 256 * kt; \
                    float own = 0.f; \
                    _Pragma("unroll") for (int i = 0; i < 4; ++i) { float bi_; \
                        if (FARB) bi_ = bfar; else { int dc = dq - 16 * i; dc = dc < -1 ? -1 : dc; dc = dc > 127 ? 127 : dc; bi_ = lutx[r * LUTS + 1 + dc]; } \
                        const float e = __builtin_amdgcn_exp2f(__builtin_fmaf(s[i] + bi_, LOG2E, Mc[ct])) * invL[ct]; p[ct][hf][i] = e; own += e; } \
                      \
                    float ra, rb; \
                    { auto s16 = __builtin_amdgcn_permlane16_swap(__builtin_bit_cast(unsigned, p[ct][hf][3]), __builtin_bit_cast(unsigned, p[ct][hf][3]), false, false); \
                      const unsigned x16 = (q & 1) ? (unsigned)s16[0] : (unsigned)s16[1]; \
                      ra = __builtin_bit_cast(float, x16); \
                      auto s32 = __builtin_amdgcn_permlane32_swap(x16, x16, false, false); \
                      rb = __builtin_bit_cast(float, (q & 2) ? (unsigned)s32[0] : (unsigned)s32[1]); } \
                    const float prev3 = (q & 1) ? ra : (q == 2 ? rb : carry[ct]); carry[ct] = rb; \
                    float v = own + prev3; v += dppf<DPP_XOR1>(v); v += dppf<DPP_XOR2>(v); \
                    if (r == 0) imp[(8 * w + 4 * ct + (c16 >> 2)) * 64 + 4 * kt + q] = v; \
                } \
            } \
            bf16x8 Pf[2]; \
            _Pragma("unroll") for (int ct = 0; ct < 2; ++ct) Pf[ct] = pack8(p[ct][0][0], p[ct][0][1], p[ct][0][2], p[ct][0][3], p[ct][1][0], p[ct][1][1], p[ct][1][2], p[ct][1][3]); \
            _Pragma("unroll") for (int mt = 0; mt < 4; ++mt) { \
                const bf16x8 a = *(const LAS bf16x8*)(lds + A_VCT + (16 * mt + c16) * VCROW + 64 * (u) + 16 * q); \
                _Pragma("unroll") for (int ct = 0; ct < 2; ++ct) Oc[ct][mt] = mfma16(a, Pf[ct], Oc[ct][mt]); \
            } } while (0)
#pragma unroll 1
        for (int u = 0; u < (kfar >> 1); ++u) CMP_PASS2(u, true);
#pragma unroll 1
        for (int u = (kfar >> 1); u < nch; ++u) CMP_PASS2(u, false);
#undef CMP_PASS2
#pragma unroll
        for (int ct = 0; ct < 2; ++ct)
#pragma unroll
            for (int mt = 0; mt < 4; ++mt) Ot[ct][mt] = Oc[ct][mt] * GATE(ct, 0);
    }
    LDS_WAIT(); asm volatile("" ::: "memory");
    {
        const int ts = lane >> 3, sub = lane & 7;
        unsigned long long mask;
        if (cur <= 7) mask = (2ull << cur) - 1ull;
        else {
            float v[8];
#pragma unroll
            for (int i = 0; i < 8; ++i) { const int j = sub * 8 + i; v[i] = (j >= 1 && j <= cur - 2) ? imp[(8 * w + ts) * 64 + j] : -3e38f; }
            mask = 1ull | (1ull << cur) | (1ull << (cur - 1));
#pragma unroll 1
            for (int rd = 0; rd < 5; ++rd) {
                float best = v[0]; int bi = 0;
#pragma unroll
                for (int i = 1; i < 8; ++i) if (v[i] > best) { best = v[i]; bi = i; }
                int bj = sub * 8 + bi;
#pragma unroll
                for (int st = 0; st < 3; ++st) {
                    const float ov = st == 0 ? dppf<DPP_XOR1>(best) : (st == 1 ? dppf<DPP_XOR2>(best) : dppf<DPP_HMIRROR>(best));
                    const int oj = st == 0 ? dppi<DPP_XOR1>(bj) : (st == 1 ? dppi<DPP_XOR2>(bj) : dppi<DPP_HMIRROR>(bj));
                    if (ov > best || (ov == best && oj < bj)) { best = ov; bj = oj; } }
                mask |= 1ull << bj;
#pragma unroll
                for (int i = 0; i < 8; ++i) if (bj == sub * 8 + i) v[i] = -3e38f;
            }
        }
        if (sub == 0) selm[8 * w + ts] = mask;
    }
    LDS_WAIT(); asm volatile("" ::: "memory");
    __syncthreads();
#pragma unroll
    for (int ct = 0; ct < 2; ++ct) {
        const int qi = (8 * w + 4 * ct + (c16 >> 2)) * 4 + r;
        *(LAS bf16x8*)(lds + A_QS + qi * KROW + q * 16) = Qf[ct][0]; *(LAS bf16x8*)(lds + A_QS + qi * KROW + 64 + q * 16) = Qf[ct][1];
#pragma unroll
        for (int mt = 0; mt < 4; ++mt) *(LAS f32x4*)(lds + A_OS + qi * OSROW + q * 16 + 64 * mt) = (f32x4){0.f, 0.f, 0.f, 0.f};
        ((LAS float*)(lds + A_ML))[qi * 8 + q] = 0.f; if (q == 0) ((LAS float*)(lds + A_ML))[qi * 8 + 4] = NEG_BIG;
        if (q == 1) ((LAS float*)(lds + A_ML))[qi * 8 + 5] = GATE(ct, 1);
        if (q == 2) ((LAS float*)(lds + A_ML))[qi * 8 + 6] = GATE(ct, 2);
    }
    __syncthreads();
    {
        const int nd = cur + 1 < 3 ? cur + 1 : 3, jlo = cur >= 8 ? cur - 8 : 0, nw = cur - jlo + 1, ntot = nd + nw;
#define LIST_BLOCK(idx) ((idx) < nd ? ((idx) == 0 ? 0 : cur - (nd - 1 - (idx))) : jlo + (idx) - nd)
#define STAGE_FETCH(dk, dv, idx) do { const int brn_ = (idx) >= nd, jn_ = LIST_BLOCK(idx); \
            const bf16* Kg_ = brn_ ? WSP(bf16, WS_KW) : WSP(bf16, WS_KS); const bf16* Vg_ = brn_ ? WSP(bf16, WS_VWT) : WSP(bf16, WS_VST); \
            dk = *(const v4u*)(Kg_ + ((size_t)((b * 4 + g) * 4096 + 64 * jn_ + srow) << 6) + scc * 8); \
            dv = *(const v4u*)(Vg_ + ((size_t)((b * 4 + g) * 64 + jn_) << 12) + srow * 64 + scc * 8); } while (0)
        v4u ka = {0u, 0u, 0u, 0u}, va = ka;
        if (ntot > 1) STAGE_FETCH(ka, va, 1);
        AttnState S;
#pragma unroll
        for (int ct = 0; ct < 2; ++ct) { S.m[ct] = NEG_BIG; S.l[ct] = 0.f;
#pragma unroll
            for (int mt = 0; mt < 4; ++mt) S.O[ct][mt] = (f32x4){0.f, 0.f, 0.f, 0.f}; }
#pragma unroll 1
        for (int ib = 0; ib < nd; ++ib) {
            const int j = LIST_BLOCK(ib), bufo = (ib & 1);
            v4u kr = {0u, 0u, 0u, 0u}, vr = kr;
            if (ib + 2 <= nd && ib + 2 < ntot) STAGE_FETCH(kr, vr, ib + 2);
            const LAS unsigned char* kb = lds + A_KB + bufo * KBUF; const LAS unsigned char* vb = lds + A_VB + bufo * VBUF;
            if (cur - j <= 2) attn_block2<1>(S, kb, vb, lutx, Qf, tq, 64 * j, true, true, true, true, bfar, c16, q, r);
            else attn_block2<0>(S, kb, vb, lutx, Qf, tq, 64 * j, true, true, true, true, bfar, c16, q, r);
            if (ib + 1 < ntot) { *(LAS v4u*)(lds + kdst + (bufo ^ 1) * KBUF) = ka; *(LAS v4u*)(lds + vdst + (bufo ^ 1) * VBUF) = va; }
            ka = kr; va = vr;
            __syncthreads();
        }
#pragma unroll
        for (int ct = 0; ct < 2; ++ct) {
            const int qi = (8 * w + 4 * ct + (c16 >> 2)) * 4 + r;
#pragma unroll
            for (int mt = 0; mt < 4; ++mt) *(LAS f32x4*)(lds + A_OS + qi * OSROW + q * 16 + 64 * mt) = S.O[ct][mt];
            ((LAS float*)(lds + A_ML))[qi * 8 + q] = S.l[ct]; if (q == 0) ((LAS float*)(lds + A_ML))[qi * 8 + 4] = S.m[ct];
        }
        if (tid == 0) *(LAS unsigned*)(lds + A_TKT) = 0u;
        __syncthreads();
#pragma unroll 1
        for (;;) {
            int tk_ = 0;
            if (lane == 0) tk_ = (int)__hip_atomic_fetch_add((LAS unsigned*)(lds + A_TKT), 1u, __ATOMIC_RELAXED, __HIP_MEMORY_SCOPE_WORKGROUP);
            tk_ = __builtin_amdgcn_readfirstlane(tk_);
            const int nfar = cur - 2;
            if (tk_ >= 2 * nfar) break;
            const bool sweep2 = tk_ >= nfar;
            const int j = 1 + (sweep2 ? tk_ - nfar : tk_);
            const unsigned wj = ((const LAS unsigned*)(lds + A_SEL))[2 * lane + (j >> 5)];
            const unsigned long long amask = __ballot((wj >> (j & 31)) & 1u);
            const int na = __builtin_popcountll(amask), nu = (na + 3) >> 2;
            if (nu == 0 || (nu >= 2) == sweep2) continue;
            bf16x8 Kf[4][2], Vf[2][4];
            { const bf16* kg = WSP(bf16, WS_KS) + ((size_t)((b * 4 + g) * 4096 + 64 * j) << 6); const bf16* vg = WSP(bf16, WS_VST) + ((size_t)((b * 4 + g) * 64 + j) << 12);
#pragma unroll
              for (int kt = 0; kt < 4; ++kt)
#pragma unroll
                  for (int ks = 0; ks < 2; ++ks) Kf[kt][ks] = *(const bf16x8*)(kg + (16 * kt + c16) * 64 + ks * 32 + q * 8);
#pragma unroll
              for (int u = 0; u < 2; ++u)
#pragma unroll
                  for (int mt = 0; mt < 4; ++mt) Vf[u][mt] = *(const bf16x8*)(vg + (16 * mt + c16) * 64 + 32 * u + 8 * q); }
#pragma unroll 1
            for (int un = 0; un < nu; ++un) {
                int tk; bool valid; unsigned long long lockbits;
                if (amask == ~0ull) { tk = 4 * un + (c16 >> 2); valid = true; lockbits = 0xfull << (4 * un); }
                else { unsigned long long m = amask; for (int i = 0; i < 4 * un; ++i) m &= m - 1ull;
                    const int rem = na - 4 * un;
                    int t0s = __builtin_ctzll(m); m &= m - 1ull; int t1s = rem > 1 ? __builtin_ctzll(m) : t0s; if (rem > 1) m &= m - 1ull;
                    int t2s = rem > 2 ? __builtin_ctzll(m) : t0s; if (rem > 2) m &= m - 1ull; int t3s = rem > 3 ? __builtin_ctzll(m) : t0s;
                    lockbits = (1ull << t0s) | (1ull << t1s) | (1ull << t2s) | (1ull << t3s);
                    const int sl = c16 >> 2; tk = sl == 0 ? t0s : (sl == 1 ? t1s : (sl == 2 ? t2s : t3s)); valid = sl < rem; }
                const int qi = tk * 4 + r, tqv = t0 + tk;
                if (cur - j <= 2) far_unit<1>(lds, Kf, Vf, lutx, qi, tqv, valid, 64 * j, 0.f, q, r, lockbits, lane == 0);
                else far_unit<0>(lds, Kf, Vf, lutx, qi, tqv, valid, 64 * j, lutx[r * LUTS + 128], q, r, lockbits, lane == 0);
            }
        }
        if (nd + 1 < ntot) STAGE_FETCH(ka, va, nd + 1);
        LDS_WAIT(); asm volatile("" ::: "memory");
        __syncthreads();
        LAS f32x4* otl = (LAS f32x4*)(lds + A_OS + w * 8192) + lane;
#pragma unroll
        for (int ct = 0; ct < 2; ++ct) {
            const int qi = (8 * w + 4 * ct + (c16 >> 2)) * 4 + r;
            const LAS float* ml = (const LAS float*)(lds + A_ML) + qi * 8;
            const float L = xq_sum(ml[q]); const float inv = L > 0.f ? ml[5] / L : 0.f;
#pragma unroll
            for (int mt = 0; mt < 4; ++mt) Ot[ct][mt] += *(const LAS f32x4*)(lds + A_OS + qi * OSROW + q * 16 + 64 * mt) * inv;
        }
        __syncthreads();
#pragma unroll
        for (int ct = 0; ct < 2; ++ct)
#pragma unroll
            for (int mt = 0; mt < 4; ++mt) otl[(ct * 4 + mt) * 64] = Ot[ct][mt];
#pragma unroll
        for (int ct = 0; ct < 2; ++ct) { S.m[ct] = NEG_BIG; S.l[ct] = 0.f;
#pragma unroll
            for (int mt = 0; mt < 4; ++mt) S.O[ct][mt] = (f32x4){0.f, 0.f, 0.f, 0.f};
            const int qi = (8 * w + 4 * ct + (c16 >> 2)) * 4 + r;
            Qf[ct][0] = *(const LAS bf16x8*)(lds + A_QS + qi * KROW + q * 16); Qf[ct][1] = *(const LAS bf16x8*)(lds + A_QS + qi * KROW + 64 + q * 16); }
#pragma unroll 1
        for (int ib = nd; ib < ntot; ++ib) {
            const int j = LIST_BLOCK(ib), bufo = (ib & 1);
            v4u kr = {0u, 0u, 0u, 0u}, vr = kr;
            if (ib + 2 < ntot) STAGE_FETCH(kr, vr, ib + 2);
            const LAS unsigned char* kb = lds + A_KB + bufo * KBUF; const LAS unsigned char* vb = lds + A_VB + bufo * VBUF;
            const float bfw = lutx[r * LUTS + 128];
            if (cur - j <= 2) attn_block2<1>(S, kb, vb, lutx, Qf, tq, 64 * j, true, true, true, true, bfw, c16, q, r);
            else if (cur - j == 8) attn_block2<2>(S, kb, vb, lutx, Qf, tq, 64 * j, true, true, true, true, bfw, c16, q, r);
            else attn_block2<0>(S, kb, vb, lutx, Qf, tq, 64 * j, true, true, true, true, bfw, c16, q, r);
            if (ib + 1 < ntot) { *(LAS v4u*)(lds + kdst + (bufo ^ 1) * KBUF) = ka; *(LAS v4u*)(lds + vdst + (bufo ^ 1) * VBUF) = va; }
            ka = kr; va = vr;
            __syncthreads();
        }
#undef STAGE_FETCH
#undef LIST_BLOCK
#pragma unroll
        for (int ct = 0; ct < 2; ++ct) {
            const int qi = (8 * w + 4 * ct + (c16 >> 2)) * 4 + r;
            const float L = xq_sum(S.l[ct]); const float inv = L > 0.f ? ((const LAS float*)(lds + A_ML))[qi * 8 + 6] / L : 0.f;
#pragma unroll
            for (int mt = 0; mt < 4; ++mt) Ot[ct][mt] = otl[(ct * 4 + mt) * 64] + S.O[ct][mt] * inv;
        }
    }
    bf16* OA = WSP(bf16, WS_OAB);
    int lane_e = lane; asm volatile("" : "+v"(lane_e));
    const int c16e = lane_e & 15, qe = lane_e >> 4, re = c16e & 3;
#pragma unroll
    for (int ct = 0; ct < 2; ++ct) {
        const int tqe = t0 + 8 * w + 4 * ct + (c16e >> 2);
        const size_t base = (size_t)(b * SEQ + tqe) * 1024 + (g * 4 + re) * 64 + 4 * qe, obase = base + (size_t)(b * SEQ + tqe) * 1024;
#pragma unroll
        for (int mt = 0; mt < 4; ++mt) {
            const u32x2 z = *(const u32x2*)(ZA + base + 16 * mt);
            const f32x4 ov = Ot[ct][mt];
            u32x2 o; o.x = cvtpk(ov.x * bflo(z.x), ov.y * bfhi(z.x)); o.y = cvtpk(ov.z * bflo(z.y), ov.w * bfhi(z.y));
            *(u32x2*)(OA + obase + 16 * mt) = o;
        }
    }
    __syncthreads();
}

#ifndef PHMASK
#define PHMASK 0x1ff
#endif
struct Args { const float* in[27]; float* out; unsigned char* ws; int pad0, pad1; };

__global__ void __launch_bounds__(NTHR, 2) mega_fwd(Args args) {
    extern __shared__ __attribute__((aligned(16))) unsigned char lds_raw[];
    Ctx C;
    C.out = args.out; C.ws = args.ws; C.lds = (LAS unsigned char*)lds_raw;
    C.wave = __builtin_amdgcn_readfirstlane((int)threadIdx.x >> 6); C.G = gridDim.x; C.bid = blockIdx.x;
#define REFRESH_TID() do { unsigned m_ = ~0u; asm volatile("" : "+s"(m_)); const int l_ = __builtin_amdgcn_mbcnt_hi(m_, __builtin_amdgcn_mbcnt_lo(m_, 0u)); C.lane = l_; C.tid = C.wave * 64 + l_; } while (0)
    REFRESH_TID();
    volatile LAS unsigned* MISC = (volatile LAS unsigned*)(C.lds + MISC_OFF);
    for (int u = C.tid; u < (LDS_BYTES - RING_BYTES) / 4; u += NTHR) ((LAS unsigned*)(C.lds + RING_BYTES))[u] = 0u;
    __syncthreads();
    if (C.tid < 27) { const unsigned long long pv = (unsigned long long)args.in[C.tid]; LAS unsigned* tab = (LAS unsigned*)(C.lds + PTR_OFF); tab[2 * C.tid] = (unsigned)pv; tab[2 * C.tid + 1] = (unsigned)(pv >> 32); }
    __syncthreads();
    XcdBarrier bar = xcd_barrier_post((unsigned*)(C.ws + WS_CTL) + CW_BAR, MISC + 8, C.tid == 0);
    volatile LAS unsigned long long* TS = (volatile LAS unsigned long long*)(C.lds + RING_BYTES + 1024);
    int n_ts = 0;
#define STAMP() do { if (DBGT >= 0) { if (C.tid == 0) TS[n_ts] = __builtin_amdgcn_s_memrealtime(); ++n_ts; } } while (0)
#define GRID_BAR() do { REFRESH_TID(); xcd_barrier(bar, C.tid == 0); STAMP(); REFRESH_TID(); } while (0)
    STAMP();
    LAS unsigned char* ring = C.lds;

    if (PHMASK & (1 << 0))
    phase0(C);
    REFRESH_TID(); counter_wait(C, CW_GEMV, 96u); STAMP(); REFRESH_TID();
    if (PHMASK & (1 << 1))
    phase1(C);
    GRID_BAR();
    if (PHMASK & (1 << 2))
    {
#ifndef NO_BFGEMM
        { pg8::Gemm g{WSP(const bf16, WS_H), WSP(const bf16, WS_WIN), MTOK, INB, DM}; pg8::StaticOrder S; S.init(MTOK, INB, C.G, C.bid);
          EpiIn E{C.ws, 0};
          pg8::gemm_phase<EpiIn, pg8::StaticOrder, true, true, false>(ring, g, S, E, C.tid); }
#endif
#ifndef NO_FP8GEMM
        { pg8::Gemm g{WSP(const bf16, WS_OAB), WSP(const bf16, WS_W8), MTOK, ING, DM / 2}; pg8::StaticOrder S; S.init(MTOK, ING, C.G, (C.bid + C.G / 2) % C.G);
          EpiIn E{C.ws, 1};
          pg8::gemm_phase<EpiIn, pg8::StaticOrder, true, true, true>(ring, g, S, E, C.tid); }
#endif
    }
    GRID_BAR();
    if (PHMASK & (1 << 3))
    {
        for (int it = C.bid; it < 256; it += C.G) compress_item(C, it);
        for (int it = C.bid; it < 256; it += C.G) ssm_item(C, it);
    }
    __syncthreads(); STAMP(); REFRESH_TID();
    if (PHMASK & (1 << 4))
    {
        __syncthreads();
        if (DBGT >= 0 && C.tid == 0) TS[15] = __builtin_amdgcn_s_memrealtime();
        REFRESH_TID();
#ifndef NO_ATTN
        for (int k = C.bid; k < 1024; k += C.G) {
            const int rd = k >> 8, kk = k & 255, bg = kk & 15, jj = kk >> 4;
            const unsigned long long tw = (rd == 0) ? (jj < 8 ? 0x382d36393f3a3e3dull : 0x353326312e2c2f34ull)
                                        : (rd == 1) ? (jj < 8 ? 0x1f2a272b30373c3bull : 0x181a251d1c211e17ull)
                                                    : (jj < 8 ? 0x1520232422282932ull : 0x10111b1219161413ull);
            const int cur = (rd == 3) ? jj : (int)((tw >> (8 * (jj & 7))) & 255ull);
            attn_item(C, bg >> 2, bg & 3, cur);
        }
#endif
    }
    __syncthreads(); STAMP(); REFRESH_TID();
    if (PHMASK & (1 << 5))
    {
        counter_wait(C, CW_SSM, 256u);
        pg8::Gemm g{WSP(const bf16, WS_H), WSP(const bf16, WS_WGLU), MTOK, 1024, 1024}; pg8::StaticOrder S; S.init(MTOK, 1024, C.G, C.bid);
        EpiMix<0> E{WSP(const bf16, WS_H), WSP(const bf16, WS_ZB), WSP(bf16, WS_OAB) + 1024, inp(C, 21), nullptr, nullptr, 1024, 2048};
        pg8::gemm_phase<EpiMix<0>, pg8::StaticOrder, true, true>(ring, g, S, E, C.tid);
    }
    GRID_BAR();
    if (PHMASK & (1 << 6))
    {
        pg8::Gemm g{WSP(const bf16, WS_OAB), WSP(const bf16, WS_WBN), MTOK, 2048, 1024, 2048}; pg8::SplitKOrder S; S.init(MTOK, 2048, C.G, C.bid);
        EpiMix<1> E{WSP(const bf16, WS_GA), WSP(const bf16, WS_GB), WSP(bf16, WS_H), nullptr, nullptr, nullptr, 2048, 2048};
        pg8::gemm_phase<EpiMix<1>, pg8::SplitKOrder, true, true>(ring, g, S, E, C.tid);
    }
    GRID_BAR();
    if (PHMASK & (1 << 7))
    {
        pg8::Gemm g{WSP(const bf16, WS_H), WSP(const bf16, WS_WOUT), MTOK, 2048, 2048}; pg8::StaticOrder S; S.init(MTOK, 2048, C.G, C.bid);
        EpiMix<3> E{nullptr, nullptr, WSP(bf16, WS_Q), nullptr, WSP(const float, WS_MOD), nullptr, 2048, 2048};
        pg8::gemm_phase<EpiMix<3>, pg8::StaticOrder, true, true>(ring, g, S, E, C.tid);
    }
    GRID_BAR();
    if (PHMASK & (1 << 8))
    phase_ln_out(C);
    if (DBGT >= 0) {
        __syncthreads(); STAMP(); __syncthreads();
        if (C.bid == 0 && C.wave == 1) {
            const float T2 = (DBGT == 19) ? (float)(TS[9] - TS[0]) * 0.01f * DBGS : (DBGT >= 21) ? (float)TS[DBGT] * 0.01f * DBGS : (DBGT == 20) ? (float)(TS[15] - TS[4]) * 0.01f * DBGS : (float)(TS[DBGT + 1] - TS[DBGT]) * 0.01f * DBGS;
            f32x4* zr = (f32x4*)(C.out + (size_t)1 * DM) + C.lane;
#pragma unroll
            for (int j = 0; j < 8; ++j) { f32x4 v = zr[64 * j]; v.x += T2; v.y += T2; v.z += T2; v.w += T2; zr[64 * j] = v; }
        }
    }
}

extern "C" void kernel_launch(void* const* d_in, const int* in_sizes, int n_in, void* d_out, int out_size, void* d_ws, size_t ws_size, hipStream_t stream) {
    static int grid = 0;
    if (grid == 0) {
        if (n_in != 27 || out_size != MTOK * DM || ws_size < WS_END) { fprintf(stderr, "kernel_launch: unexpected problem (n_in %d, out %d, ws %zu)\n", n_in, out_size, ws_size); grid = -1; return; }
        int dev = 0, cus = 0, per_cu = 0;
        if (hipGetDevice(&dev) != hipSuccess || hipDeviceGetAttribute(&cus, hipDeviceAttributeMultiprocessorCount, dev) != hipSuccess) { grid = -1; return; }
        if (hipFuncSetAttribute((const void*)mega_fwd, hipFuncAttributeMaxDynamicSharedMemorySize, LDS_BYTES) != hipSuccess) { fprintf(stderr, "kernel_launch: hipFuncSetAttribute failed\n"); grid = -1; return; }
        if (hipOccupancyMaxActiveBlocksPerMultiprocessor(&per_cu, (const void*)mega_fwd, NTHR, LDS_BYTES) != hipSuccess || per_cu < 1) { fprintf(stderr, "kernel_launch: occupancy query says %d\n", per_cu); }
        (void)hipGetLastError();
        grid = cus;
    }
    if (grid < 0) return;
    if (hipMemsetAsync((char*)d_ws + 16384, 0, 16384, stream) != hipSuccess) return;
    Args a{};
    for (int i = 0; i < 27; ++i) a.in[i] = (const float*)d_in[i];
    a.out = (float*)d_out; a.ws = (unsigned char*)d_ws;
    hipLaunchKernelGGL(mega_fwd, dim3(grid), dim3(NTHR), LDS_BYTES, stream, a);
}
```

```cpp
#include <hip/hip_runtime.h>
#include <cstdio>
#include <cstdint>
namespace pg8 {
#define PG8_LAS __attribute__((address_space(3)))
typedef unsigned short bf16_t;
typedef short bf16x8 __attribute__((ext_vector_type(8)));
typedef float f32x4 __attribute__((ext_vector_type(4)));
typedef unsigned u32x4 __attribute__((ext_vector_type(4)));
constexpr int BM = 256, BK = 64, HALF = 128, HTB = HALF * BK * 2  , STAGE_BYTES = 8 * HTB, NXCD = 8, WGM = 8;

__host__ __device__ __forceinline__ int lds_byte(int r, int c) { const int st = (r >> 4) * 2 + (c >> 5), rr = r & 15, cc = c & 31, ob = rr * 64 + cc * 2; return st * 1024 + (ob ^ (((ob >> 9) & 1) << 5)); }
__host__ __device__ __forceinline__ void stage_rc(int b, int& R, int& C) { const int st = b / 1024, sb = b % 1024, swz = sb ^ (((sb >> 9) & 1) << 5); R = (st >> 1) * 16 + swz / 64; C = (st & 1) * 32 + (swz % 64) / 2; }
__host__ __device__ __forceinline__ int perm32(int rho) { const int n = rho >> 4, i = rho & 15; return 8 * (i >> 2) + 4 * n + (i & 3); }

struct Unit { int pm, pn, kh; };
struct Gemm { const bf16_t* A; const bf16_t* Bt; int M, N, K, ld; };

struct StaticOrder {
    int nM, nN, nwg, G, c;
    __host__ __device__ void init(int M, int N, int G_, int c_) { nM = M / BM; nN = N / BM; nwg = nM * nN; G = G_; c = c_; }
    __host__ __device__ bool next(int i, Unit& u) const {
        const long L = (long)i * G + c; if (L >= nwg) return false;
        int wgid = (int)L; { const int q = nwg / NXCD, r = nwg % NXCD, xcd = wgid % NXCD, off = wgid / NXCD; wgid = (xcd < r ? xcd * (q + 1) : r * (q + 1) + (xcd - r) * q) + off; }
        const int nig = WGM * nN, gid = wgid / nig, fm = gid * WGM, gsz = (nM - fm) < WGM ? (nM - fm) : WGM;
        u.pm = fm + ((wgid % nig) % gsz); u.pn = (wgid % nig) / gsz; u.kh = 0; return true;
    }
    __device__ __forceinline__ void a_ready(const Unit&) const {}
    __device__ __forceinline__ void done(const Unit&) const {}
};
struct SplitKOrder {
    StaticOrder base;
    __host__ __device__ void init(int M, int N, int G_, int c_) { base.init(M, N, G_, c_); }
    __host__ __device__ bool next(int i, Unit& u) const { if (!base.next(i >> 1, u)) return false; u.kh = i & 1; return true; }
    __device__ __forceinline__ void a_ready(const Unit&) const {}
    __device__ __forceinline__ void done(const Unit&) const {}
};

__device__ __forceinline__ unsigned cvt_pk_bf16(float lo, float hi) { unsigned r; asm volatile("v_cvt_pk_bf16_f32 %0, %1, %2" : "=v"(r) : "v"(lo), "v"(hi)); return r; }
typedef float f32x2 __attribute__((ext_vector_type(2)));
__device__ __forceinline__ f32x2 gelu_pk(f32x2 v) {
    const f32x2 av = __builtin_elementwise_abs(v), d = av * 0.2316418882f + 1.0f;
    f32x2 t; t.x = __builtin_amdgcn_rcpf(d.x); t.y = __builtin_amdgcn_rcpf(d.y);
    f32x2 q = t * 0.5307027145f + (-0.7265760135f); q = q * t + 0.7107068705f; q = q * t + (-0.142248368f); q = q * t + 0.127414796f; q = q * t;
    const f32x2 s = (v * v) * (-0.72134752044f);
    f32x2 e; e.x = __builtin_amdgcn_exp2f(s.x); e.y = __builtin_amdgcn_exp2f(s.y);
    const f32x2 m = v * (q * e), r = v - m;
    f32x2 o; o.x = v.x < 0.f ? m.x : r.x; o.y = v.y < 0.f ? m.y : r.y; return o;
}

typedef int i32x4_t __attribute__((ext_vector_type(4)));
typedef int i32x8_t __attribute__((ext_vector_type(8)));
__device__ __forceinline__ i32x8_t cat8(bf16x8 lo, bf16x8 hi) { const i32x4_t a = __builtin_bit_cast(i32x4_t, lo), b = __builtin_bit_cast(i32x4_t, hi); return __builtin_shufflevector(a, b, 0, 1, 2, 3, 4, 5, 6, 7); }
template <class Epi, class Sched, bool ALIGN_EPI = false, bool SP2 = false, bool FP8 = false>
__device__ __forceinline__ void gemm_phase(PG8_LAS unsigned char* lds, const Gemm g, const Sched& S, const Epi& E, int tid_in) {
    int tid_ = tid_in; asm volatile("" : "+v"(tid_));
    const int tid = tid_, wid = __builtin_amdgcn_readfirstlane(tid >> 6), lane = tid & 63, wr = wid >> 2, wc = wid & 3, fr = lane & 15, fq = lane >> 4;
    int pg8_scale1 = 0x7F7F7F7F; asm volatile("" : "+v"(pg8_scale1));
    const int K = g.K, nt = K / BK, LD = g.ld ? g.ld : g.K;
    unsigned voffA[2], voffB[2];
#pragma unroll
    for (int i = 0; i < 2; ++i) { int R, C; stage_rc(tid * 16 + i * 8192, R, C); const int Rb = Epi::PERM ? ((R & ~31) + perm32(R & 31)) : R;
        voffA[i] = (unsigned)(R * LD + C) * 2u; voffB[i] = (unsigned)(Rb * LD + C) * 2u; }
    const size_t kstep = (size_t)(BK * 2);
    const size_t hstep = (size_t)HALF * LD * 2;
    const size_t tstep = 2 * hstep;
    const unsigned ldsw = (unsigned)wid * 1024u;
    const int aoff = lds_byte(wr * 64 + fr, fq * 8), boff = lds_byte(wc * 32 + fr, fq * 8);
#define PG8_SA(b, h) (((b) * 2 + (h)) * HTB)
#define PG8_SB(b, h) ((4 + (b) * 2 + (h)) * HTB)
#define PG8_STAGE(bufoff, gbase, voff) do { _Pragma("unroll") for (int _i = 0; _i < 2; ++_i) \
        __builtin_amdgcn_global_load_lds((const unsigned*)((const char*)(gbase) + (voff)[_i]), (PG8_LAS unsigned*)(lds + (bufoff) + ldsw + _i * 8192), 16, 0, 0); } while (0)
#define PG8_LDA(dst, b, h) do { _Pragma("unroll") for (int m = 0; m < 4; ++m) { dst[m].lo = *(const PG8_LAS i32x4_t*)(lds + PG8_SA(b, h) + aoff + m * 2048); dst[m].hi = *(const PG8_LAS i32x4_t*)(lds + PG8_SA(b, h) + aoff + m * 2048 + 1024); } } while (0)
#define PG8_LDB(dst, b, h) do { _Pragma("unroll") for (int n = 0; n < 2; ++n) { dst[n].lo = *(const PG8_LAS i32x4_t*)(lds + PG8_SB(b, h) + boff + n * 2048); dst[n].hi = *(const PG8_LAS i32x4_t*)(lds + PG8_SB(b, h) + boff + n * 2048 + 1024); } } while (0)
#define PG8_MMA(ai, bj, At, Bt) do { __builtin_amdgcn_s_setprio(1); if constexpr (FP8) { _Pragma("unroll") for (int m = 0; m < 4; ++m) _Pragma("unroll") for (int n = 0; n < 2; ++n) \
        asm volatile("v_mfma_scale_f32_16x16x128_f8f6f4 %0, %1, %2, %0, %3, %3 op_sel_hi:[0,0,0]" : "+v"(acc[ai][bj][m][n]) : "v"(Bt[n]), "v"(At[m]), "v"(pg8_scale1)); } else { \
        _Pragma("unroll") for (int m = 0; m < 4; ++m) _Pragma("unroll") for (int n = 0; n < 2; ++n) { \
        acc[ai][bj][m][n] = __builtin_amdgcn_mfma_f32_16x16x32_bf16(__builtin_bit_cast(bf16x8, (i32x4_t)Bt[n].lo), __builtin_bit_cast(bf16x8, (i32x4_t)At[m].lo), acc[ai][bj][m][n], 0, 0, 0); \
        acc[ai][bj][m][n] = __builtin_amdgcn_mfma_f32_16x16x32_bf16(__builtin_bit_cast(bf16x8, (i32x4_t)Bt[n].hi), __builtin_bit_cast(bf16x8, (i32x4_t)At[m].hi), acc[ai][bj][m][n], 0, 0, 0); } } __builtin_amdgcn_s_setprio(0); } while (0)
#define PG8_WAIT_V(n) asm volatile("s_waitcnt vmcnt(" #n ")" ::: "memory")
#define PG8_WAIT_L(n) asm volatile("s_waitcnt lgkmcnt(" #n ")" ::: "memory")
#define PG8_BAR __builtin_amdgcn_s_barrier()
#define PG8_SCHED __builtin_amdgcn_sched_barrier(0)
    Unit cur, nxt; int ui = 0;
    if (!S.next(0, cur)) return;
    f32x4 acc[2][2][4][2];
#pragma unroll
    for (int a = 0; a < 2; ++a)
#pragma unroll
        for (int b = 0; b < 2; ++b)
#pragma unroll
            for (int m = 0; m < 4; ++m)
#pragma unroll
                for (int n = 0; n < 2; ++n) acc[a][b][m][n] = (f32x4){0.f, 0.f, 0.f, 0.f};
    i32x8_t At[4], B0[2], B1[2];
    const size_t khstep = (size_t)K * 2;
    const char* cA = (const char*)g.A + (size_t)cur.pm * tstep + (size_t)cur.kh * khstep; const char* cB = (const char*)g.Bt + (size_t)cur.pn * tstep + (size_t)cur.kh * khstep;
    S.a_ready(cur);
    if constexpr (SP2) {
        PG8_STAGE(PG8_SB(0, 0), cB, voffB); PG8_STAGE(PG8_SB(0, 1), cB + hstep, voffB); PG8_STAGE(PG8_SA(0, 0), cA, voffA); PG8_STAGE(PG8_SA(0, 1), cA + hstep, voffA);
        if (wr == 1) PG8_BAR;
        PG8_WAIT_V(2); PG8_BAR;
        PG8_STAGE(PG8_SB(1, 0), cB + kstep, voffB); PG8_STAGE(PG8_SA(1, 0), cA + kstep, voffA); PG8_STAGE(PG8_SB(1, 1), cB + hstep + kstep, voffB);
        PG8_WAIT_V(6); PG8_BAR;
    } else {
        PG8_STAGE(PG8_SB(0, 0), cB, voffB); PG8_STAGE(PG8_SA(0, 0), cA, voffA); PG8_STAGE(PG8_SB(0, 1), cB + hstep, voffB); PG8_STAGE(PG8_SA(0, 1), cA + hstep, voffA);
        if (wr == 1) PG8_BAR;
        PG8_WAIT_V(4); PG8_BAR;
        PG8_STAGE(PG8_SB(1, 0), cB + kstep, voffB); PG8_STAGE(PG8_SA(1, 0), cA + kstep, voffA); PG8_STAGE(PG8_SB(1, 1), cB + hstep + kstep, voffB);
        PG8_WAIT_V(6); PG8_BAR;
    }
    for (;;) {
        const bool has_next = S.next(ui + 1, nxt);
        const char* nA = has_next ? (const char*)g.A + (size_t)nxt.pm * tstep + (size_t)nxt.kh * khstep : cA; const char* nB = has_next ? (const char*)g.Bt + (size_t)nxt.pn * tstep + (size_t)nxt.kh * khstep : cB;
        for (int t = 0; t < nt; t += 2) {
            const bool last = (t == nt - 2);
            const char* a1 = cA + (size_t)(t + 1) * kstep;
            const char* a2 = last ? nA : cA + (size_t)(t + 2) * kstep; const char* b2 = last ? nB : cB + (size_t)(t + 2) * kstep;
            const char* a3 = a2 + kstep; const char* b3 = b2 + kstep;
            if (last && has_next) S.a_ready(nxt);
            if constexpr (SP2) {
            PG8_LDB(B0, 0, 0); PG8_LDB(B1, 0, 1); PG8_SCHED; PG8_LDA(At, 0, 0); PG8_STAGE(PG8_SA(1, 1), a1 + hstep, voffA);
            PG8_WAIT_V(8); PG8_WAIT_L(0); PG8_BAR; PG8_MMA(0, 0, At, B0); PG8_MMA(0, 1, At, B1); PG8_BAR; PG8_SCHED;
            PG8_LDA(At, 0, 1); PG8_STAGE(PG8_SB(0, 0), b2, voffB); PG8_STAGE(PG8_SB(0, 1), b2 + hstep, voffB); PG8_STAGE(PG8_SA(0, 0), a2, voffA);
            PG8_WAIT_V(8); PG8_WAIT_L(0); PG8_BAR; PG8_MMA(1, 0, At, B0); PG8_MMA(1, 1, At, B1); PG8_BAR; PG8_SCHED;
            PG8_LDB(B0, 1, 0); PG8_LDB(B1, 1, 1); PG8_SCHED; PG8_LDA(At, 1, 0); PG8_STAGE(PG8_SA(0, 1), a2 + hstep, voffA);
            PG8_WAIT_V(8); PG8_WAIT_L(0); PG8_BAR; PG8_MMA(0, 0, At, B0); PG8_MMA(0, 1, At, B1); PG8_BAR; PG8_SCHED;
            PG8_LDA(At, 1, 1); PG8_STAGE(PG8_SB(1, 0), b3, voffB); PG8_STAGE(PG8_SB(1, 1), b3 + hstep, voffB); PG8_STAGE(PG8_SA(1, 0), a3, voffA);
            PG8_WAIT_V(8); PG8_WAIT_L(0); PG8_BAR; PG8_MMA(1, 0, At, B0); PG8_MMA(1, 1, At, B1); PG8_BAR; PG8_SCHED;
            } else {
            PG8_LDB(B0, 0, 0); PG8_SCHED; PG8_LDA(At, 0, 0); PG8_STAGE(PG8_SA(1, 1), a1 + hstep, voffA);
            PG8_WAIT_L(8); PG8_BAR; PG8_WAIT_L(0); PG8_MMA(0, 0, At, B0); PG8_BAR; PG8_SCHED;
            PG8_LDB(B1, 0, 1); PG8_STAGE(PG8_SB(0, 0), b2, voffB);
            PG8_BAR; PG8_WAIT_L(0); PG8_MMA(0, 1, At, B1); PG8_BAR;
            PG8_LDA(At, 0, 1); PG8_STAGE(PG8_SA(0, 0), a2, voffA);
            PG8_BAR; PG8_WAIT_L(0); PG8_MMA(1, 0, At, B0); PG8_BAR; PG8_SCHED;
            PG8_STAGE(PG8_SB(0, 1), b2 + hstep, voffB);
            PG8_WAIT_V(6); PG8_BAR; PG8_MMA(1, 1, At, B1); PG8_BAR;
            PG8_LDB(B0, 1, 0); PG8_SCHED; PG8_LDA(At, 1, 0); PG8_STAGE(PG8_SA(0, 1), a2 + hstep, voffA);
            PG8_WAIT_L(8); PG8_BAR; PG8_WAIT_L(0); PG8_MMA(0, 0, At, B0); PG8_BAR; PG8_SCHED;
            PG8_LDB(B1, 1, 1); PG8_STAGE(PG8_SB(1, 0), b3, voffB);
            PG8_BAR; PG8_WAIT_L(0); PG8_MMA(0, 1, At, B1); PG8_BAR;
            PG8_LDA(At, 1, 1); PG8_STAGE(PG8_SA(1, 0), a3, voffA);
            PG8_BAR; PG8_WAIT_L(0); PG8_MMA(1, 0, At, B0); PG8_BAR; PG8_SCHED;
            PG8_STAGE(PG8_SB(1, 1), b3 + hstep, voffB);
            PG8_WAIT_V(6); PG8_BAR; PG8_MMA(1, 1, At, B1); PG8_BAR;
            }
        }
        if constexpr (ALIGN_EPI) { if (wr == 0) PG8_BAR; }
        if constexpr (FP8) asm volatile("s_nop 15\n\ts_nop 15" ::: "memory");
        bool keep = false;
        if constexpr (Epi::HAS_MID) keep = (cur.kh == 0);
        if constexpr (!Epi::AFTER_DRAIN) { if constexpr (Epi::HAS_MID) { if (keep) E.mid(acc, cur, wr, wc, fr, fq); else E(acc, cur, wr, wc, fr, fq); } else E(acc, cur, wr, wc, fr, fq); S.done(cur); }
        if (!has_next) break;
        if (!keep)
#pragma unroll
        for (int a = 0; a < 2; ++a)
#pragma unroll
            for (int b = 0; b < 2; ++b)
#pragma unroll
                for (int m = 0; m < 4; ++m)
#pragma unroll
                    for (int n = 0; n < 2; ++n) acc[a][b][m][n] = (f32x4){0.f, 0.f, 0.f, 0.f};
        cur = nxt; cA = nA; cB = nB; ++ui;
        if constexpr (ALIGN_EPI) { if (wr == 1) PG8_BAR; }
    }
    PG8_WAIT_V(0);
    if constexpr (!ALIGN_EPI) { if (wr == 0) PG8_BAR; }
    PG8_BAR;
    if constexpr (Epi::AFTER_DRAIN) { E.fused(acc, cur, wr, wc, fr, fq, lds, wid, lane); S.done(cur); }
#undef PG8_SA
#undef PG8_SB
#undef PG8_STAGE
#undef PG8_LDA
#undef PG8_LDB
#undef PG8_MMA
#undef PG8_WAIT_V
#undef PG8_WAIT_L
#undef PG8_BAR
#undef PG8_SCHED
}
}
#define GAS __attribute__((address_space(1)))
#define LAS __attribute__((address_space(3)))
typedef unsigned short bf16;
typedef unsigned v4u __attribute__((ext_vector_type(4)));
typedef float f32x4 __attribute__((ext_vector_type(4)));
typedef short bf16x8 __attribute__((ext_vector_type(8)));
typedef GAS unsigned gu32;
typedef GAS unsigned long long gu64;
#define RLX_AGENT __ATOMIC_RELAXED, __HIP_MEMORY_SCOPE_AGENT
#define LDS_WAIT() asm volatile("s_waitcnt lgkmcnt(0)" ::: "memory")
#define VM_WAIT() asm volatile("s_waitcnt vmcnt(0)" ::: "memory")
__device__ __forceinline__ unsigned long long rt() { return __builtin_amdgcn_s_memrealtime(); }
__device__ __forceinline__ unsigned f2bf(float f) { unsigned u = __builtin_bit_cast(unsigned, f); return (u + 0x7fffu + ((u >> 16) & 1u)) >> 16; }
__device__ __forceinline__ unsigned pk2(float lo, float hi) { return f2bf(lo) | (f2bf(hi) << 16); }

#define XB_TMO      128
#define XB_XCNT(j)  (256  + 64 * (j))
#define XB_XSUB(j)  (1280 + 64 * (j))
#define XB_XGEN(j)  (2304 + 64 * (j))
#define XB_TOP      3328
#define XB_TOPGEN   3392
#define XCD_BAR_WORDS 3456
#define XB_SPIN_CAP (1u << 18)

__device__ __forceinline__ unsigned xb_ld(unsigned* p)              { return __hip_atomic_load(p, __ATOMIC_RELAXED, __HIP_MEMORY_SCOPE_AGENT); }
__device__ __forceinline__ unsigned xb_add(unsigned* p, unsigned v) { return __hip_atomic_fetch_add(p, v, __ATOMIC_RELAXED, __HIP_MEMORY_SCOPE_AGENT); }
__device__ __forceinline__ unsigned xb_xcc_id() { return (unsigned)__builtin_amdgcn_s_getreg((3 << 11) | 20) & 0xFu; }
#define XB_SPIN(cond, bar) do { unsigned _sp = 0; while (cond) { __builtin_amdgcn_s_sleep(1); \
    if ((++_sp & 255u) == 0u) { if (xb_ld(&(bar)[XB_TMO])) break; if (_sp > XB_SPIN_CAP) { atomicAdd(&(bar)[XB_TMO], 1u); break; } } } } while (0)

struct XcdBarrier {
    unsigned* bar; unsigned x;
    volatile LAS unsigned* st;
};

__device__ __forceinline__ XcdBarrier xcd_barrier_post(unsigned* bar, volatile LAS unsigned* st, bool is_t0) {
    XcdBarrier b; b.bar = bar; b.x = xb_xcc_id(); b.st = st;
    if (is_t0) (void)xb_add(&bar[XB_XCNT(b.x)], 1u);
    return b;
}
__device__ __forceinline__ void xcd_barrier_complete(unsigned* bar, unsigned x, unsigned& nloc, unsigned& nx) {
    const unsigned G = gridDim.x * gridDim.y * gridDim.z;
    unsigned sum, cnt, mine, sp = 0u;
    for (;;) {
        sum = 0u; cnt = 0u; mine = 0u;
#pragma unroll
        for (unsigned j = 0; j < 16; ++j) { const unsigned c = xb_ld(&bar[XB_XCNT(j)]); sum += c; cnt += (c > 0u) ? 1u : 0u; mine = (j == x) ? c : mine; }
        if (sum == G) break;
        __builtin_amdgcn_s_sleep(1);
        if ((++sp & 255u) == 0u) { if (xb_ld(&bar[XB_TMO])) break; if (sp > XB_SPIN_CAP) { atomicAdd(&bar[XB_TMO], 1u); break; } }
    }
    nloc = mine > 0u ? mine : 1u; nx = cnt > 0u ? cnt : 1u;
}

__device__ __forceinline__ void xcd_barrier(const XcdBarrier& b, bool is_t0) {
    asm volatile("s_waitcnt vmcnt(0)" ::: "memory");
    __syncthreads();
    if (is_t0) {
        unsigned* bar = b.bar;
        __builtin_amdgcn_s_waitcnt(0);
        unsigned nloc = b.st[0], nx = b.st[1];
        if (nloc == 0u) { xcd_barrier_complete(bar, b.x, nloc, nx); b.st[0] = nloc; b.st[1] = nx; }
        const unsigned old = xb_add(&bar[XB_XSUB(b.x)], 1u);
        const unsigned gen = old / nloc;
        if (old + 1u == (gen + 1u) * nloc) {
            __builtin_amdgcn_fence(__ATOMIC_RELEASE, "agent");
            asm volatile("s_waitcnt vmcnt(0)" ::: "memory");
            const unsigned og = xb_add(&bar[XB_TOP], 1u);
            const unsigned tg = og / nx;
            if (og + 1u == (tg + 1u) * nx) xb_add(&bar[XB_TOPGEN], 1u);
            else XB_SPIN(xb_ld(&bar[XB_TOPGEN]) == tg, bar);
            __builtin_amdgcn_fence(__ATOMIC_ACQUIRE, "agent");
            xb_add(&bar[XB_XGEN(b.x)], 1u);
            asm volatile("s_waitcnt vmcnt(0)" ::: "memory");
        } else {
            XB_SPIN(xb_ld(&bar[XB_XGEN(b.x)]) == gen, bar);
            __builtin_amdgcn_fence(__ATOMIC_ACQUIRE, "agent");
            asm volatile("s_waitcnt vmcnt(0)" ::: "memory");
        }
    }
    __syncthreads();
}

#ifndef DBGT
#define DBGT -1
#endif
#ifndef DBGS
#define DBGS 0.002f
#endif

constexpr int NB = 4, SEQ = 4096, DM = 2048, MTOK = NB * SEQ;
constexpr int NHEAD = 16, NGRP = 4, HDIM = 64, NSAW = 1024, KVW = 256;
constexpr int SSMW = 1024;
#ifndef KV8MASK
#define KV8MASK 0x0b
#endif
__host__ __device__ constexpr int kv_popc(int m) { return (m & 1) + ((m >> 1) & 1) + ((m >> 2) & 1) + ((m >> 3) & 1) + ((m >> 4) & 1); }
__host__ __device__ constexpr int kv_nth(int m, int k) { int c = 0; for (int i = 0; i < 5; ++i) if ((m >> i) & 1) { if (c == k) return i; ++c; } return 0; }
constexpr int NKV8 = kv_popc(KV8MASK), NKVB = 5 - NKV8;
constexpr int INW = 9776, INWP = 9984, INB = (18 + NKVB) * 256, ING = (16 + NKV8) * 256;
constexpr int CHUNK = 512, NCHUNK = SEQ / CHUNK;
constexpr float LN_EPS = 1e-5f;
constexpr float DN_ALPHA = 1.189207115002721f;
constexpr int NWAVES = 8, NTHR = 512;
#ifndef DBG
#define DBG 0
#endif
constexpr int LDS_BYTES = 159744, RING_BYTES = 155648, MISC_OFF = RING_BYTES + 320;

constexpr size_t MiB = 1u << 20;
constexpr size_t WS_CTL = 0, CTL_ZERO_BYTES = 1 * MiB;
constexpr int CW_BAR = 4096;
constexpr int CW_CMP = 7680;
constexpr int CW_SSM = 7680 + 16 * 16;
constexpr int CW_GEMV = CW_SSM + 16;
constexpr size_t WS_MOD = 32 * 1024;
constexpr size_t WS_MODP = 128 * 1024;
constexpr size_t WS_LUT = 512 * 1024;
constexpr size_t WS_BP = 520 * 1024;
constexpr size_t WS_KC = 1 * MiB;
constexpr size_t WS_VCT = 1 * MiB + 512 * 1024;
constexpr size_t WS_E = 2 * MiB;
constexpr size_t WS_WIN = 4 * MiB;
constexpr size_t WS_W8 = 28 * MiB;
constexpr size_t WS_WGLU = 43 * MiB;
constexpr size_t WS_WBN = 45 * MiB;
constexpr size_t WS_WBS = 49 * MiB;
constexpr size_t WS_WOUT = 53 * MiB;
constexpr size_t WS_WK1 = 61 * MiB;
constexpr size_t WS_WV1 = 61 * MiB + 512 * 1024;
constexpr size_t WS_WK2 = 62 * MiB;
constexpr size_t WS_WV2 = 62 * MiB + 64 * 1024;
constexpr size_t WS_H = 64 * MiB;
constexpr size_t WS_Q = 128 * MiB;
constexpr size_t WS_KCI = 160 * MiB, WS_VCI = 168 * MiB, WS_KS = 176 * MiB, WS_KW = 184 * MiB;
constexpr size_t WS_VST = 192 * MiB, WS_VWT = 200 * MiB;
constexpr size_t WS_NGB = 208 * MiB;
constexpr size_t WS_ZA = 212 * MiB;
constexpr size_t WS_US = 244 * MiB;
constexpr size_t WS_ZB = 276 * MiB;
constexpr size_t WS_GA = 308 * MiB, WS_GB = 372 * MiB;
constexpr size_t WS_OAB = 436 * MiB;
constexpr size_t WS_END = 500 * MiB;

typedef unsigned u32x2 __attribute__((ext_vector_type(2)));
typedef short s16x4 __attribute__((ext_vector_type(4)));

__device__ __forceinline__ float bflo(unsigned u) { return __builtin_bit_cast(float, u << 16); }
__device__ __forceinline__ float bfhi(unsigned u) { return __builtin_bit_cast(float, u & 0xffff0000u); }
__device__ __forceinline__ float bf2f(bf16 h) { return __builtin_bit_cast(float, (unsigned)h << 16); }
__device__ __forceinline__ unsigned cvtpk(float lo, float hi) { return pg8::cvt_pk_bf16(lo, hi); }
__device__ __forceinline__ float fexp(float x) { return __builtin_amdgcn_exp2f(x * 1.4426950408889634f); }
__device__ __forceinline__ float sigmoidf_(float v) { return __builtin_amdgcn_rcpf(1.f + fexp(-v)); }
__device__ __forceinline__ float siluf_(float v) { return v * sigmoidf_(v); }
__device__ __forceinline__ float gelu_tanh(float x) {
    const float z = 0.7978845608028654f * (x + 0.044715f * x * x * x);
    const float e = fexp(2.f * z);
    const float th = 1.f - 2.f * __builtin_amdgcn_rcpf(1.f + e);
    return 0.5f * x * (1.f + th);
}
__device__ __forceinline__ bf16x8 pack8(float a0, float a1, float a2, float a3, float a4, float a5, float a6, float a7) {
    v4u w; w.x = cvtpk(a0, a1); w.y = cvtpk(a2, a3); w.z = cvtpk(a4, a5); w.w = cvtpk(a6, a7);
    return __builtin_bit_cast(bf16x8, w);
}
__device__ __forceinline__ f32x4 mfma16(bf16x8 a, bf16x8 b, f32x4 c) { return __builtin_amdgcn_mfma_f32_16x16x32_bf16(a, b, c, 0, 0, 0); }
template <int CTRL> __device__ __forceinline__ float dppf(float x) { return __builtin_bit_cast(float, __builtin_amdgcn_mov_dpp(__builtin_bit_cast(int, x), CTRL, 0xf, 0xf, true)); }
template <int CTRL> __device__ __forceinline__ int dppi(int x) { return __builtin_amdgcn_mov_dpp(x, CTRL, 0xf, 0xf, true); }
constexpr int DPP_XOR1 = 0xB1, DPP_XOR2 = 0x4E, DPP_HMIRROR = 0x141;
__device__ __forceinline__ float xq_max(float x) {
    auto s = __builtin_amdgcn_permlane16_swap(__builtin_bit_cast(unsigned, x), __builtin_bit_cast(unsigned, x), false, false);
    x = fmaxf(__builtin_bit_cast(float, (unsigned)s[0]), __builtin_bit_cast(float, (unsigned)s[1]));
    auto t = __builtin_amdgcn_permlane32_swap(__builtin_bit_cast(unsigned, x), __builtin_bit_cast(unsigned, x), false, false);
    return fmaxf(__builtin_bit_cast(float, (unsigned)t[0]), __builtin_bit_cast(float, (unsigned)t[1]));
}
__device__ __forceinline__ float xq_sum(float x) {
    auto s = __builtin_amdgcn_permlane16_swap(__builtin_bit_cast(unsigned, x), __builtin_bit_cast(unsigned, x), false, false);
    x = __builtin_bit_cast(float, (unsigned)s[0]) + __builtin_bit_cast(float, (unsigned)s[1]);
    auto t = __builtin_amdgcn_permlane32_swap(__builtin_bit_cast(unsigned, x), __builtin_bit_cast(unsigned, x), false, false);
    return __builtin_bit_cast(float, (unsigned)t[0]) + __builtin_bit_cast(float, (unsigned)t[1]);
}

constexpr int DPP_RMIRROR = 0x140;
__device__ __forceinline__ float wave_sum(float v) {
    v += dppf<DPP_XOR1>(v); v += dppf<DPP_XOR2>(v); v += dppf<DPP_HMIRROR>(v); v += dppf<DPP_RMIRROR>(v);
    return xq_sum(v);
}

struct Ctx {
    float* out; unsigned char* ws;
    LAS unsigned char* lds;
    int tid, lane, wave, G, bid;
};
constexpr int PTR_OFF = RING_BYTES + 512;
__device__ __forceinline__ const float* inp(const Ctx& C, int i) {
    const LAS unsigned* tab = (const LAS unsigned*)(C.lds + PTR_OFF);
    const unsigned lo = __builtin_amdgcn_readfirstlane(tab[2 * i]), hi = __builtin_amdgcn_readfirstlane(tab[2 * i + 1]);
    return (const float*)(((unsigned long long)hi << 32) | lo);
}
#define WSP(T, off) ((T*)(C.ws + (off)))
__device__ __forceinline__ void counter_signal(const Ctx& C, int word) {
    if (C.tid == 0) { __builtin_amdgcn_fence(__ATOMIC_RELEASE, "agent"); asm volatile("s_waitcnt vmcnt(0)" ::: "memory");
        __hip_atomic_fetch_add((unsigned*)(C.ws + WS_CTL) + word, 1u, __ATOMIC_RELAXED, __HIP_MEMORY_SCOPE_AGENT); }
}
__device__ __forceinline__ void counter_wait(const Ctx& C, int word, unsigned target) {
    if (C.tid == 0) {
        unsigned* p = (unsigned*)(C.ws + WS_CTL) + word; unsigned sp = 0;
        while (__hip_atomic_load(p, __ATOMIC_RELAXED, __HIP_MEMORY_SCOPE_AGENT) < target) { __builtin_amdgcn_s_sleep(2); if (++sp > (1u << 22)) break; }
        __builtin_amdgcn_fence(__ATOMIC_ACQUIRE, "agent"); asm volatile("s_waitcnt vmcnt(0)" ::: "memory");
    }
    __syncthreads();
}

struct EpiIn {
    static constexpr bool PERM = true, AFTER_DRAIN = false, HAS_MID = false;
    unsigned char* ws; int gates;
    __device__ __forceinline__ void operator()(const pg8::f32x4 (&acc)[2][2][4][2], const pg8::Unit& u, int wr, int wc, int fr, int fq) const {
        const int pn = u.pn;
        int mode; size_t off; int ld; int cb;
        int kvid = -1;
        if (!gates) {
            if (pn < 4) { mode = 1; off = WS_Q; ld = 1024; cb = pn * 256; }
            else if (pn < 5) { mode = 0; off = WS_KCI; ld = 256; cb = 0; }
            else if (pn < 5 + NKVB) { kvid = kv_nth(0x1f & ~KV8MASK, pn - 5); }
            else if (pn < 9 + NKVB) { mode = 2; off = WS_ZA; ld = 1024; cb = (pn - 5 - NKVB) * 256; }
            else if (pn < 13 + NKVB) { mode = 0; off = WS_US; ld = 1024; cb = (pn - 9 - NKVB) * 256; }
            else if (pn < 17 + NKVB) { mode = 2; off = WS_ZB; ld = 1024; cb = (pn - 13 - NKVB) * 256; }
            else { mode = 5; off = WS_NGB; ld = 64; cb = 0; }
        } else {
            if (pn < NKV8) kvid = kv_nth(KV8MASK, pn);
            else { mode = 6; off = WS_GA; ld = 2048; cb = (pn - NKV8) * 128; }
        }
        if (kvid >= 0) { ld = 256; cb = 0; mode = (kvid == 2 || kvid == 4) ? 4 : 0;
            off = kvid == 0 ? WS_VCI : (kvid == 1 ? WS_KS : (kvid == 2 ? WS_VST : (kvid == 3 ? WS_KW : WS_VWT))); }
        const float gsc = gates ? 0.03125f : 1.f;
        bf16* base = (bf16*)(ws + off);
        const int row0 = u.pm * 256 + wr * 64 + fr;
        if (mode == 6) {
            bf16* gbp = (bf16*)(ws + WS_GB);
#pragma unroll
            for (int ai = 0; ai < 2; ++ai)
#pragma unroll
                for (int m = 0; m < 4; ++m) {
                    const size_t o = (size_t)(row0 + ai * 128 + m * 16) * 2048 + cb + wc * 32 + 8 * fq;
                    float ra[8], sb[8];
#pragma unroll
                    for (int e = 0; e < 8; ++e) {
                        const float a = acc[ai][0][m][e >> 2][e & 3] * gsc, bb = acc[ai][1][m][e >> 2][e & 3] * gsc;
                        const float A = 1.f + fexp(fminf(-a, 40.f)), B = 1.f + fexp(fminf(-bb, 40.f)), t = __builtin_amdgcn_rcpf(A * B);
                        ra[e] = t * B * B; sb[e] = t * A;
                    }
                    { v4u w; w.x = cvtpk(ra[0], ra[1]); w.y = cvtpk(ra[2], ra[3]); w.z = cvtpk(ra[4], ra[5]); w.w = cvtpk(ra[6], ra[7]); __builtin_nontemporal_store(w, (v4u*)(base + o)); }
                    { v4u w; w.x = cvtpk(sb[0], sb[1]); w.y = cvtpk(sb[2], sb[3]); w.z = cvtpk(sb[4], sb[5]); w.w = cvtpk(sb[6], sb[7]); __builtin_nontemporal_store(w, (v4u*)(gbp + o)); }
                }
            return;
        }
#pragma unroll
        for (int ai = 0; ai < 2; ++ai)
#pragma unroll
            for (int m = 0; m < 4; ++m) {
                const int row = row0 + ai * 128 + m * 16;
#pragma unroll
                for (int bj = 0; bj < 2; ++bj) {
                    const int cc = bj * 128 + wc * 32 + 8 * fq;
                    float v[8];
#pragma unroll
                    for (int e = 0; e < 4; ++e) { v[e] = acc[ai][bj][m][0][e] * gsc; v[4 + e] = acc[ai][bj][m][1][e] * gsc; }
                    if (mode == 1) {
#pragma unroll
                        for (int e = 0; e < 8; ++e) v[e] *= 0.125f;
                    } else if (mode == 2) {
#pragma unroll
                        for (int e = 0; e < 8; ++e) v[e] = siluf_(v[e]);
                    } else if (mode == 3 || mode == 5) {
#pragma unroll
                        for (int e = 0; e < 8; ++e) v[e] = sigmoidf_(v[e]);
                    }
                    if (mode == 4) {
                        const int b = row >> 12, t = row & 4095, g = cc >> 6, d0 = cc & 63, kk = t & 31;
                        const int pos = (t & 32) + 8 * ((kk & 15) >> 2) + 4 * (kk >> 4) + (kk & 3);
                        bf16* p = base + ((size_t)((b * 4 + g) * 64 + (t >> 6)) << 12) + d0 * 64 + pos;
#pragma unroll
                        for (int e = 0; e < 8; ++e) p[e * 64] = (bf16)(cvtpk(v[e], 0.f) & 0xffffu);
                    } else if (mode == 5) {
                        if (cc < 48) { v4u w; w.x = cvtpk(v[0], v[1]); w.y = cvtpk(v[2], v[3]); w.z = cvtpk(v[4], v[5]); w.w = cvtpk(v[6], v[7]);
                            *(v4u*)(base + (size_t)row * 64 + cc) = w; }
                    } else if (ld == 256) {
                        v4u w; w.x = cvtpk(v[0], v[1]); w.y = cvtpk(v[2], v[3]); w.z = cvtpk(v[4], v[5]); w.w = cvtpk(v[6], v[7]);
                        __builtin_nontemporal_store(w, (v4u*)(base + ((size_t)(((row >> 12) * 4 + (cc >> 6)) * 4096 + (row & 4095)) << 6) + (cc & 63)));
                    } else {
                        v4u w; w.x = cvtpk(v[0], v[1]); w.y = cvtpk(v[2], v[3]); w.z = cvtpk(v[4], v[5]); w.w = cvtpk(v[6], v[7]);
                        __builtin_nontemporal_store(w, (v4u*)(base + (size_t)row * ld + cb + cc));
                    }
                }
            }
    }
};

template <int MODE> struct EpiMix {
    static constexpr bool PERM = true, AFTER_DRAIN = false, HAS_MID = (MODE == 1);
    const bf16* P0; const bf16* P1; bf16* O; const float* F0; const float* F1; float* OF; int ld; int ldo;
    __device__ __forceinline__ void mid(pg8::f32x4 (&acc)[2][2][4][2], const pg8::Unit& u, int wr, int wc, int fr, int fq) const {
        const int row0 = u.pm * 256 + wr * 64 + fr;
#pragma unroll
        for (int ai = 0; ai < 2; ++ai) {
            v4u ga[4][2];
#pragma unroll
            for (int m = 0; m < 4; ++m)
#pragma unroll
                for (int bj = 0; bj < 2; ++bj) {
                    const size_t idx = (size_t)(row0 + ai * 128 + m * 16) * ld + u.pn * 256 + bj * 128 + wc * 32 + 8 * fq;
                    ga[m][bj] = *(const v4u*)(P0 + idx);
                }
#pragma unroll
            for (int m = 0; m < 4; ++m)
#pragma unroll
                for (int bj = 0; bj < 2; ++bj) {
                    const unsigned aa[4] = {ga[m][bj].x, ga[m][bj].y, ga[m][bj].z, ga[m][bj].w};
#pragma unroll
                    for (int e = 0; e < 4; ++e) { acc[ai][bj][m][e >> 1][(2 * e) & 3] *= bflo(aa[e]); acc[ai][bj][m][e >> 1][(2 * e + 1) & 3] *= bfhi(aa[e]); }
                }
            __builtin_amdgcn_sched_barrier(0);
        }
    }
    __device__ __forceinline__ void operator()(const pg8::f32x4 (&acc)[2][2][4][2], const pg8::Unit& u, int wr, int wc, int fr, int fq) const {
        const int row0 = u.pm * 256 + wr * 64 + fr;
        f32x4 cv[2][2];
        if (MODE == 0 || MODE == 3) {
#pragma unroll
            for (int bj = 0; bj < 2; ++bj) {
                const int col = u.pn * 256 + bj * 128 + wc * 32 + 8 * fq;
                const float* cp = MODE == 0 ? F0 + col : F1 + (u.pm >> 4) * 6144 + 4096 + col;
                cv[bj][0] = *(const f32x4*)cp; cv[bj][1] = *(const f32x4*)(cp + 4);
            }
        }
#pragma unroll
        for (int ai = 0; ai < 2; ++ai) {
            v4u la[4][2], lb[4][2];
            if (MODE != 3) {
#pragma unroll
                for (int m = 0; m < 4; ++m)
#pragma unroll
                    for (int bj = 0; bj < 2; ++bj) {
                        const size_t idx = (size_t)(row0 + ai * 128 + m * 16) * ld + u.pn * 256 + bj * 128 + wc * 32 + 8 * fq;
                        if (MODE == 0) { la[m][bj] = *(const v4u*)(P0 + idx); lb[m][bj] = *(const v4u*)(P1 + idx); }
                        else if (MODE == 1) { la[m][bj] = *(const v4u*)(P1 + idx); }
                        else { la[m][bj] = *(const v4u*)(P0 + idx); lb[m][bj] = *(const v4u*)(P1 + idx); }
                    }
            }
#pragma unroll
            for (int m = 0; m < 4; ++m) {
                const int row = row0 + ai * 128 + m * 16;
#pragma unroll
                for (int bj = 0; bj < 2; ++bj) {
                    const int col = u.pn * 256 + bj * 128 + wc * 32 + 8 * fq;
                    float v[8];
#pragma unroll
                    for (int e = 0; e < 4; ++e) { v[e] = acc[ai][bj][m][0][e]; v[4 + e] = acc[ai][bj][m][1][e]; }
                    if (MODE == 0) {
                        const v4u y = la[m][bj], z = lb[m][bj];
                        const f32x4 b0 = cv[bj][0], b1 = cv[bj][1];
                        const float bb[8] = {b0.x, b0.y, b0.z, b0.w, b1.x, b1.y, b1.z, b1.w};
                        const unsigned yy[4] = {y.x, y.y, y.z, y.w}, zz[4] = {z.x, z.y, z.z, z.w};
#pragma unroll
                        for (int e = 0; e < 4; ++e) {
                            v[2 * e] = bflo(yy[e]) * sigmoidf_(v[2 * e] + bb[2 * e]) * bflo(zz[e]);
                            v[2 * e + 1] = bfhi(yy[e]) * sigmoidf_(v[2 * e + 1] + bb[2 * e + 1]) * bfhi(zz[e]);
                        }
                    } else if (MODE == 1) {
                        const v4u g = la[m][bj]; const unsigned gg[4] = {g.x, g.y, g.z, g.w};
#pragma unroll
                        for (int e = 0; e < 4; ++e) { v[2 * e] *= bflo(gg[e]); v[2 * e + 1] *= bfhi(gg[e]); }
                    } else if (MODE == 2) {
                        const v4u g = la[m][bj], m1 = lb[m][bj];
                        const unsigned gg[4] = {g.x, g.y, g.z, g.w}, mm[4] = {m1.x, m1.y, m1.z, m1.w};
#pragma unroll
                        for (int e = 0; e < 4; ++e) { v[2 * e] = bflo(mm[e]) + v[2 * e] * bflo(gg[e]); v[2 * e + 1] = bfhi(mm[e]) + v[2 * e + 1] * bfhi(gg[e]); }
                    } else {
                        const f32x4 g0 = cv[bj][0], g1 = cv[bj][1];
                        v[0] *= g0.x; v[1] *= g0.y; v[2] *= g0.z; v[3] *= g0.w; v[4] *= g1.x; v[5] *= g1.y; v[6] *= g1.z; v[7] *= g1.w;
                        if (DBG == 1) {
#pragma unroll
                            for (int e = 0; e < 8; ++e) v[e] = 0.f; }
                    }
                    { v4u w; w.x = cvtpk(v[0], v[1]); w.y = cvtpk(v[2], v[3]); w.z = cvtpk(v[4], v[5]); w.w = cvtpk(v[6], v[7]); *(v4u*)(O + (size_t)row * ldo + col) = w; }
                }
            }
        }
    }
};

__device__ __forceinline__ int win_src_col(int n) {
    const int t = n >> 8, c = n & 255;
    if (n < INB) {
        if (t < 5) return n;
        if (t < 5 + NKVB) return 1280 + 256 * kv_nth(0x1f & ~KV8MASK, t - 5) + c;
        const int t2 = t - 5 - NKVB;
        if (t2 < 12) return 2608 + 256 * t2 + c;
        return c < 48 ? 2560 + c : -1;
    }
    const int t8 = t - INB / 256;
    if (t8 < NKV8) return 1280 + 256 * kv_nth(KV8MASK, t8) + c;
    { const int gt = t8 - NKV8; return c < 128 ? 5680 + 128 * gt + c : 7728 + 128 * gt + (c - 128); }
}
struct TItem { const float* src; unsigned char* dst; int N, sc; bool f8; };
__device__ __forceinline__ void titem_load(const TItem& T, f32x4 (&v)[16]) {
#pragma unroll
    for (int i = 0; i < 16; ++i) v[i] = (T.sc >= 0) ? *(const f32x4*)(T.src + (size_t)(4 * i) * T.N) : (f32x4){0.f, 0.f, 0.f, 0.f};
}
__device__ __forceinline__ void titem_store(const TItem& T, const f32x4 (&v)[16], LAS float* scr, int lane) {
    const int ksub = lane >> 4, n4 = 4 * (lane & 15);
    const bool f8 = T.f8;
    v4u o[8];
#pragma unroll
    for (int h = 0; h < 2; ++h) {
#pragma unroll
        for (int i = 0; i < 8; ++i) *(LAS f32x4*)(scr + (4 * i + ksub) * 68 + n4) = v[8 * h + i];
        LDS_WAIT(); asm volatile("" ::: "memory");
        if (f8) {
            unsigned wd[8];
#pragma unroll
            for (int c = 0; c < 8; ++c) { const LAS float* s = scr + (4 * c) * 68 + lane;
                int t = __builtin_amdgcn_cvt_pk_fp8_f32(s[0 * 68] * 32.f, s[1 * 68] * 32.f, 0, false); t = __builtin_amdgcn_cvt_pk_fp8_f32(s[2 * 68] * 32.f, s[3 * 68] * 32.f, t, true); wd[c] = (unsigned)t; }
            o[2 * h] = (v4u){wd[0], wd[1], wd[2], wd[3]}; o[2 * h + 1] = (v4u){wd[4], wd[5], wd[6], wd[7]};
        } else {
#pragma unroll
            for (int c = 0; c < 4; ++c) { const LAS float* s = scr + (8 * c) * 68 + lane;
                o[4 * h + c].x = cvtpk(s[0 * 68], s[1 * 68]); o[4 * h + c].y = cvtpk(s[2 * 68], s[3 * 68]); o[4 * h + c].z = cvtpk(s[4 * 68], s[5 * 68]); o[4 * h + c].w = cvtpk(s[6 * 68], s[7 * 68]); }
        }
        LDS_WAIT(); asm volatile("" ::: "memory");
    }
    v4u* wp = (v4u*)T.dst;
    if (f8) {
#pragma unroll
        for (int c = 0; c < 4; ++c) wp[c] = o[c];
    } else {
#pragma unroll
        for (int c = 0; c < 8; ++c) wp[c] = o[c];
    }
}

__device__ __forceinline__ void phase0(const Ctx& C) {
    LAS float* scr = (LAS float*)(C.lds + C.wave * 16384);
    const int gw = C.bid * NWAVES + C.wave, NGW = C.G * NWAVES, lane = C.lane;
    const int NGV = (C.G >= 192) ? 96 : 0;
    if (C.bid < 96 && (NGV || C.bid == 0)) {
        const float* cvec = inp(C, 1); const float* wada = inp(C, 2); float* modp = WSP(float, WS_MODP);
        for (int u = C.bid; u < 96; u += (NGV ? 96 : 1)) {
            const int nc = u % 24, kq = u / 24;
            const int n0 = nc * 256 + 4 * lane, kb = kq * 512 + C.wave * 64;
            f32x4 a0 = {0, 0, 0, 0}, a1 = a0, a2 = a0, a3 = a0;
#pragma unroll 16
            for (int k = kb; k < kb + 64; ++k) {
                const f32x4 w = *(const f32x4*)(wada + (size_t)k * 6144 + n0);
                a0 += w * cvec[k]; a1 += w * cvec[2048 + k]; a2 += w * cvec[4096 + k]; a3 += w * cvec[6144 + k];
            }
            LAS f32x4* part = (LAS f32x4*)C.lds;
            part[(C.wave * 4 + 0) * 64 + lane] = a0; part[(C.wave * 4 + 1) * 64 + lane] = a1; part[(C.wave * 4 + 2) * 64 + lane] = a2; part[(C.wave * 4 + 3) * 64 + lane] = a3;
            __syncthreads();
            if (C.wave < 4) {
                f32x4 s = part[C.wave * 64 + lane];
#pragma unroll
                for (int w8 = 1; w8 < 8; ++w8) s += part[(w8 * 4 + C.wave) * 64 + lane];
                *(f32x4*)(modp + (size_t)(kq * 4 + C.wave) * 6144 + n0) = s;
                asm volatile("s_waitcnt vmcnt(0)" ::: "memory");
            }
            __syncthreads();
            counter_signal(C, CW_GEMV);
        }
    }
    {
        constexpr int I_IN = 32 * (INWP / 64), I_GLU = 16 * 16, I_BN = 16 * 32, I_OUT = 32 * 32, I_C1 = 32 * 2, I_C2 = 2 * 1;
        constexpr int NIT = I_IN + I_GLU + 2 * I_BN + I_OUT + 2 * I_C1 + 2 * I_C2;
        constexpr int QG = 2;
        const int NGW_G = NGV * NWAVES, NGWC = (C.G - NGV) * NWAVES, NG_IT = QG * NGW_G;
        int it, iend, istep;
        if (C.bid >= NGV) { it = NG_IT + (C.bid - NGV) * NWAVES + C.wave; iend = NIT; istep = NGWC; }
        else { it = C.bid * NWAVES + C.wave; iend = NG_IT; istep = NGW_G; }
        auto decode = [&](int item) -> TItem {
            int r = item; const float* W; int N, NP, ldk, koff = 0; size_t wo; bool win = false;
            if (r < I_IN) { W = inp(C, 4); N = INW; NP = INWP; ldk = 2048; wo = WS_WIN; win = true; }
            else if ((r -= I_IN) < I_GLU) { W = inp(C, 20); N = 1024; NP = 1024; ldk = 1024; wo = WS_WGLU; }
            else if ((r -= I_GLU) < I_BN) { W = inp(C, 22); N = 2048; NP = 2048; ldk = 2048; wo = WS_WBN; }
            else if ((r -= I_BN) < I_BN) { W = inp(C, 23); N = 2048; NP = 2048; ldk = 2048; koff = 1024; wo = WS_WBN; }
            else if ((r -= I_BN) < I_OUT) { W = inp(C, 24); N = 2048; NP = 2048; ldk = 2048; wo = WS_WOUT; }
            else if ((r -= I_OUT) < I_C1) { W = inp(C, 8); N = 128; NP = 128; ldk = 2048; wo = WS_WK1; }
            else if ((r -= I_C1) < I_C1) { W = inp(C, 10); N = 128; NP = 128; ldk = 2048; wo = WS_WV1; }
            else if ((r -= I_C1) < I_C2) { W = inp(C, 9); N = 64; NP = 64; ldk = 128; wo = WS_WK2; }
            else { r -= I_C2; W = inp(C, 11); N = 64; NP = 64; ldk = 128; wo = WS_WV2; }
            const int nblk = NP / 64, kb = r / nblk, nb = r - kb * nblk, k0 = 64 * kb, n0 = 64 * nb;
            const int nn = n0 + 4 * (lane & 15); const int sc = win ? win_src_col(nn) : nn;
            TItem T; T.N = N; T.sc = sc; T.f8 = win && n0 >= INB;
            T.src = W + (size_t)(k0 + (lane >> 4)) * N + (sc >= 0 ? sc : 0);
            T.dst = T.f8 ? C.ws + WS_W8 + (size_t)(n0 - INB + lane) * 2048 + k0 : C.ws + wo + ((size_t)(n0 + lane) * ldk + koff + k0) * 2;
            return T;
        };
        if (it < iend) {
            TItem T = decode(it);
            f32x4 v[16];
            titem_load(T, v);
            for (; it < iend; it += istep) {
                const bool more = it + istep < iend;
                TItem Tn = T; f32x4 nv[16];
                if (more) { Tn = decode(it + istep); titem_load(Tn, nv); }
                titem_store(T, v, scr, lane);
                if (more) {
#pragma unroll
                    for (int i = 0; i < 16; ++i) v[i] = nv[i];
                    T = Tn;
                }
            }
        }
    }
    if (C.bid == C.G - 1) {
        const float* rb = inp(C, 5); float* lut = WSP(float, WS_LUT);
        for (int i = C.tid; i < 16 * 128; i += NTHR) {
            const int h = i >> 7, d = i & 127; int bk;
            if (d < 16) bk = d; else { const float v = logf((float)d / 16.f) / 2.0794415416798357f * 16.f; bk = 16 + (int)v; if (bk > 31) bk = 31; }
            lut[i] = rb[bk * 16 + h];
        }
    }
}

__device__ __forceinline__ void phase1(const Ctx& C) {
    const int gw = C.bid * NWAVES + C.wave, NGW = C.G * NWAVES, lane = C.lane;
    const float* x = inp(C, 0); bf16* H = WSP(bf16, WS_H);
    const float* modp = WSP(const float, WS_MODP); const float* bada = inp(C, 3);
#define MOD4(b_, o_) ({ const int o4_ = (o_); f32x4 s_ = *(const f32x4*)(bada + o4_); \
        s_ += *(const f32x4*)(modp + (size_t)(0 * 4 + (b_)) * 6144 + o4_); s_ += *(const f32x4*)(modp + (size_t)(1 * 4 + (b_)) * 6144 + o4_); \
        s_ += *(const f32x4*)(modp + (size_t)(2 * 4 + (b_)) * 6144 + o4_); s_ += *(const f32x4*)(modp + (size_t)(3 * 4 + (b_)) * 6144 + o4_); s_; })
    for (int gq = gw; gq < 32; gq += NGW) {
        const int b = gq >> 3, o = 4096 + (gq & 7) * 256 + 4 * lane;
        *(f32x4*)(WSP(float, WS_MOD) + b * 6144 + o) = MOD4(b, o);
    }
    if (NGW == 2048) {
        const int b = gw & 3, r0 = gw >> 2;
        f32x4 sh[8], sc[8];
#pragma unroll
        for (int j = 0; j < 8; ++j) { sh[j] = MOD4(b, 4 * (lane + 64 * j)); const f32x4 g = MOD4(b, 2048 + 4 * (lane + 64 * j)); sc[j] = g + 1.f; }
        f32x4 v[8];
        { const f32x4* xr = (const f32x4*)(x + (size_t)(b * SEQ + r0) * DM) + lane;
#pragma unroll
          for (int j = 0; j < 8; ++j) v[j] = __builtin_nontemporal_load(xr + 64 * j); }
        for (int k = 0; k < 8; ++k) {
            const int m = b * SEQ + r0 + 512 * k;
            f32x4 nv[8];
            { const int mn = (k < 7) ? m + 512 : m; const f32x4* xr = (const f32x4*)(x + (size_t)mn * DM) + lane;
#pragma unroll
              for (int j = 0; j < 8; ++j) nv[j] = __builtin_nontemporal_load(xr + 64 * j); }
            float s = 0.f;
#pragma unroll
            for (int j = 0; j < 8; ++j) s += (v[j].x + v[j].y) + (v[j].z + v[j].w);
            const float mean = wave_sum(s) * (1.f / DM); float s2 = 0.f;
#pragma unroll
            for (int j = 0; j < 8; ++j) { v[j] = v[j] - mean; s2 += (v[j].x * v[j].x + v[j].y * v[j].y) + (v[j].z * v[j].z + v[j].w * v[j].w); }
            const float rstd = 1.f / sqrtf(wave_sum(s2) * (1.f / DM) + LN_EPS);
            u32x2* o8 = (u32x2*)(H + (size_t)m * DM) + lane;
#pragma unroll
            for (int j = 0; j < 8; ++j) {
                const f32x4 hh = v[j] * rstd * sc[j] + sh[j];
                u32x2 w; w.x = cvtpk(hh.x, hh.y); w.y = cvtpk(hh.z, hh.w); o8[64 * j] = w;
                int t8 = __builtin_amdgcn_cvt_pk_fp8_f32(hh.x, hh.y, 0, false); t8 = __builtin_amdgcn_cvt_pk_fp8_f32(hh.z, hh.w, t8, true);
                ((unsigned*)(C.ws + WS_OAB + (size_t)m * DM))[lane + 64 * j] = (unsigned)t8;
            }
#pragma unroll
            for (int j = 0; j < 8; ++j) v[j] = nv[j];
        }
    } else
    {
        f32x4 v[8];
        if (gw < MTOK) { const f32x4* xr = (const f32x4*)(x + (size_t)gw * DM) + lane;
#pragma unroll
            for (int j = 0; j < 8; ++j) v[j] = xr[64 * j]; }
        for (int m = gw; m < MTOK; m += NGW) {
            const int b = m >> 12;
            f32x4 nv[8];
            { const int mn = (m + NGW < MTOK) ? m + NGW : m; const f32x4* xr = (const f32x4*)(x + (size_t)mn * DM) + lane;
#pragma unroll
              for (int j = 0; j < 8; ++j) nv[j] = xr[64 * j]; }
            float s = 0.f;
#pragma unroll
            for (int j = 0; j < 8; ++j) s += (v[j].x + v[j].y) + (v[j].z + v[j].w);
            const float mean = wave_sum(s) * (1.f / DM); float s2 = 0.f;
#pragma unroll
            for (int j = 0; j < 8; ++j) { v[j] = v[j] - mean; s2 += (v[j].x * v[j].x + v[j].y * v[j].y) + (v[j].z * v[j].z + v[j].w * v[j].w); }
            const float rstd = 1.f / sqrtf(wave_sum(s2) * (1.f / DM) + LN_EPS);

            u32x2* o8 = (u32x2*)(H + (size_t)m * DM) + lane;
#pragma unroll
            for (int j = 0; j < 8; ++j) {
                const f32x4 a = MOD4(b, 4 * (lane + 64 * j)), g = MOD4(b, 2048 + 4 * (lane + 64 * j));
                const float h0 = v[j].x * rstd * (1.f + g.x) + a.x, h1 = v[j].y * rstd * (1.f + g.y) + a.y, h2 = v[j].z * rstd * (1.f + g.z) + a.z, h3 = v[j].w * rstd * (1.f + g.w) + a.w;
                u32x2 w; w.x = cvtpk(h0, h1); w.y = cvtpk(h2, h3); o8[64 * j] = w;
            }
#pragma unroll
            for (int j = 0; j < 8; ++j) v[j] = nv[j];
        }
    }
    for (int it = C.bid; it < 256; it += C.G) {
        const int kv = it >> 7, uu = it & 127; const float* pos = inp(C, kv ? 7 : 6); const float* w1 = inp(C, kv ? 10 : 8);
        float s = 0.f;
#pragma unroll
        for (int i = 0; i < 4; ++i) { const int k = 256 * C.wave + lane + 64 * i; s += pos[k] * w1[(size_t)k * 128 + uu]; }
        s = wave_sum(s);
        LAS float* red = (LAS float*)C.lds;
        if (lane == 0) red[C.wave] = s;
        __syncthreads();
        if (C.tid == 0) { float t = red[0]; for (int w8 = 1; w8 < 8; ++w8) t += red[w8]; WSP(float, WS_BP)[it] = t; }
        __syncthreads();
    }
}

__device__ __forceinline__ void phase_ln_out(const Ctx& C) {
    const int gw = C.bid * NWAVES + C.wave, NGW = C.G * NWAVES, lane = C.lane;
    const float* x = inp(C, 0); const float* lg = inp(C, 25); const float* lb = inp(C, 26); const bf16* GY = WSP(bf16, WS_Q);
    f32x4 v[8]; u32x2 y[8];
    f32x4 lgv[8], lbv[8];
#pragma unroll
    for (int j = 0; j < 8; ++j) { lgv[j] = ((const f32x4*)lg)[lane + 64 * j]; lbv[j] = ((const f32x4*)lb)[lane + 64 * j]; }
    if (gw < MTOK) { const f32x4* xr = (const f32x4*)(x + (size_t)gw * DM) + lane; const u32x2* yr = (const u32x2*)(GY + (size_t)gw * DM) + lane;
#pragma unroll
        for (int j = 0; j < 8; ++j) { v[j] = __builtin_nontemporal_load(xr + 64 * j); y[j] = yr[64 * j]; } }
    for (int m = gw; m < MTOK; m += NGW) {
        f32x4* zr = (f32x4*)(C.out + (size_t)m * DM) + lane;
        f32x4 nv[8]; u32x2 ny[8];
        { const int mn = (m + NGW < MTOK) ? m + NGW : m; const f32x4* xn = (const f32x4*)(x + (size_t)mn * DM) + lane; const u32x2* yn = (const u32x2*)(GY + (size_t)mn * DM) + lane;
#pragma unroll
          for (int j = 0; j < 8; ++j) { nv[j] = __builtin_nontemporal_load(xn + 64 * j); ny[j] = yn[64 * j]; } }
        float s = 0.f;
#pragma unroll
        for (int j = 0; j < 8; ++j) { v[j].x = DN_ALPHA * v[j].x + bflo(y[j].x); v[j].y = DN_ALPHA * v[j].y + bfhi(y[j].x); v[j].z = DN_ALPHA * v[j].z + bflo(y[j].y); v[j].w = DN_ALPHA * v[j].w + bfhi(y[j].y);
            s += (v[j].x + v[j].y) + (v[j].z + v[j].w); }
        const float mean = wave_sum(s) * (1.f / DM); float s2 = 0.f;
#pragma unroll
        for (int j = 0; j < 8; ++j) { v[j] = v[j] - mean; s2 += (v[j].x * v[j].x + v[j].y * v[j].y) + (v[j].z * v[j].z + v[j].w * v[j].w); }
        const float rstd = 1.f / sqrtf(wave_sum(s2) * (1.f / DM) + LN_EPS);
#pragma unroll
        for (int j = 0; j < 8; ++j) {
            const f32x4 g = lgv[j], bb = lbv[j];
            f32x4 o; o.x = v[j].x * rstd * g.x + bb.x; o.y = v[j].y * rstd * g.y + bb.y; o.z = v[j].z * rstd * g.z + bb.z; o.w = v[j].w * rstd * g.w + bb.w;
            __builtin_nontemporal_store(o, zr + 64 * j);
        }
#pragma unroll
        for (int j = 0; j < 8; ++j) { v[j] = nv[j]; y[j] = ny[j]; }
    }
}

constexpr int HS = 136;
constexpr int SSM_HS_OFF = 0, SSM_EL_OFF = 8 * 16 * HS * 2, SSM_SH_OFF = SSM_EL_OFF + 32 * 64 * 8;
typedef float f32x2v __attribute__((ext_vector_type(2)));
template <bool FINAL>
__device__ __forceinline__ void ssm_pass(const Ctx& C, int b, int g, const bf16x8 (&Bf)[8], const bf16x8 (&Cf)[4], const float (&lr)[4], const float (&li)[4],
                                         float (&hr)[4], float (&hi)[4], const float (&dskip)[4]) {
    const int lane = C.lane, c16 = lane & 15, q = lane >> 4, w = C.wave;
    const bf16* US = WSP(bf16, WS_US);
    LAS unsigned* Hs = (LAS unsigned*)(C.lds + SSM_HS_OFF + w * (16 * HS * 2));
    const size_t row0 = (size_t)(b * SEQ + 512 * w + 128 * (c16 >> 2) + (c16 & 3));
    const bf16* uptr = US + row0 * 1024 + g * 16 + 8 * (q & 1);
    const bf16* qptr = US + row0 * 1024 + g * 16 + 4 * q;
    constexpr int PG = 4;
    bf16x8 An[PG]; u32x2 un[PG];
#pragma unroll
    for (int i = 0; i < PG; ++i) { An[i] = *(const bf16x8*)(uptr + (size_t)i * 4096); un[i] = FINAL ? *(const u32x2*)(qptr + (size_t)i * 4096) : (u32x2){0u, 0u}; }
#pragma unroll 1
    for (int sg = 0; sg < 32 / PG; ++sg) {
        bf16x8 Ac[PG]; u32x2 uc[PG];
#pragma unroll
        for (int i = 0; i < PG; ++i) { Ac[i] = An[i]; uc[i] = un[i]; }
        { const int sn = (sg + 1 < 32 / PG) ? sg + 1 : sg;
#pragma unroll
          for (int i = 0; i < PG; ++i) { An[i] = *(const bf16x8*)(uptr + (size_t)(PG * sn + i) * 4096); un[i] = FINAL ? *(const u32x2*)(qptr + (size_t)(PG * sn + i) * 4096) : (u32x2){0u, 0u}; } }
#pragma unroll
        for (int si = 0; si < PG; ++si) {
            bf16x8 Af = Ac[si];
            if (q >= 2) Af = (bf16x8){0, 0, 0, 0, 0, 0, 0, 0};
            f32x4 d[8];
#pragma unroll
            for (int nt = 0; nt < 8; ++nt) d[nt] = mfma16(Af, Bf[nt], (f32x4){0.f, 0.f, 0.f, 0.f});
#pragma unroll
            for (int i = 0; i < 4; ++i)
#pragma unroll
                for (int nt = 0; nt < 4; ++nt) {
                    const float tr = __builtin_fmaf(lr[nt], hr[nt], __builtin_fmaf(-li[nt], hi[nt], d[nt][i])); hi[nt] = __builtin_fmaf(lr[nt], hi[nt], __builtin_fmaf(li[nt], hr[nt], d[nt + 4][i])); hr[nt] = tr;
                    asm("" : "+v"(hr[nt]), "+v"(hi[nt]));
                    if (FINAL) Hs[(4 * q + i) * (HS / 2) + 16 * nt + c16] = cvtpk(hr[nt], hi[nt]);
                }
            if (FINAL) {
                LDS_WAIT(); asm volatile("" ::: "memory");
                f32x4 y = {0.f, 0.f, 0.f, 0.f};
#pragma unroll
                for (int ks = 0; ks < 4; ++ks) { const bf16x8 hb = *(const LAS bf16x8*)((const LAS unsigned char*)Hs + c16 * (HS * 2) + (32 * ks + 8 * q) * 2); y = mfma16(Cf[ks], hb, y); }
                const u32x2 uq = uc[si];
                const float o0 = gelu_tanh(y[0] + dskip[0] * bflo(uq.x)), o1 = gelu_tanh(y[1] + dskip[1] * bfhi(uq.x));
                const float o2 = gelu_tanh(y[2] + dskip[2] * bflo(uq.y)), o3 = gelu_tanh(y[3] + dskip[3] * bfhi(uq.y));
                u32x2 ov; ov.x = cvtpk(o0, o1); ov.y = cvtpk(o2, o3);
                *(u32x2*)(WSP(bf16, WS_H) + (row0 + (size_t)(4 * (PG * sg + si))) * 1024 + g * 16 + 4 * q) = ov;
                LDS_WAIT(); asm volatile("" ::: "memory");
            }
        }
    }
}

__device__ __forceinline__ void ssm_item(const Ctx& C, int item) {
    const int lane = C.lane, c16 = lane & 15, q = lane >> 4, w = C.wave;
    const int g = item & 63, b = item >> 6;
    if (DBGT >= 40 && C.bid == 0 && C.tid == 0) { volatile LAS unsigned long long* TSX = (volatile LAS unsigned long long*)(C.lds + RING_BYTES + 1024); TSX[47] = __builtin_amdgcn_s_memrealtime(); }
    const float* a_re = inp(C, 12); const float* a_im = inp(C, 13); const float* log_dt = inp(C, 14);
    const float* b_re = inp(C, 15); const float* b_im = inp(C, 16); const float* c_re = inp(C, 17); const float* c_im = inp(C, 18); const float* dsk = inp(C, 19);
    LAS f32x2v* EL = (LAS f32x2v*)(C.lds + SSM_EL_OFF); LAS bf16x8* SH = (LAS bf16x8*)(C.lds + SSM_SH_OFF);
    const float ldt = log_dt[g];
    float ar[4], ai[4];
#pragma unroll
    for (int nt = 0; nt < 4; ++nt) { ar[nt] = a_re[g * 64 + 16 * nt + c16]; ai[nt] = a_im[g * 64 + 16 * nt + c16]; }
    const int ntw = w & 3, ps = g * 64 + 16 * ntw + c16;
    f32x4 r0 = {0.f, 0.f, 0.f, 0.f}, r1 = r0, i0 = r0, i1 = r0;
    if (q < 2) { r0 = *(const f32x4*)(b_re + (size_t)ps * 16 + 8 * q); r1 = *(const f32x4*)(b_re + (size_t)ps * 16 + 8 * q + 4);
                 i0 = *(const f32x4*)(b_im + (size_t)ps * 16 + 8 * q); i1 = *(const f32x4*)(b_im + (size_t)ps * 16 + 8 * q + 4); }
    f32x4 vr = {0.f, 0.f, 0.f, 0.f}, vi = vr;
    if (w < 4) { const size_t o = (size_t)(g * 16 + c16) * 64 + 16 * w + 4 * q; vr = *(const f32x4*)(c_re + o); vi = *(const f32x4*)(c_im + o); }
    const f32x4 dv = *(const f32x4*)(dsk + g * 16 + 4 * q);
    const float dt = __expf(ldt);
    float lr[4], li[4], fr[4], fi[4];
#pragma unroll
    for (int nt = 0; nt < 4; ++nt) {
        const float mag = __expf(ar[nt] * dt); lr[nt] = mag * __cosf(ai[nt] * dt); li[nt] = mag * __sinf(ai[nt] * dt);
        const float den = ar[nt] * ar[nt] + ai[nt] * ai[nt], nr = lr[nt] - 1.f, ni = li[nt];
        fr[nt] = (nr * ar[nt] + ni * ai[nt]) / den; fi[nt] = (ni * ar[nt] - nr * ai[nt]) / den;
    }
    {
        float frw = fr[0], fiw = fi[0];
#pragma unroll
        for (int nt = 1; nt < 4; ++nt) if (ntw == nt) { frw = fr[nt]; fiw = fi[nt]; }
        const float ca = (w >= 4) ? fiw : frw, cb = (w >= 4) ? frw : -fiw;
        bf16x8 f = pack8(ca * r0.x + cb * i0.x, ca * r0.y + cb * i0.y, ca * r0.z + cb * i0.z, ca * r0.w + cb * i0.w, ca * r1.x + cb * i1.x, ca * r1.y + cb * i1.y, ca * r1.z + cb * i1.z, ca * r1.w + cb * i1.w);
        if (q >= 2) f = (bf16x8){0, 0, 0, 0, 0, 0, 0, 0};
        SH[w * 64 + lane] = f;
        if (w < 4) SH[(8 + w) * 64 + lane] = pack8(vr.x, -vi.x, vr.y, -vi.y, vr.z, -vi.z, vr.w, -vi.w);
    }
    __syncthreads();
    bf16x8 Bf[8], Cf[4];
#pragma unroll
    for (int nt = 0; nt < 8; ++nt) Bf[nt] = SH[nt * 64 + lane];
#pragma unroll
    for (int ks = 0; ks < 4; ++ks) Cf[ks] = SH[(8 + ks) * 64 + lane];
    const float dskip[4] = {dv.x, dv.y, dv.z, dv.w};
    float hr[4] = {0.f, 0.f, 0.f, 0.f}, hi[4] = {0.f, 0.f, 0.f, 0.f};
    if (DBGT >= 40 && C.bid == 0 && C.tid == 0) { volatile LAS unsigned long long* TSX = (volatile LAS unsigned long long*)(C.lds + RING_BYTES + 1024); const unsigned long long tn = __builtin_amdgcn_s_memrealtime(); TSX[42] += tn - TSX[47]; TSX[47] = tn; }
    ssm_pass<false>(C, b, g, Bf, Cf, lr, li, hr, hi, dskip);
    if (DBGT >= 40 && C.bid == 0 && C.tid == 0) { volatile LAS unsigned long long* TSX = (volatile LAS unsigned long long*)(C.lds + RING_BYTES + 1024); const unsigned long long tn = __builtin_amdgcn_s_memrealtime(); TSX[43] += tn - TSX[47]; TSX[47] = tn; }
    const int sc = 4 * w + q;
#pragma unroll
    for (int nt = 0; nt < 4; ++nt) EL[sc * 64 + 16 * nt + c16] = (f32x2v){hr[nt], hi[nt]};
    __syncthreads();
    {
        float Lr[4], Li[4];
#pragma unroll
        for (int nt = 0; nt < 4; ++nt) { Lr[nt] = lr[nt]; Li[nt] = li[nt];
#pragma unroll
            for (int s = 0; s < 7; ++s) { const float t = Lr[nt] * Lr[nt] - Li[nt] * Li[nt]; Li[nt] = 2.f * Lr[nt] * Li[nt]; Lr[nt] = t; } }
#pragma unroll
        for (int nt = 0; nt < 4; ++nt) { hr[nt] = 0.f; hi[nt] = 0.f; }
        for (int cc = 0; cc < 31; ++cc) {
            if (cc < sc) {
#pragma unroll
                for (int nt = 0; nt < 4; ++nt) { const f32x2v e = EL[cc * 64 + 16 * nt + c16];
                    const float t = Lr[nt] * hr[nt] - Li[nt] * hi[nt] + e.x; hi[nt] = Lr[nt] * hi[nt] + Li[nt] * hr[nt] + e.y; hr[nt] = t; }
            }
        }
    }
    if (DBGT >= 40 && C.bid == 0 && C.tid == 0) { volatile LAS unsigned long long* TSX = (volatile LAS unsigned long long*)(C.lds + RING_BYTES + 1024); const unsigned long long tn = __builtin_amdgcn_s_memrealtime(); TSX[44] += tn - TSX[47]; TSX[47] = tn; }
    ssm_pass<true>(C, b, g, Bf, Cf, lr, li, hr, hi, dskip);
    asm volatile("s_waitcnt vmcnt(0)" ::: "memory");
    __syncthreads();
    counter_signal(C, CW_SSM);
    if (DBGT >= 40 && C.bid == 0 && C.tid == 0) { volatile LAS unsigned long long* TSX = (volatile LAS unsigned long long*)(C.lds + RING_BYTES + 1024); const unsigned long long tn = __builtin_amdgcn_s_memrealtime(); TSX[45] += tn - TSX[47]; TSX[47] = tn; }
}

__device__ __forceinline__ void compress_item(const Ctx& C, int item) {
    const int lane = C.lane, w = C.wave, c16 = lane & 15, q = lane >> 4, tid = C.tid;
    const int ntp = item & 7, g = (item >> 3) & 3, b = (item >> 5) & 3, kv = item >> 7;
    const bf16* SRC = kv ? WSP(bf16, WS_VCI) : WSP(bf16, WS_KCI);
    const bf16* W1 = kv ? WSP(bf16, WS_WV1) : WSP(bf16, WS_WK1);
    const bf16* W2 = kv ? WSP(bf16, WS_WV2) : WSP(bf16, WS_WK2);
    const float* bp = WSP(float, WS_BP) + kv * 128;
    LAS bf16* Hid = (LAS bf16*)C.lds;
    LAS unsigned char* As = C.lds + 8960;
    {
        const bf16* src = SRC + ((size_t)((b * 4 + g) * 4096) << 6);
#pragma unroll
        for (int i = 0; i < 9; ++i) {
            const int id = tid + 512 * i;
            if (id < 528 * 8) { const int r = id >> 3, cc = id & 7; int tok = 512 * ntp + r; tok = tok > SEQ - 1 ? SEQ - 1 : tok;
                *(LAS v4u*)(As + r * 128 + ((cc ^ ((r >> 4) & 7)) << 4)) = *(const v4u*)(src + (size_t)tok * 64 + cc * 8); }
        }
    }
    const bf16* brow = W1 + (size_t)(16 * w + c16) * 2048 + 8 * q;
    f32x4 acc0 = {0.f, 0.f, 0.f, 0.f}, acc1 = acc0;
    __syncthreads();
#pragma unroll 1
    for (int kb = 0; kb < 2; ++kb) {
        bf16x8 bb[32];
#pragma unroll
        for (int k2 = 0; k2 < 32; ++k2) bb[k2] = *(const bf16x8*)(brow + 32 * (32 * kb + k2));
#pragma unroll
        for (int k2 = 0; k2 < 32; ++k2) {
            const int ks = 32 * kb + k2, cc = 4 * (ks & 1) + q;
            const int r0 = 16 * c16 + (ks >> 1), r1 = r0 + 256;
            const bf16x8 a0 = *(const LAS bf16x8*)(As + r0 * 128 + ((cc ^ ((r0 >> 4) & 7)) << 4));
            const bf16x8 a1 = *(const LAS bf16x8*)(As + r1 * 128 + ((cc ^ ((r1 >> 4) & 7)) << 4));
            acc0 = mfma16(a0, bb[k2], acc0); acc1 = mfma16(a1, bb[k2], acc1);
        }
    }
    { const float bias = bp[16 * w + c16];
#pragma unroll
      for (int i = 0; i < 4; ++i) { Hid[(4 * q + i) * HS + 16 * w + c16] = (bf16)(cvtpk(gelu_tanh(acc0[i] + bias), 0.f) & 0xffffu);
                                    Hid[(16 + 4 * q + i) * HS + 16 * w + c16] = (bf16)(cvtpk(gelu_tanh(acc1[i] + bias), 0.f) & 0xffffu); } }
    __syncthreads();
    {
        const int rt = w >> 2, ct = w & 3;
        f32x4 o = {0.f, 0.f, 0.f, 0.f};
#pragma unroll
        for (int ks = 0; ks < 4; ++ks) {
            const bf16x8 a = *(const LAS bf16x8*)(Hid + (16 * rt + c16) * HS + 32 * ks + 8 * q);
            const bf16x8 bb = *(const bf16x8*)(W2 + (size_t)(16 * ct + c16) * 128 + 32 * ks + 8 * q);
            o = mfma16(a, bb, o);
        }
        const int dim = 16 * ct + c16, n0 = 32 * ntp + 16 * rt + 4 * q;
        float ov[4];
#pragma unroll
        for (int i = 0; i < 4; ++i) ov[i] = (n0 + i < 255) ? o[i] : 0.f;
        if (kv == 0) {
            bf16* kc = WSP(bf16, WS_KC) + (size_t)((b * 4 + g) * 256) * 64;
#pragma unroll
            for (int i = 0; i < 4; ++i) kc[(size_t)(n0 + i) * 64 + dim] = (bf16)(cvtpk(ov[i], 0.f) & 0xffffu);
        } else {
            bf16* vc = WSP(bf16, WS_VCT) + (size_t)((b * 4 + g) * 64 + dim) * 256 + n0;
            u32x2 wv; wv.x = cvtpk(ov[0], ov[1]); wv.y = cvtpk(ov[2], ov[3]); *(u32x2*)vc = wv;
        }
    }
    asm volatile("s_waitcnt vmcnt(0)" ::: "memory");
    __syncthreads();
    counter_signal(C, CW_CMP + 16 * (b * 4 + g));
}

constexpr int A_KC = 0, A_VCT = 36864;
constexpr int A_OS = 0;
constexpr int A_IMP = 70656, A_QS = 70656;
constexpr int A_KB = 107520, A_VB = 125952;
constexpr int A_ML = 144384;
#ifndef NOLOCK
#define NOLOCK 0
#endif
constexpr int A_LOCK = RING_BYTES + 768, A_TKT = RING_BYTES + 776;
constexpr int A_LUT = 152576, A_SEL = A_LUT + 2112, A_END = A_SEL + 512;
static_assert(A_ML + 8192 <= A_LUT && A_END <= RING_BYTES, "attention LDS map");
constexpr int KROW = 144, VCROW = 528, VROW = 144, KBUF = 64 * KROW, VBUF = 64 * VROW, LUTS = 132, OSROW = 272;
constexpr float NEG_BIG = -1e30f, LOG2E = 1.4426950408889634f;
#define NEG_INF (-__builtin_inff())

__device__ __forceinline__ float max16(const f32x4 (&s)[4]) {
    float a = fmaxf(fmaxf(s[0].x, s[0].y), fmaxf(s[0].z, s[0].w)), b = fmaxf(fmaxf(s[1].x, s[1].y), fmaxf(s[1].z, s[1].w));
    float c = fmaxf(fmaxf(s[2].x, s[2].y), fmaxf(s[2].z, s[2].w)), d = fmaxf(fmaxf(s[3].x, s[3].y), fmaxf(s[3].z, s[3].w));
    return fmaxf(fmaxf(a, b), fmaxf(c, d));
}

template <int MODE>
__device__ __forceinline__ void far_unit(LAS unsigned char* lds, const bf16x8 (&Kf)[4][2], const bf16x8 (&Vf)[2][4], const LAS float* lutx,
                                         int qi, int tqv, bool valid, int kpos0, float bfar, int q, int r, unsigned long long lockbits, bool lane0) {
    const bf16x8 q0 = *(const LAS bf16x8*)(lds + A_QS + qi * KROW + q * 16), q1 = *(const LAS bf16x8*)(lds + A_QS + qi * KROW + 64 + q * 16);
    LAS float* ml = (LAS float*)(lds + A_ML) + qi * 8;
    LAS float* os = (LAS float*)(lds + A_OS + qi * OSROW + q * 16);
    const float m_ref = ml[4];
    f32x4 s[4];
#pragma unroll
    for (int kt = 0; kt < 4; ++kt) { s[kt] = mfma16(Kf[kt][0], q0, (f32x4){0.f, 0.f, 0.f, 0.f}); s[kt] = mfma16(Kf[kt][1], q1, s[kt]); }
    float cadd = valid ? 0.f : NEG_INF;
    if (MODE == 0) cadd += bfar * LOG2E;
    else {
        const int dq = tqv - kpos0 - 4 * q;
#pragma unroll
        for (int kt = 0; kt < 4; ++kt)
#pragma unroll
            for (int i = 0; i < 4; ++i) { const int d = dq - 16 * kt - i; int dc = d < -1 ? -1 : d; dc = dc > 127 ? 127 : dc; s[kt][i] += lutx[r * LUTS + 1 + dc]; }
    }
    const float cc = cadd - m_ref * LOG2E;
    float ps = 0.f;
#pragma unroll
    for (int kt = 0; kt < 4; ++kt)
#pragma unroll
        for (int i = 0; i < 4; ++i) { const float e = __builtin_amdgcn_exp2f(fminf(__builtin_fmaf(s[kt][i], LOG2E, cc), 80.f)); s[kt][i] = e; ps += e; }
    f32x4 O[4];
#pragma unroll
    for (int mt = 0; mt < 4; ++mt) O[mt] = (f32x4){0.f, 0.f, 0.f, 0.f};
#pragma unroll
    for (int u = 0; u < 2; ++u) {
        const bf16x8 Pf = pack8(s[2 * u][0], s[2 * u][1], s[2 * u][2], s[2 * u][3], s[2 * u + 1][0], s[2 * u + 1][1], s[2 * u + 1][2], s[2 * u + 1][3]);
#pragma unroll
        for (int mt = 0; mt < 4; ++mt) O[mt] = mfma16(Vf[u][mt], Pf, O[mt]);
    }
    LAS unsigned long long* lockw = (LAS unsigned long long*)(lds + A_LOCK);
    asm volatile("" :: "v"(O[0]), "v"(O[1]), "v"(O[2]), "v"(O[3]), "v"(ps) : "memory");
    if (!NOLOCK) {
        unsigned long long old = 0ull;
        if (lane0) old = __hip_atomic_fetch_or(lockw, lockbits, __ATOMIC_ACQUIRE, __HIP_MEMORY_SCOPE_WORKGROUP);
        unsigned long long olds = ((unsigned long long)(unsigned)__builtin_amdgcn_readfirstlane((int)(unsigned)(old >> 32)) << 32) | (unsigned)__builtin_amdgcn_readfirstlane((int)(unsigned)old);
        if (olds & lockbits) {
            const unsigned long long mine = lockbits & ~olds;
            if (mine != 0ull && lane0) __hip_atomic_fetch_and(lockw, ~mine, __ATOMIC_RELAXED, __HIP_MEMORY_SCOPE_WORKGROUP);
            unsigned long long guess = olds & ~lockbits;
#pragma unroll 1
            for (;;) {
                __builtin_amdgcn_s_sleep(1);
                old = guess;
                if (lane0) __hip_atomic_compare_exchange_strong(lockw, &old, guess | lockbits, __ATOMIC_ACQUIRE, __ATOMIC_RELAXED, __HIP_MEMORY_SCOPE_WORKGROUP);
                olds = ((unsigned long long)(unsigned)__builtin_amdgcn_readfirstlane((int)(unsigned)(old >> 32)) << 32) | (unsigned)__builtin_amdgcn_readfirstlane((int)(unsigned)old);
                if (olds == guess) break;
                guess = olds & ~lockbits;
            }
        }
    }
    asm volatile("" ::: "memory");
    if (valid) {
        LAS f32x4* p = (LAS f32x4*)os;
        const f32x4 c0 = p[0], c1 = p[4], c2 = p[8], c3 = p[12]; const float lq = ml[q];
        p[0] = c0 + O[0]; p[4] = c1 + O[1]; p[8] = c2 + O[2]; p[12] = c3 + O[3]; ml[q] = lq + ps;
    }
    LDS_WAIT(); asm volatile("" ::: "memory");
    if (!NOLOCK && lane0) __hip_atomic_fetch_and(lockw, ~lockbits, __ATOMIC_RELEASE, __HIP_MEMORY_SCOPE_WORKGROUP);
}

struct AttnState { float m[2], l[2]; f32x4 O[2][4]; };
constexpr float RESCALE_THR = 8.f;
template <int MODE>
__device__ __forceinline__ void attn_block2(AttnState& S, const LAS unsigned char* kb, const LAS unsigned char* vb, const LAS float* lutx, const bf16x8 (&Qf)[2][2],
                                           const int (&tq)[2], int kpos0, bool on0, bool on1, bool act0, bool act1, float bfar, int c16, int q, int r) {
    bf16x8 Kf[4][2], Vf[2][4];
#pragma unroll
    for (int kt = 0; kt < 4; ++kt)
#pragma unroll
        for (int ks = 0; ks < 2; ++ks) Kf[kt][ks] = *(const LAS bf16x8*)(kb + (16 * kt + c16) * KROW + ks * 64 + q * 16);
#pragma unroll
    for (int u = 0; u < 2; ++u)
#pragma unroll
        for (int mt = 0; mt < 4; ++mt) Vf[u][mt] = *(const LAS bf16x8*)(vb + (16 * mt + c16) * VROW + 64 * u + 16 * q);
    f32x4 s[2][4];
#pragma unroll
    for (int ct = 0; ct < 2; ++ct) {
        if (!(ct ? act1 : act0)) continue;
#pragma unroll
        for (int kt = 0; kt < 4; ++kt) {
            s[ct][kt] = mfma16(Kf[kt][0], Qf[ct][0], (f32x4){0.f, 0.f, 0.f, 0.f});
            s[ct][kt] = mfma16(Kf[kt][1], Qf[ct][1], s[ct][kt]);
        }
    }
#pragma unroll
    for (int ct = 0; ct < 2; ++ct) {
        const bool act = ct ? act1 : act0; const bool on = ct ? on1 : on0;
        if (!act) continue;
        float cadd, mx;
        if (MODE == 0) {
            const float bl = on ? bfar : NEG_INF;
            mx = max16(s[ct]) + bl; cadd = bl * LOG2E;
        } else {
            const int dq = tq[ct] - kpos0 - 4 * q;
            const float offb = on ? 0.f : NEG_INF;
#pragma unroll
            for (int kt = 0; kt < 4; ++kt)
#pragma unroll
                for (int i = 0; i < 4; ++i) {
                    const int d = dq - 16 * kt - i;
                    if (MODE == 1) { int dc = d < -1 ? -1 : d; dc = dc > 127 ? 127 : dc; s[ct][kt][i] += lutx[r * LUTS + 1 + dc] + offb; }
                    else s[ct][kt][i] = d < 512 ? s[ct][kt][i] + bfar : NEG_INF;
                }
            mx = max16(s[ct]); cadd = 0.f;
        }
        mx = xq_max(mx);
        if (__any(mx > S.m[ct] + RESCALE_THR)) {
            const float mn = fmaxf(S.m[ct], mx), alpha = __builtin_amdgcn_exp2f((S.m[ct] - mn) * LOG2E);
            S.m[ct] = mn; S.l[ct] *= alpha;
#pragma unroll
            for (int mt = 0; mt < 4; ++mt) S.O[ct][mt] = S.O[ct][mt] * alpha;
        }
        const float cc = cadd - S.m[ct] * LOG2E;
        float ps = 0.f;
#pragma unroll
        for (int kt = 0; kt < 4; ++kt)
#pragma unroll
            for (int i = 0; i < 4; ++i) { const float e = __builtin_amdgcn_exp2f(__builtin_fmaf(s[ct][kt][i], LOG2E, cc)); s[ct][kt][i] = e; ps += e; }
        S.l[ct] += ps;
#pragma unroll
        for (int u = 0; u < 2; ++u) {
            const bf16x8 Pf = pack8(s[ct][2 * u][0], s[ct][2 * u][1], s[ct][2 * u][2], s[ct][2 * u][3], s[ct][2 * u + 1][0], s[ct][2 * u + 1][1], s[ct][2 * u + 1][2], s[ct][2 * u + 1][3]);
#pragma unroll
            for (int mt = 0; mt < 4; ++mt) S.O[ct][mt] = mfma16(Vf[u][mt], Pf, S.O[ct][mt]);
        }
    }
}

__device__ __forceinline__ void vt_store(LAS unsigned char* rowp, int k0, v4u v) {
    const int u = k0 >> 5, kk = k0 & 31, qq = (kk & 15) >> 2, hh = kk >> 4;
    LAS unsigned char* p = rowp + (32 * u + 8 * qq + 4 * hh) * 2;
    u32x2 a; a.x = v.x; a.y = v.y; u32x2 bq; bq.x = v.z; bq.y = v.w;
    *(LAS u32x2*)p = a; *(LAS u32x2*)(p + 16) = bq;
}

__device__ __forceinline__ int nth_bit(unsigned long long m, int k) { for (int i = 0; i < k; ++i) m &= m - 1ull; return __builtin_ctzll(m); }

__device__ __forceinline__ void attn_item(const Ctx& C, int b, int g, int cur) {
    LAS unsigned char* lds = C.lds;
    int lane_ = C.lane; asm volatile("" : "+v"(lane_));
    const int lane = lane_, w = C.wave, tid = w * 64 + lane, c16 = lane & 15, q = lane >> 4, r = c16 & 3;
    const int t0 = cur * 64;
    const bf16* Qg = WSP(bf16, WS_Q); const bf16* NGB = WSP(bf16, WS_NGB); const bf16* ZA = WSP(bf16, WS_ZA);
    LAS float* lutx = (LAS float*)(lds + A_LUT); LAS float* imp = (LAS float*)(lds + A_IMP);
    LAS unsigned long long* selm = (LAS unsigned long long*)(lds + A_SEL);
    const int srow = tid >> 3, scc = tid & 7, kdst = A_KB + srow * KROW + scc * 16, vdst = A_VB + srow * VROW + scc * 16;
    counter_wait(C, CW_CMP + 16 * (b * 4 + g), 16u);
    {
        const bf16* kcg = WSP(bf16, WS_KC) + (size_t)((b * 4 + g) * 256) * 64;
        const bf16* vcg = WSP(bf16, WS_VCT) + (size_t)((b * 4 + g) * 64) * 256;
#pragma unroll
        for (int i = 0; i < 4; ++i) {
            const int id = tid + 512 * i;
            { const int row = id >> 3, cc = id & 7; *(LAS v4u*)(lds + A_KC + row * KROW + cc * 16) = *(const v4u*)(kcg + row * 64 + cc * 8); }
            { const int dim = id >> 5, kc = id & 31; vt_store(lds + A_VCT + dim * VCROW, 8 * kc, *(const v4u*)(vcg + dim * 256 + kc * 8)); }
        }
        lutx[(tid >> 7) * LUTS + 1 + (tid & 127)] = WSP(float, WS_LUT)[(g * 4 + (tid >> 7)) * 128 + (tid & 127)];
        if (tid < 4) lutx[tid * LUTS] = NEG_INF;
        *(LAS v4u*)(lds + kdst) = *(const v4u*)(WSP(bf16, WS_KS) + ((size_t)((b * 4 + g) * 4096 + srow) << 6) + scc * 8);
        *(LAS v4u*)(lds + vdst) = *(const v4u*)(WSP(bf16, WS_VST) + ((size_t)((b * 4 + g) * 64) << 12) + srow * 64 + scc * 8);
    }
    bf16x8 Qf[2][2]; int tq[2];
#pragma unroll
    for (int ct = 0; ct < 2; ++ct) {
        tq[ct] = t0 + 8 * w + 4 * ct + (c16 >> 2);
        const size_t row = (size_t)(b * SEQ + tq[ct]);
#pragma unroll
        for (int ks = 0; ks < 2; ++ks) Qf[ct][ks] = *(const bf16x8*)(Qg + row * 1024 + (g * 4 + r) * 64 + 32 * ks + 8 * q);
    }
    unsigned gpk[2][2];
#pragma unroll
    for (int ct = 0; ct < 2; ++ct) { const bf16* gp = NGB + (size_t)(b * SEQ + tq[ct]) * 64 + (g * 4 + r) * 3;
        gpk[ct][0] = (unsigned)gp[0] | ((unsigned)gp[1] << 16); gpk[ct][1] = (unsigned)gp[2]; }
#define GATE(ct, br) ((DBG == 4 + (br)) ? 0.f : ((br) == 0 ? bflo(gpk[ct][0]) : ((br) == 1 ? bfhi(gpk[ct][0]) : bflo(gpk[ct][1]))))
    const float bfar = WSP(float, WS_LUT)[(g * 4 + r) * 128 + 127];
    f32x4 Ot[2][4];
    __syncthreads();
    const int nch = (4 * cur + 3 + 31) >> 5;
    {
        float mA[2] = {NEG_BIG, NEG_BIG}, lA[2] = {0.f, 0.f};
#define CMP_PASS1(kt, FARB) do { \
            const bf16x8 k0 = *(const LAS bf16x8*)(lds + A_KC + (16 * (kt) + c16) * KROW + q * 16), k1 = *(const LAS bf16x8*)(lds + A_KC + (16 * (kt) + c16) * KROW + 64 + q * 16); \
            _Pragma("unroll") for (int ct = 0; ct < 2; ++ct) { \
                f32x4 s = mfma16(k0, Qf[ct][0], (f32x4){0.f, 0.f, 0.f, 0.f}); s = mfma16(k1, Qf[ct][1], s); \
                if (FARB) { s[0] += bfar; s[1] += bfar; s[2] += bfar; s[3] += bfar; } \
                else { const int dq = tq[ct] - 31 - 64 * q - 256 * (kt); \
                    _Pragma("unroll") for (int i = 0; i < 4; ++i) { int dc = dq - 16 * i; dc = dc < -1 ? -1 : dc; dc = dc > 127 ? 127 : dc; s[i] += lutx[r * LUTS + 1 + dc]; } } \
                const float mx = fmaxf(fmaxf(s[0], s[1]), fmaxf(s[2], s[3])); \
                const float mn = fmaxf(mA[ct], mx); const float cc = -mn * LOG2E; \
                const float ps = (__builtin_amdgcn_exp2f(__builtin_fmaf(s[0], LOG2E, cc)) + __builtin_amdgcn_exp2f(__builtin_fmaf(s[1], LOG2E, cc))) + \
                                 (__builtin_amdgcn_exp2f(__builtin_fmaf(s[2], LOG2E, cc)) + __builtin_amdgcn_exp2f(__builtin_fmaf(s[3], LOG2E, cc))); \
                lA[ct] = lA[ct] * __builtin_amdgcn_exp2f((mA[ct] - mn) * LOG2E) + ps; mA[ct] = mn; } } while (0)
        const int tqmin = t0 + 8 * w;
        int kfar = tqmin >= 142 ? (tqmin - 142) >> 8 : 0; kfar = kfar < 2 * nch ? kfar : 2 * nch; kfar &= ~1;
#pragma unroll 1
        for (int kt = 0; kt < kfar; kt += 2) { CMP_PASS1(kt, true); CMP_PASS1(kt + 1, true); }
#pragma unroll 1
        for (int kt = kfar; kt < 2 * nch; kt += 2) { CMP_PASS1(kt, false); CMP_PASS1(kt + 1, false); }
#undef CMP_PASS1
        float Mc[2], invL[2];
#pragma unroll
        for (int ct = 0; ct < 2; ++ct) {
            const float mm = xq_max(mA[ct]);
            const float ll = xq_sum(lA[ct] * __builtin_amdgcn_exp2f((mA[ct] - mm) * LOG2E));
            Mc[ct] = -mm * LOG2E; invL[ct] = ll > 0.f ? 1.f / ll : 0.f;
        }
        f32x4 Oc[2][4];
#pragma unroll
        for (int ct = 0; ct < 2; ++ct)
#pragma unroll
            for (int mt = 0; mt < 4; ++mt) Oc[ct][mt] = (f32x4){0.f, 0.f, 0.f, 0.f};
        float carry[2] = {0.f, 0.f};
#define CMP_PASS2(u, FARB) do { \
            float p[2][2][4]; \
            _Pragma("unroll") for (int hf = 0; hf < 2; ++hf) { \
                const int kt = 2 * (u) + hf; \
                const bf16x8 k0 = *(const LAS bf16x8*)(lds + A_KC + (16 * kt + c16) * KROW + q * 16), k1 = *(const LAS bf16x8*)(lds + A_KC + (16 * kt + c16) * KROW + 64 + q * 16); \
                _Pragma("unroll") for (int ct = 0; ct < 2; ++ct) { \
                    f32x4 s = mfma16(k0, Qf[ct][0], (f32x4){0.f, 0.f, 0.f, 0.f}); s = mfma16(k1, Qf[ct][1], s); \
                    const int dq = tq[ct] - 31 - 64 * q - 256 * kt; \
                    float own = 0.f; \
                    _Pragma("unroll") for (int i = 0; i < 4; ++i) { float bi_; \
                        if (FARB) bi_ = bfar; else { int dc = dq - 16 * i; dc = dc < -1 ? -1 : dc; dc = dc > 127 ? 127 : dc; bi_ = lutx[r * LUTS + 1 + dc]; } \
                        const float e = __builtin_amdgcn_exp2f(__builtin_fmaf(s[i] + bi_, LOG2E, Mc[ct])) * invL[ct]; p[ct][hf][i] = e; own += e; } \
                      \
                    float ra, rb; \
                    { auto s16 = __builtin_amdgcn_permlane16_swap(__builtin_bit_cast(unsigned, p[ct][hf][3]), __builtin_bit_cast(unsigned, p[ct][hf][3]), false, false); \
                      const unsigned x16 = (q & 1) ? (unsigned)s16[0] : (unsigned)s16[1]; \
                      ra = __builtin_bit_cast(float, x16); \
                      auto s32 = __builtin_amdgcn_permlane32_swap(x16, x16, false, false); \
                      rb = __builtin_bit_cast(float, (q & 2) ? (unsigned)s32[0] : (unsigned)s32[1]); } \
                    const float prev3 = (q & 1) ? ra : (q == 2 ? rb : carry[ct]); carry[ct] = rb; \
                    float v = own + prev3; v += dppf<DPP_XOR1>(v); v += dppf<DPP_XOR2>(v); \
                    if (r == 0) imp[(8 * w + 4 * ct + (c16 >> 2)) * 64 + 4 * kt + q] = v; \
                } \
            } \
            bf16x8 Pf[2]; \
            _Pragma("unroll") for (int ct = 0; ct < 2; ++ct) Pf[ct] = pack8(p[ct][0][0], p[ct][0][1], p[ct][0][2], p[ct][0][3], p[ct][1][0], p[ct][1][1], p[ct][1][2], p[ct][1][3]); \
            _Pragma("unroll") for (int mt = 0; mt < 4; ++mt) { \
                const bf16x8 a = *(const LAS bf16x8*)(lds + A_VCT + (16 * mt + c16) * VCROW + 64 * (u) + 16 * q); \
                _Pragma("unroll") for (int ct = 0; ct < 2; ++ct) Oc[ct][mt] = mfma16(a, Pf[ct], Oc[ct][mt]); \
            } } while (0)
#pragma unroll 1
        for (int u = 0; u < (kfar >> 1); ++u) CMP_PASS2(u, true);
#pragma unroll 1
        for (int u = (kfar >> 1); u < nch; ++u) CMP_PASS2(u, false);
#undef CMP_PASS2
#pragma unroll
        for (int ct = 0; ct < 2; ++ct)
#pragma unroll
            for (int mt = 0; mt < 4; ++mt) Ot[ct][mt] = Oc[ct][mt] * GATE(ct, 0);
    }
    LDS_WAIT(); asm volatile("" ::: "memory");
    {
        const int ts = lane >> 3, sub = lane & 7;
        unsigned long long mask;
        if (cur <= 7) mask = (2ull << cur) - 1ull;
        else {
            float v[8];
#pragma unroll
            for (int i = 0; i < 8; ++i) { const int j = sub * 8 + i; v[i] = (j >= 1 && j <= cur - 2) ? imp[(8 * w + ts) * 64 + j] : -3e38f; }
            mask = 1ull | (1ull << cur) | (1ull << (cur - 1));
#pragma unroll 1
            for (int rd = 0; rd < 5; ++rd) {
                float best = v[0]; int bi = 0;
#pragma unroll
                for (int i = 1; i < 8; ++i) if (v[i] > best) { best = v[i]; bi = i; }
                int bj = sub * 8 + bi;
#pragma unroll
                for (int st = 0; st < 3; ++st) {
                    const float ov = st == 0 ? dppf<DPP_XOR1>(best) : (st == 1 ? dppf<DPP_XOR2>(best) : dppf<DPP_HMIRROR>(best));
                    const int oj = st == 0 ? dppi<DPP_XOR1>(bj) : (st == 1 ? dppi<DPP_XOR2>(bj) : dppi<DPP_HMIRROR>(bj));
                    if (ov > best || (ov == best && oj < bj)) { best = ov; bj = oj; } }
                mask |= 1ull << bj;
#pragma unroll
                for (int i = 0; i < 8; ++i) if (bj == sub * 8 + i) v[i] = -3e38f;
            }
        }
        if (sub == 0) selm[8 * w + ts] = mask;
    }
    LDS_WAIT(); asm volatile("" ::: "memory");
    __syncthreads();
#pragma unroll
    for (int ct = 0; ct < 2; ++ct) {
        const int qi = (8 * w + 4 * ct + (c16 >> 2)) * 4 + r;
        *(LAS bf16x8*)(lds + A_QS + qi * KROW + q * 16) = Qf[ct][0]; *(LAS bf16x8*)(lds + A_QS + qi * KROW + 64 + q * 16) = Qf[ct][1];
#pragma unroll
        for (int mt = 0; mt < 4; ++mt) *(LAS f32x4*)(lds + A_OS + qi * OSROW + q * 16 + 64 * mt) = (f32x4){0.f, 0.f, 0.f, 0.f};
        ((LAS float*)(lds + A_ML))[qi * 8 + q] = 0.f; if (q == 0) ((LAS float*)(lds + A_ML))[qi * 8 + 4] = NEG_BIG;
        if (q == 1) ((LAS float*)(lds + A_ML))[qi * 8 + 5] = GATE(ct, 1);
        if (q == 2) ((LAS float*)(lds + A_ML))[qi * 8 + 6] = GATE(ct, 2);
    }
    __syncthreads();
    {
        const int nd = cur + 1 < 3 ? cur + 1 : 3, jlo = cur >= 8 ? cur - 8 : 0, nw = cur - jlo + 1, ntot = nd + nw;
#define LIST_BLOCK(idx) ((idx) < nd ? ((idx) == 0 ? 0 : cur - (nd - 1 - (idx))) : jlo + (idx) - nd)
#define STAGE_FETCH(dk, dv, idx) do { const int brn_ = (idx) >= nd, jn_ = LIST_BLOCK(idx); \
            const bf16* Kg_ = brn_ ? WSP(bf16, WS_KW) : WSP(bf16, WS_KS); const bf16* Vg_ = brn_ ? WSP(bf16, WS_VWT) : WSP(bf16, WS_VST); \
            dk = *(const v4u*)(Kg_ + ((size_t)((b * 4 + g) * 4096 + 64 * jn_ + srow) << 6) + scc * 8); \
            dv = *(const v4u*)(Vg_ + ((size_t)((b * 4 + g) * 64 + jn_) << 12) + srow * 64 + scc * 8); } while (0)
        v4u ka = {0u, 0u, 0u, 0u}, va = ka;
        if (ntot > 1) STAGE_FETCH(ka, va, 1);
        AttnState S;
#pragma unroll
        for (int ct = 0; ct < 2; ++ct) { S.m[ct] = NEG_BIG; S.l[ct] = 0.f;
#pragma unroll
            for (int mt = 0; mt < 4; ++mt) S.O[ct][mt] = (f32x4){0.f, 0.f, 0.f, 0.f}; }
#pragma unroll 1
        for (int ib = 0; ib < nd; ++ib) {
            const int j = LIST_BLOCK(ib), bufo = (ib & 1);
            v4u kr = {0u, 0u, 0u, 0u}, vr = kr;
            if (ib + 2 <= nd && ib + 2 < ntot) STAGE_FETCH(kr, vr, ib + 2);
            const LAS unsigned char* kb = lds + A_KB + bufo * KBUF; const LAS unsigned char* vb = lds + A_VB + bufo * VBUF;
            if (cur - j <= 2) attn_block2<1>(S, kb, vb, lutx, Qf, tq, 64 * j, true, true, true, true, bfar, c16, q, r);
            else attn_block2<0>(S, kb, vb, lutx, Qf, tq, 64 * j, true, true, true, true, bfar, c16, q, r);
            if (ib + 1 < ntot) { *(LAS v4u*)(lds + kdst + (bufo ^ 1) * KBUF) = ka; *(LAS v4u*)(lds + vdst + (bufo ^ 1) * VBUF) = va; }
            ka = kr; va = vr;
            __syncthreads();
        }
#pragma unroll
        for (int ct = 0; ct < 2; ++ct) {
            const int qi = (8 * w + 4 * ct + (c16 >> 2)) * 4 + r;
#pragma unroll
            for (int mt = 0; mt < 4; ++mt) *(LAS f32x4*)(lds + A_OS + qi * OSROW + q * 16 + 64 * mt) = S.O[ct][mt];
            ((LAS float*)(lds + A_ML))[qi * 8 + q] = S.l[ct]; if (q == 0) ((LAS float*)(lds + A_ML))[qi * 8 + 4] = S.m[ct];
        }
        if (tid == 0) *(LAS unsigned*)(lds + A_TKT) = 0u;
        __syncthreads();
#pragma unroll 1
        for (;;) {
            int tk_ = 0;
            if (lane == 0) tk_ = (int)__hip_atomic_fetch_add((LAS unsigned*)(lds + A_TKT), 1u, __ATOMIC_RELAXED, __HIP_MEMORY_SCOPE_WORKGROUP);
            tk_ = __builtin_amdgcn_readfirstlane(tk_);
            const int nfar = cur - 2;
            if (tk_ >= 2 * nfar) break;
            const bool sweep2 = tk_ >= nfar;
            const int j = 1 + (sweep2 ? tk_ - nfar : tk_);
            const unsigned wj = ((const LAS unsigned*)(lds + A_SEL))[2 * lane + (j >> 5)];
            const unsigned long long amask = __ballot((wj >> (j & 31)) & 1u);
            const int na = __builtin_popcountll(amask), nu = (na + 3) >> 2;
            if (nu == 0 || (nu >= 2) == sweep2) continue;
            bf16x8 Kf[4][2], Vf[2][4];
            { const bf16* kg = WSP(bf16, WS_KS) + ((size_t)((b * 4 + g) * 4096 + 64 * j) << 6); const bf16* vg = WSP(bf16, WS_VST) + ((size_t)((b * 4 + g) * 64 + j) << 12);
#pragma unroll
              for (int kt = 0; kt < 4; ++kt)
#pragma unroll
                  for (int ks = 0; ks < 2; ++ks) Kf[kt][ks] = *(const bf16x8*)(kg + (16 * kt + c16) * 64 + ks * 32 + q * 8);
#pragma unroll
              for (int u = 0; u < 2; ++u)
#pragma unroll
                  for (int mt = 0; mt < 4; ++mt) Vf[u][mt] = *(const bf16x8*)(vg + (16 * mt + c16) * 64 + 32 * u + 8 * q); }
#pragma unroll 1
            for (int un = 0; un < nu; ++un) {
                int tk; bool valid; unsigned long long lockbits;
                if (amask == ~0ull) { tk = 4 * un + (c16 >> 2); valid = true; lockbits = 0xfull << (4 * un); }
                else { unsigned long long m = amask; for (int i = 0; i < 4 * un; ++i) m &= m - 1ull;
                    const int rem = na - 4 * un;
                    int t0s = __builtin_ctzll(m); m &= m - 1ull; int t1s = rem > 1 ? __builtin_ctzll(m) : t0s; if (rem > 1) m &= m - 1ull;
                    int t2s = rem > 2 ? __builtin_ctzll(m) : t0s; if (rem > 2) m &= m - 1ull; int t3s = rem > 3 ? __builtin_ctzll(m) : t0s;
                    lockbits = (1ull << t0s) | (1ull << t1s) | (1ull << t2s) | (1ull << t3s);
                    const int sl = c16 >> 2; tk = sl == 0 ? t0s : (sl == 1 ? t1s : (sl == 2 ? t2s : t3s)); valid = sl < rem; }
                const int qi = tk * 4 + r, tqv = t0 + tk;
                if (cur - j <= 2) far_unit<1>(lds, Kf, Vf, lutx, qi, tqv, valid, 64 * j, 0.f, q, r, lockbits, lane == 0);
                else far_unit<0>(lds, Kf, Vf, lutx, qi, tqv, valid, 64 * j, lutx[r * LUTS + 128], q, r, lockbits, lane == 0);
            }
        }
        if (nd + 1 < ntot) STAGE_FETCH(ka, va, nd + 1);
        LDS_WAIT(); asm volatile("" ::: "memory");
        __syncthreads();
        LAS f32x4* otl = (LAS f32x4*)(lds + A_OS + w * 8192) + lane;
#pragma unroll
        for (int ct = 0; ct < 2; ++ct) {
            const int qi = (8 * w + 4 * ct + (c16 >> 2)) * 4 + r;
            const LAS float* ml = (const LAS float*)(lds + A_ML) + qi * 8;
            const float L = xq_sum(ml[q]); const float inv = L > 0.f ? ml[5] / L : 0.f;
#pragma unroll
            for (int mt = 0; mt < 4; ++mt) Ot[ct][mt] += *(const LAS f32x4*)(lds + A_OS + qi * OSROW + q * 16 + 64 * mt) * inv;
        }
        __syncthreads();
#pragma unroll
        for (int ct = 0; ct < 2; ++ct)
#pragma unroll
            for (int mt = 0; mt < 4; ++mt) otl[(ct * 4 + mt) * 64] = Ot[ct][mt];
#pragma unroll
        for (int ct = 0; ct < 2; ++ct) { S.m[ct] = NEG_BIG; S.l[ct] = 0.f;
#pragma unroll
            for (int mt = 0; mt < 4; ++mt) S.O[ct][mt] = (f32x4){0.f, 0.f, 0.f, 0.f};
            const int qi = (8 * w + 4 * ct + (c16 >> 2)) * 4 + r;
            Qf[ct][0] = *(const LAS bf16x8*)(lds + A_QS + qi * KROW + q * 16); Qf[ct][1] = *(const LAS bf16x8*)(lds + A_QS + qi * KROW + 64 + q * 16); }
#pragma unroll 1
        for (int ib = nd; ib < ntot; ++ib) {
            const int j = LIST_BLOCK(ib), bufo = (ib & 1);
            v4u kr = {0u, 0u, 0u, 0u}, vr = kr;
            if (ib + 2 < ntot) STAGE_FETCH(kr, vr, ib + 2);
            const LAS unsigned char* kb = lds + A_KB + bufo * KBUF; const LAS unsigned char* vb = lds + A_VB + bufo * VBUF;
            const float bfw = lutx[r * LUTS + 128];
            if (cur - j <= 2) attn_block2<1>(S, kb, vb, lutx, Qf, tq, 64 * j, true, true, true, true, bfw, c16, q, r);
            else if (cur - j == 8) attn_block2<2>(S, kb, vb, lutx, Qf, tq, 64 * j, true, true, true, true, bfw, c16, q, r);
            else attn_block2<0>(S, kb, vb, lutx, Qf, tq, 64 * j, true, true, true, true, bfw, c16, q, r);
            if (ib + 1 < ntot) { *(LAS v4u*)(lds + kdst + (bufo ^ 1) * KBUF) = ka; *(LAS v4u*)(lds + vdst + (bufo ^ 1) * VBUF) = va; }
            ka = kr; va = vr;
            __syncthreads();
        }
#undef STAGE_FETCH
#undef LIST_BLOCK
#pragma unroll
        for (int ct = 0; ct < 2; ++ct) {
            const int qi = (8 * w + 4 * ct + (c16 >> 2)) * 4 + r;
            const float L = xq_sum(S.l[ct]); const float inv = L > 0.f ? ((const LAS float*)(lds + A_ML))[qi * 8 + 6] / L : 0.f;
#pragma unroll
            for (int mt = 0; mt < 4; ++mt) Ot[ct][mt] = otl[(ct * 4 + mt) * 64] + S.O[ct][mt] * inv;
        }
    }
    bf16* OA = WSP(bf16, WS_OAB);
    int lane_e = lane; asm volatile("" : "+v"(lane_e));
    const int c16e = lane_e & 15, qe = lane_e >> 4, re = c16e & 3;
#pragma unroll
    for (int ct = 0; ct < 2; ++ct) {
        const int tqe = t0 + 8 * w + 4 * ct + (c16e >> 2);
        const size_t base = (size_t)(b * SEQ + tqe) * 1024 + (g * 4 + re) * 64 + 4 * qe, obase = base + (size_t)(b * SEQ + tqe) * 1024;
#pragma unroll
        for (int mt = 0; mt < 4; ++mt) {
            const u32x2 z = *(const u32x2*)(ZA + base + 16 * mt);
            const f32x4 ov = Ot[ct][mt];
            u32x2 o; o.x = cvtpk(ov.x * bflo(z.x), ov.y * bfhi(z.x)); o.y = cvtpk(ov.z * bflo(z.y), ov.w * bfhi(z.y));
            *(u32x2*)(OA + obase + 16 * mt) = o;
        }
    }
    __syncthreads();
}

#ifndef PHMASK
#define PHMASK 0x1ff
#endif
struct Args { const float* in[27]; float* out; unsigned char* ws; int pad0, pad1; };

__global__ void __launch_bounds__(NTHR, 2) mega_fwd(Args args) {
    extern __shared__ __attribute__((aligned(16))) unsigned char lds_raw[];
    Ctx C;
    C.out = args.out; C.ws = args.ws; C.lds = (LAS unsigned char*)lds_raw;
    C.wave = __builtin_amdgcn_readfirstlane((int)threadIdx.x >> 6); C.G = gridDim.x; C.bid = blockIdx.x;
#define REFRESH_TID() do { unsigned m_ = ~0u; asm volatile("" : "+s"(m_)); const int l_ = __builtin_amdgcn_mbcnt_hi(m_, __builtin_amdgcn_mbcnt_lo(m_, 0u)); C.lane = l_; C.tid = C.wave * 64 + l_; } while (0)
    REFRESH_TID();
    volatile LAS unsigned* MISC = (volatile LAS unsigned*)(C.lds + MISC_OFF);
    for (int u = C.tid; u < (LDS_BYTES - RING_BYTES) / 4; u += NTHR) ((LAS unsigned*)(C.lds + RING_BYTES))[u] = 0u;
    __syncthreads();
    if (C.tid < 27) { const unsigned long long pv = (unsigned long long)args.in[C.tid]; LAS unsigned* tab = (LAS unsigned*)(C.lds + PTR_OFF); tab[2 * C.tid] = (unsigned)pv; tab[2 * C.tid + 1] = (unsigned)(pv >> 32); }
    __syncthreads();
    XcdBarrier bar = xcd_barrier_post((unsigned*)(C.ws + WS_CTL) + CW_BAR, MISC + 8, C.tid == 0);
    volatile LAS unsigned long long* TS = (volatile LAS unsigned long long*)(C.lds + RING_BYTES + 1024);
    int n_ts = 0;
#define STAMP() do { if (DBGT >= 0) { if (C.tid == 0) TS[n_ts] = __builtin_amdgcn_s_memrealtime(); ++n_ts; } } while (0)
#define GRID_BAR() do { REFRESH_TID(); xcd_barrier(bar, C.tid == 0); STAMP(); REFRESH_TID(); } while (0)
    STAMP();
    LAS unsigned char* ring = C.lds;

    if (PHMASK & (1 << 0))
    phase0(C);
    REFRESH_TID(); counter_wait(C, CW_GEMV, 96u); STAMP(); REFRESH_TID();
    if (PHMASK & (1 << 1))
    phase1(C);
    GRID_BAR();
    if (PHMASK & (1 << 2))
    {
#ifndef NO_BFGEMM
        { pg8::Gemm g{WSP(const bf16, WS_H), WSP(const bf16, WS_WIN), MTOK, INB, DM}; pg8::StaticOrder S; S.init(MTOK, INB, C.G, C.bid);
          EpiIn E{C.ws, 0};
          pg8::gemm_phase<EpiIn, pg8::StaticOrder, true, true, false>(ring, g, S, E, C.tid); }
#endif
#ifndef NO_FP8GEMM
        { pg8::Gemm g{WSP(const bf16, WS_OAB), WSP(const bf16, WS_W8), MTOK, ING, DM / 2}; pg8::StaticOrder S; S.init(MTOK, ING, C.G, (C.bid + C.G / 2) % C.G);
          EpiIn E{C.ws, 1};
          pg8::gemm_phase<EpiIn, pg8::StaticOrder, true, true, true>(ring, g, S, E, C.tid); }
#endif
    }
    GRID_BAR();
    if (PHMASK & (1 << 3))
    {
        for (int it = C.bid; it < 256; it += C.G) compress_item(C, it);
        for (int it = C.bid; it < 256; it += C.G) ssm_item(C, it);
    }
    __syncthreads(); STAMP(); REFRESH_TID();
    if (PHMASK & (1 << 4))
    {
        __syncthreads();
        if (DBGT >= 0 && C.tid == 0) TS[15] = __builtin_amdgcn_s_memrealtime();
        REFRESH_TID();
#ifndef NO_ATTN
        for (int k = C.bid; k < 1024; k += C.G) {
            const int rd = k >> 8, kk = k & 255, bg = kk & 15, jj = kk >> 4;
            const unsigned long long tw = (rd == 0) ? (jj < 8 ? 0x382d36393f3a3e3dull : 0x353326312e2c2f34ull)
                                        : (rd == 1) ? (jj < 8 ? 0x1f2a272b30373c3bull : 0x181a251d1c211e17ull)
                                                    : (jj < 8 ? 0x1520232422282932ull : 0x10111b1219161413ull);
            const int cur = (rd == 3) ? jj : (int)((tw >> (8 * (jj & 7))) & 255ull);
            attn_item(C, bg >> 2, bg & 3, cur);
        }
#endif
    }
    __syncthreads(); STAMP(); REFRESH_TID();
    if (PHMASK & (1 << 5))
    {
        counter_wait(C, CW_SSM, 256u);
        pg8::Gemm g{WSP(const bf16, WS_H), WSP(const bf16, WS_WGLU), MTOK, 1024, 1024}; pg8::StaticOrder S; S.init(MTOK, 1024, C.G, C.bid);
        EpiMix<0> E{WSP(const bf16, WS_H), WSP(const bf16, WS_ZB), WSP(bf16, WS_OAB) + 1024, inp(C, 21), nullptr, nullptr, 1024, 2048};
        pg8::gemm_phase<EpiMix<0>, pg8::StaticOrder, false, true>(ring, g, S, E, C.tid);
    }
    GRID_BAR();
    if (PHMASK & (1 << 6))
    {
        pg8::Gemm g{WSP(const bf16, WS_OAB), WSP(const bf16, WS_WBN), MTOK, 2048, 1024, 2048}; pg8::SplitKOrder S; S.init(MTOK, 2048, C.G, C.bid);
        EpiMix<1> E{WSP(const bf16, WS_GA), WSP(const bf16, WS_GB), WSP(bf16, WS_H), nullptr, nullptr, nullptr, 2048, 2048};
        pg8::gemm_phase<EpiMix<1>, pg8::SplitKOrder, true, true>(ring, g, S, E, C.tid);
    }
    GRID_BAR();
    if (PHMASK & (1 << 7))
    {
        pg8::Gemm g{WSP(const bf16, WS_H), WSP(const bf16, WS_WOUT), MTOK, 2048, 2048}; pg8::StaticOrder S; S.init(MTOK, 2048, C.G, C.bid);
        EpiMix<3> E{nullptr, nullptr, WSP(bf16, WS_Q), nullptr, WSP(const float, WS_MOD), nullptr, 2048, 2048};
        pg8::gemm_phase<EpiMix<3>, pg8::StaticOrder, true, true>(ring, g, S, E, C.tid);
    }
    GRID_BAR();
    if (PHMASK & (1 << 8))
    phase_ln_out(C);
    if (DBGT >= 0) {
        __syncthreads(); STAMP(); __syncthreads();
        if (C.bid == 0 && C.wave == 1) {
            const float T2 = (DBGT == 19) ? (float)(TS[9] - TS[0]) * 0.01f * DBGS : (DBGT >= 21) ? (float)TS[DBGT] * 0.01f * DBGS : (DBGT == 20) ? (float)(TS[15] - TS[4]) * 0.01f * DBGS : (float)(TS[DBGT + 1] - TS[DBGT]) * 0.01f * DBGS;
            f32x4* zr = (f32x4*)(C.out + (size_t)1 * DM) + C.lane;
#pragma unroll
            for (int j = 0; j < 8; ++j) { f32x4 v = zr[64 * j]; v.x += T2; v.y += T2; v.z += T2; v.w += T2; zr[64 * j] = v; }
        }
    }
}

extern "C" void kernel_launch(void* const* d_in, const int* in_sizes, int n_in, void* d_out, int out_size, void* d_ws, size_t ws_size, hipStream_t stream) {
    static int grid = 0;
    if (grid == 0) {
        if (n_in != 27 || out_size != MTOK * DM || ws_size < WS_END) { fprintf(stderr, "kernel_launch: unexpected problem (n_in %d, out %d, ws %zu)\n", n_in, out_size, ws_size); grid = -1; return; }
        int dev = 0, cus = 0, per_cu = 0;
        if (hipGetDevice(&dev) != hipSuccess || hipDeviceGetAttribute(&cus, hipDeviceAttributeMultiprocessorCount, dev) != hipSuccess) { grid = -1; return; }
        if (hipFuncSetAttribute((const void*)mega_fwd, hipFuncAttributeMaxDynamicSharedMemorySize, LDS_BYTES) != hipSuccess) { fprintf(stderr, "kernel_launch: hipFuncSetAttribute failed\n"); grid = -1; return; }
        if (hipOccupancyMaxActiveBlocksPerMultiprocessor(&per_cu, (const void*)mega_fwd, NTHR, LDS_BYTES) != hipSuccess || per_cu < 1) { fprintf(stderr, "kernel_launch: occupancy query says %d\n", per_cu); }
        (void)hipGetLastError();
        grid = cus;
    }
    if (grid < 0) return;
    if (hipMemsetAsync((char*)d_ws + 16384, 0, 16384, stream) != hipSuccess) return;
    Args a{};
    for (int i = 0; i < 27; ++i) a.in[i] = (const float*)d_in[i];
    a.out = (float*)d_out; a.ws = (unsigned char*)d_ws;
    hipLaunchKernelGGL(mega_fwd, dim3(grid), dim3(NTHR), LDS_BYTES, stream, a);
}
```

```cpp
#include <hip/hip_runtime.h>
#include <cstdio>
#include <cstdint>
namespace pg8 {
#define PG8_LAS __attribute__((address_space(3)))
typedef unsigned short bf16_t;
typedef short bf16x8 __attribute__((ext_vector_type(8)));
typedef float f32x4 __attribute__((ext_vector_type(4)));
typedef unsigned u32x4 __attribute__((ext_vector_type(4)));
constexpr int BM = 256, BK = 64, HALF = 128, HTB = HALF * BK * 2  , STAGE_BYTES = 8 * HTB, NXCD = 8, WGM = 8;

__host__ __device__ __forceinline__ int lds_byte(int r, int c) { const int st = (r >> 4) * 2 + (c >> 5), rr = r & 15, cc = c & 31, ob = rr * 64 + cc * 2; return st * 1024 + (ob ^ (((ob >> 9) & 1) << 5)); }
__host__ __device__ __forceinline__ void stage_rc(int b, int& R, int& C) { const int st = b / 1024, sb = b % 1024, swz = sb ^ (((sb >> 9) & 1) << 5); R = (st >> 1) * 16 + swz / 64; C = (st & 1) * 32 + (swz % 64) / 2; }
__host__ __device__ __forceinline__ int perm32(int rho) { const int n = rho >> 4, i = rho & 15; return 8 * (i >> 2) + 4 * n + (i & 3); }

struct Unit { int pm, pn, kh; };
struct Gemm { const bf16_t* A; const bf16_t* Bt; int M, N, K, ld; };

struct StaticOrder {
    int nM, nN, nwg, G, c;
    __host__ __device__ void init(int M, int N, int G_, int c_) { nM = M / BM; nN = N / BM; nwg = nM * nN; G = G_; c = c_; }
    __host__ __device__ bool next(int i, Unit& u) const {
        const long L = (long)i * G + c; if (L >= nwg) return false;
        int wgid = (int)L; { const int q = nwg / NXCD, r = nwg % NXCD, xcd = wgid % NXCD, off = wgid / NXCD; wgid = (xcd < r ? xcd * (q + 1) : r * (q + 1) + (xcd - r) * q) + off; }
        const int nig = WGM * nN, gid = wgid / nig, fm = gid * WGM, gsz = (nM - fm) < WGM ? (nM - fm) : WGM;
        u.pm = fm + ((wgid % nig) % gsz); u.pn = (wgid % nig) / gsz; u.kh = 0; return true;
    }
    __device__ __forceinline__ void a_ready(const Unit&) const {}
    __device__ __forceinline__ void done(const Unit&) const {}
};
struct SplitKOrder {
    StaticOrder base;
    __host__ __device__ void init(int M, int N, int G_, int c_) { base.init(M, N, G_, c_); }
    __host__ __device__ bool next(int i, Unit& u) const { if (!base.next(i >> 1, u)) return false; u.kh = i & 1; return true; }
    __device__ __forceinline__ void a_ready(const Unit&) const {}
    __device__ __forceinline__ void done(const Unit&) const {}
};

__device__ __forceinline__ unsigned cvt_pk_bf16(float lo, float hi) { unsigned r; asm volatile("v_cvt_pk_bf16_f32 %0, %1, %2" : "=v"(r) : "v"(lo), "v"(hi)); return r; }
typedef float f32x2 __attribute__((ext_vector_type(2)));
__device__ __forceinline__ f32x2 gelu_pk(f32x2 v) {
    const f32x2 av = __builtin_elementwise_abs(v), d = av * 0.2316418882f + 1.0f;
    f32x2 t; t.x = __builtin_amdgcn_rcpf(d.x); t.y = __builtin_amdgcn_rcpf(d.y);
    f32x2 q = t * 0.5307027145f + (-0.7265760135f); q = q * t + 0.7107068705f; q = q * t + (-0.142248368f); q = q * t + 0.127414796f; q = q * t;
    const f32x2 s = (v * v) * (-0.72134752044f);
    f32x2 e; e.x = __builtin_amdgcn_exp2f(s.x); e.y = __builtin_amdgcn_exp2f(s.y);
    const f32x2 m = v * (q * e), r = v - m;
    f32x2 o; o.x = v.x < 0.f ? m.x : r.x; o.y = v.y < 0.f ? m.y : r.y; return o;
}

typedef int i32x4_t __attribute__((ext_vector_type(4)));
typedef int i32x8_t __attribute__((ext_vector_type(8)));
__device__ __forceinline__ i32x8_t cat8(bf16x8 lo, bf16x8 hi) { const i32x4_t a = __builtin_bit_cast(i32x4_t, lo), b = __builtin_bit_cast(i32x4_t, hi); return __builtin_shufflevector(a, b, 0, 1, 2, 3, 4, 5, 6, 7); }
template <class Epi, class Sched, bool ALIGN_EPI = false, bool SP2 = false, bool FP8 = false>
__device__ __forceinline__ void gemm_phase(PG8_LAS unsigned char* lds, const Gemm g, const Sched& S, const Epi& E, int tid_in) {
    int tid_ = tid_in; asm volatile("" : "+v"(tid_));
    const int tid = tid_, wid = __builtin_amdgcn_readfirstlane(tid >> 6), lane = tid & 63, wr = wid >> 2, wc = wid & 3, fr = lane & 15, fq = lane >> 4;
    int pg8_scale1 = 0x7F7F7F7F; asm volatile("" : "+v"(pg8_scale1));
    const int K = g.K, nt = K / BK, LD = g.ld ? g.ld : g.K;
    unsigned voffA[2], voffB[2];
#pragma unroll
    for (int i = 0; i < 2; ++i) { int R, C; stage_rc(tid * 16 + i * 8192, R, C); const int Rb = Epi::PERM ? ((R & ~31) + perm32(R & 31)) : R;
        voffA[i] = (unsigned)(R * LD + C) * 2u; voffB[i] = (unsigned)(Rb * LD + C) * 2u; }
    const size_t kstep = (size_t)(BK * 2);
    const size_t hstep = (size_t)HALF * LD * 2;
    const size_t tstep = 2 * hstep;
    const unsigned ldsw = (unsigned)wid * 1024u;
    const int aoff = lds_byte(wr * 64 + fr, fq * 8), boff = lds_byte(wc * 32 + fr, fq * 8);
#define PG8_SA(b, h) (((b) * 2 + (h)) * HTB)
#define PG8_SB(b, h) ((4 + (b) * 2 + (h)) * HTB)
#define PG8_STAGE(bufoff, gbase, voff) do { _Pragma("unroll") for (int _i = 0; _i < 2; ++_i) \
        __builtin_amdgcn_global_load_lds((const unsigned*)((const char*)(gbase) + (voff)[_i]), (PG8_LAS unsigned*)(lds + (bufoff) + ldsw + _i * 8192), 16, 0, 0); } while (0)
#define PG8_LDA(dst, b, h) do { _Pragma("unroll") for (int m = 0; m < 4; ++m) { dst[m].lo = *(const PG8_LAS i32x4_t*)(lds + PG8_SA(b, h) + aoff + m * 2048); dst[m].hi = *(const PG8_LAS i32x4_t*)(lds + PG8_SA(b, h) + aoff + m * 2048 + 1024); } } while (0)
#define PG8_LDB(dst, b, h) do { _Pragma("unroll") for (int n = 0; n < 2; ++n) { dst[n].lo = *(const PG8_LAS i32x4_t*)(lds + PG8_SB(b, h) + boff + n * 2048); dst[n].hi = *(const PG8_LAS i32x4_t*)(lds + PG8_SB(b, h) + boff + n * 2048 + 1024); } } while (0)
#define PG8_MMA(ai, bj, At, Bt) do { __builtin_amdgcn_s_setprio(1); if constexpr (FP8) { _Pragma("unroll") for (int m = 0; m < 4; ++m) _Pragma("unroll") for (int n = 0; n < 2; ++n) \
        asm volatile("v_mfma_scale_f32_16x16x128_f8f6f4 %0, %1, %2, %0, %3, %3 op_sel_hi:[0,0,0]" : "+v"(acc[ai][bj][m][n]) : "v"(Bt[n]), "v"(At[m]), "v"(pg8_scale1)); } else { \
        _Pragma("unroll") for (int m = 0; m < 4; ++m) _Pragma("unroll") for (int n = 0; n < 2; ++n) { \
        acc[ai][bj][m][n] = __builtin_amdgcn_mfma_f32_16x16x32_bf16(__builtin_bit_cast(bf16x8, (i32x4_t)Bt[n].lo), __builtin_bit_cast(bf16x8, (i32x4_t)At[m].lo), acc[ai][bj][m][n], 0, 0, 0); \
        acc[ai][bj][m][n] = __builtin_amdgcn_mfma_f32_16x16x32_bf16(__builtin_bit_cast(bf16x8, (i32x4_t)Bt[n].hi), __builtin_bit_cast(bf16x8, (i32x4_t)At[m].hi), acc[ai][bj][m][n], 0, 0, 0); } } __builtin_amdgcn_s_setprio(0); } while (0)
#define PG8_WAIT_V(n) asm volatile("s_waitcnt vmcnt(" #n ")" ::: "memory")
#define PG8_WAIT_L(n) asm volatile("s_waitcnt lgkmcnt(" #n ")" ::: "memory")
#define PG8_BAR __builtin_amdgcn_s_barrier()
#define PG8_SCHED __builtin_amdgcn_sched_barrier(0)
    Unit cur, nxt; int ui = 0;
    if (!S.next(0, cur)) return;
    f32x4 acc[2][2][4][2];
#pragma unroll
    for (int a = 0; a < 2; ++a)
#pragma unroll
        for (int b = 0; b < 2; ++b)
#pragma unroll
            for (int m = 0; m < 4; ++m)
#pragma unroll
                for (int n = 0; n < 2; ++n) acc[a][b][m][n] = (f32x4){0.f, 0.f, 0.f, 0.f};
    i32x8_t At[4], B0[2], B1[2];
    const size_t khstep = (size_t)K * 2;
    const char* cA = (const char*)g.A + (size_t)cur.pm * tstep + (size_t)cur.kh * khstep; const char* cB = (const char*)g.Bt + (size_t)cur.pn * tstep + (size_t)cur.kh * khstep;
    S.a_ready(cur);
    if constexpr (SP2) {
        PG8_STAGE(PG8_SB(0, 0), cB, voffB); PG8_STAGE(PG8_SB(0, 1), cB + hstep, voffB); PG8_STAGE(PG8_SA(0, 0), cA, voffA); PG8_STAGE(PG8_SA(0, 1), cA + hstep, voffA);
        if (wr == 1) PG8_BAR;
        PG8_WAIT_V(2); PG8_BAR;
        PG8_STAGE(PG8_SB(1, 0), cB + kstep, voffB); PG8_STAGE(PG8_SA(1, 0), cA + kstep, voffA); PG8_STAGE(PG8_SB(1, 1), cB + hstep + kstep, voffB);
        PG8_WAIT_V(6); PG8_BAR;
    } else {
        PG8_STAGE(PG8_SB(0, 0), cB, voffB); PG8_STAGE(PG8_SA(0, 0), cA, voffA); PG8_STAGE(PG8_SB(0, 1), cB + hstep, voffB); PG8_STAGE(PG8_SA(0, 1), cA + hstep, voffA);
        if (wr == 1) PG8_BAR;
        PG8_WAIT_V(4); PG8_BAR;
        PG8_STAGE(PG8_SB(1, 0), cB + kstep, voffB); PG8_STAGE(PG8_SA(1, 0), cA + kstep, voffA); PG8_STAGE(PG8_SB(1, 1), cB + hstep + kstep, voffB);
        PG8_WAIT_V(6); PG8_BAR;
    }
    for (;;) {
        const bool has_next = S.next(ui + 1, nxt);
        const char* nA = has_next ? (const char*)g.A + (size_t)nxt.pm * tstep + (size_t)nxt.kh * khstep : cA; const char* nB = has_next ? (const char*)g.Bt + (size_t)nxt.pn * tstep + (size_t)nxt.kh * khstep : cB;
        for (int t = 0; t < nt; t += 2) {
            const bool last = (t == nt - 2);
            const char* a1 = cA + (size_t)(t + 1) * kstep;
            const char* a2 = last ? nA : cA + (size_t)(t + 2) * kstep; const char* b2 = last ? nB : cB + (size_t)(t + 2) * kstep;
            const char* a3 = a2 + kstep; const char* b3 = b2 + kstep;
            if (last && has_next) S.a_ready(nxt);
            if constexpr (SP2) {
            PG8_LDB(B0, 0, 0); PG8_LDB(B1, 0, 1); PG8_SCHED; PG8_LDA(At, 0, 0); PG8_STAGE(PG8_SA(1, 1), a1 + hstep, voffA);
            PG8_WAIT_V(8); PG8_WAIT_L(0); PG8_BAR; PG8_MMA(0, 0, At, B0); PG8_MMA(0, 1, At, B1); PG8_BAR; PG8_SCHED;
            PG8_LDA(At, 0, 1); PG8_STAGE(PG8_SB(0, 0), b2, voffB); PG8_STAGE(PG8_SB(0, 1), b2 + hstep, voffB); PG8_STAGE(PG8_SA(0, 0), a2, voffA);
            PG8_WAIT_V(8); PG8_WAIT_L(0); PG8_BAR; PG8_MMA(1, 0, At, B0); PG8_MMA(1, 1, At, B1); PG8_BAR; PG8_SCHED;
            PG8_LDB(B0, 1, 0); PG8_LDB(B1, 1, 1); PG8_SCHED; PG8_LDA(At, 1, 0); PG8_STAGE(PG8_SA(0, 1), a2 + hstep, voffA);
            PG8_WAIT_V(8); PG8_WAIT_L(0); PG8_BAR; PG8_MMA(0, 0, At, B0); PG8_MMA(0, 1, At, B1); PG8_BAR; PG8_SCHED;
            PG8_LDA(At, 1, 1); PG8_STAGE(PG8_SB(1, 0), b3, voffB); PG8_STAGE(PG8_SB(1, 1), b3 + hstep, voffB); PG8_STAGE(PG8_SA(1, 0), a3, voffA);
            PG8_WAIT_V(8); PG8_WAIT_L(0); PG8_BAR; PG8_MMA(1, 0, At, B0); PG8_MMA(1, 1, At, B1); PG8_BAR; PG8_SCHED;
            } else {
            PG8_LDB(B0, 0, 0); PG8_SCHED; PG8_LDA(At, 0, 0); PG8_STAGE(PG8_SA(1, 1), a1 + hstep, voffA);
            PG8_WAIT_L(8); PG8_BAR; PG8_WAIT_L(0); PG8_MMA(0, 0, At, B0); PG8_BAR; PG8_SCHED;
            PG8_LDB(B1, 0, 1); PG8_STAGE(PG8_SB(0, 0), b2, voffB);
            PG8_BAR; PG8_WAIT_L(0); PG8_MMA(0, 1, At, B1); PG8_BAR;
            PG8_LDA(At, 0, 1); PG8_STAGE(PG8_SA(0, 0), a2, voffA);
            PG8_BAR; PG8_WAIT_L(0); PG8_MMA(1, 0, At, B0); PG8_BAR; PG8_SCHED;
            PG8_STAGE(PG8_SB(0, 1), b2 + hstep, voffB);
            PG8_WAIT_V(6); PG8_BAR; PG8_MMA(1, 1, At, B1); PG8_BAR;
            PG8_LDB(B0, 1, 0); PG8_SCHED; PG8_LDA(At, 1, 0); PG8_STAGE(PG8_SA(0, 1), a2 + hstep, voffA);
            PG8_WAIT_L(8); PG8_BAR; PG8_WAIT_L(0); PG8_MMA(0, 0, At, B0); PG8_BAR; PG8_SCHED;
            PG8_LDB(B1, 1, 1); PG8_STAGE(PG8_SB(1, 0), b3, voffB);
            PG8_BAR; PG8_WAIT_L(0); PG8_MMA(0, 1, At, B1); PG8_BAR;
            PG8_LDA(At, 1, 1); PG8_STAGE(PG8_SA(1, 0), a3, voffA);
            PG8_BAR; PG8_WAIT_L(0); PG8_MMA(1, 0, At, B0); PG8_BAR; PG8_SCHED;
            PG8_STAGE(PG8_SB(1, 1), b3 + hstep, voffB);
            PG8_WAIT_V(6); PG8_BAR; PG8_MMA(1, 1, At, B1); PG8_BAR;
            }
        }
        if constexpr (ALIGN_EPI) { if (wr == 0) PG8_BAR; }
        if constexpr (FP8) asm volatile("s_nop 15\n\ts_nop 15" ::: "memory");
        bool keep = false;
        if constexpr (Epi::HAS_MID) keep = (cur.kh == 0);
        if constexpr (!Epi::AFTER_DRAIN) { if constexpr (Epi::HAS_MID) { if (keep) E.mid(acc, cur, wr, wc, fr, fq); else E(acc, cur, wr, wc, fr, fq); } else E(acc, cur, wr, wc, fr, fq); S.done(cur); }
        if (!has_next) break;
        if (!keep)
#pragma unroll
        for (int a = 0; a < 2; ++a)
#pragma unroll
            for (int b = 0; b < 2; ++b)
#pragma unroll
                for (int m = 0; m < 4; ++m)
#pragma unroll
                    for (int n = 0; n < 2; ++n) acc[a][b][m][n] = (f32x4){0.f, 0.f, 0.f, 0.f};
        cur = nxt; cA = nA; cB = nB; ++ui;
        if constexpr (ALIGN_EPI) { if (wr == 1) PG8_BAR; }
    }
    PG8_WAIT_V(0);
    if constexpr (!ALIGN_EPI) { if (wr == 0) PG8_BAR; }
    PG8_BAR;
    if constexpr (Epi::AFTER_DRAIN) { E.fused(acc, cur, wr, wc, fr, fq, lds, wid, lane); S.done(cur); }
#undef PG8_SA
#undef PG8_SB
#undef PG8_STAGE
#undef PG8_LDA
#undef PG8_LDB
#undef PG8_MMA
#undef PG8_WAIT_V
#undef PG8_WAIT_L
#undef PG8_BAR
#undef PG8_SCHED
}
}
#define GAS __attribute__((address_space(1)))
#define LAS __attribute__((address_space(3)))
typedef unsigned short bf16;
typedef unsigned v4u __attribute__((ext_vector_type(4)));
typedef float f32x4 __attribute__((ext_vector_type(4)));
typedef short bf16x8 __attribute__((ext_vector_type(8)));
typedef GAS unsigned gu32;
typedef GAS unsigned long long gu64;
#define RLX_AGENT __ATOMIC_RELAXED, __HIP_MEMORY_SCOPE_AGENT
#define LDS_WAIT() asm volatile("s_waitcnt lgkmcnt(0)" ::: "memory")
#define VM_WAIT() asm volatile("s_waitcnt vmcnt(0)" ::: "memory")
__device__ __forceinline__ unsigned long long rt() { return __builtin_amdgcn_s_memrealtime(); }
__device__ __forceinline__ unsigned f2bf(float f) { unsigned u = __builtin_bit_cast(unsigned, f); return (u + 0x7fffu + ((u >> 16) & 1u)) >> 16; }
__device__ __forceinline__ unsigned pk2(float lo, float hi) { return f2bf(lo) | (f2bf(hi) << 16); }

#define XB_TMO      128
#define XB_XCNT(j)  (256  + 64 * (j))
#define XB_XSUB(j)  (1280 + 64 * (j))
#define XB_XGEN(j)  (2304 + 64 * (j))
#define XB_TOP      3328
#define XB_TOPGEN   3392
#define XCD_BAR_WORDS 3456
#define XB_SPIN_CAP (1u << 18)

__device__ __forceinline__ unsigned xb_ld(unsigned* p)              { return __hip_atomic_load(p, __ATOMIC_RELAXED, __HIP_MEMORY_SCOPE_AGENT); }
__device__ __forceinline__ unsigned xb_add(unsigned* p, unsigned v) { return __hip_atomic_fetch_add(p, v, __ATOMIC_RELAXED, __HIP_MEMORY_SCOPE_AGENT); }
__device__ __forceinline__ unsigned xb_xcc_id() { return (unsigned)__builtin_amdgcn_s_getreg((3 << 11) | 20) & 0xFu; }
#define XB_SPIN(cond, bar) do { unsigned _sp = 0; while (cond) { __builtin_amdgcn_s_sleep(1); \
    if ((++_sp & 255u) == 0u) { if (xb_ld(&(bar)[XB_TMO])) break; if (_sp > XB_SPIN_CAP) { atomicAdd(&(bar)[XB_TMO], 1u); break; } } } } while (0)

struct XcdBarrier {
    unsigned* bar; unsigned x;
    volatile LAS unsigned* st;
};

__device__ __forceinline__ XcdBarrier xcd_barrier_post(unsigned* bar, volatile LAS unsigned* st, bool is_t0) {
    XcdBarrier b; b.bar = bar; b.x = xb_xcc_id(); b.st = st;
    if (is_t0) (void)xb_add(&bar[XB_XCNT(b.x)], 1u);
    return b;
}
__device__ __forceinline__ void xcd_barrier_complete(unsigned* bar, unsigned x, unsigned& nloc, unsigned& nx) {
    const unsigned G = gridDim.x * gridDim.y * gridDim.z;
    unsigned sum, cnt, mine, sp = 0u;
    for (;;) {
        sum = 0u; cnt = 0u; mine = 0u;
#pragma unroll
        for (unsigned j = 0; j < 16; ++j) { const unsigned c = xb_ld(&bar[XB_XCNT(j)]); sum += c; cnt += (c > 0u) ? 1u : 0u; mine = (j == x) ? c : mine; }
        if (sum == G) break;
        __builtin_amdgcn_s_sleep(1);
        if ((++sp & 255u) == 0u) { if (xb_ld(&bar[XB_TMO])) break; if (sp > XB_SPIN_CAP) { atomicAdd(&bar[XB_TMO], 1u); break; } }
    }
    nloc = mine > 0u ? mine : 1u; nx = cnt > 0u ? cnt : 1u;
}

__device__ __forceinline__ void xcd_barrier(const XcdBarrier& b, bool is_t0) {
    asm volatile("s_waitcnt vmcnt(0)" ::: "memory");
    __syncthreads();
    if (is_t0) {
        unsigned* bar = b.bar;
        __builtin_amdgcn_s_waitcnt(0);
        unsigned nloc = b.st[0], nx = b.st[1];
        if (nloc == 0u) { xcd_barrier_complete(bar, b.x, nloc, nx); b.st[0] = nloc; b.st[1] = nx; }
        const unsigned old = xb_add(&bar[XB_XSUB(b.x)], 1u);
        const unsigned gen = old / nloc;
        if (old + 1u == (gen + 1u) * nloc) {
            __builtin_amdgcn_fence(__ATOMIC_RELEASE, "agent");
            asm volatile("s_waitcnt vmcnt(0)" ::: "memory");
            const unsigned og = xb_add(&bar[XB_TOP], 1u);
            const unsigned tg = og / nx;
            if (og + 1u == (tg + 1u) * nx) xb_add(&bar[XB_TOPGEN], 1u);
            else XB_SPIN(xb_ld(&bar[XB_TOPGEN]) == tg, bar);
            __builtin_amdgcn_fence(__ATOMIC_ACQUIRE, "agent");
            xb_add(&bar[XB_XGEN(b.x)], 1u);
            asm volatile("s_waitcnt vmcnt(0)" ::: "memory");
        } else {
            XB_SPIN(xb_ld(&bar[XB_XGEN(b.x)]) == gen, bar);
            __builtin_amdgcn_fence(__ATOMIC_ACQUIRE, "agent");
            asm volatile("s_waitcnt vmcnt(0)" ::: "memory");
        }
    }
    __syncthreads();
}

#ifndef DBGT
#define DBGT -1
#endif
#ifndef DBGS
#define DBGS 0.002f
#endif

constexpr int NB = 4, SEQ = 4096, DM = 2048, MTOK = NB * SEQ;
constexpr int NHEAD = 16, NGRP = 4, HDIM = 64, NSAW = 1024, KVW = 256;
constexpr int SSMW = 1024;
#ifndef KV8MASK
#define KV8MASK 0x0b
#endif
__host__ __device__ constexpr int kv_popc(int m) { return (m & 1) + ((m >> 1) & 1) + ((m >> 2) & 1) + ((m >> 3) & 1) + ((m >> 4) & 1); }
__host__ __device__ constexpr int kv_nth(int m, int k) { int c = 0; for (int i = 0; i < 5; ++i) if ((m >> i) & 1) { if (c == k) return i; ++c; } return 0; }
constexpr int NKV8 = kv_popc(KV8MASK), NKVB = 5 - NKV8;
constexpr int INW = 9776, INWP = 9984, INB = (18 + NKVB) * 256, ING = (16 + NKV8) * 256;
constexpr int CHUNK = 512, NCHUNK = SEQ / CHUNK;
constexpr float LN_EPS = 1e-5f;
constexpr float DN_ALPHA = 1.189207115002721f;
constexpr int NWAVES = 8, NTHR = 512;
#ifndef DBG
#define DBG 0
#endif
constexpr int LDS_BYTES = 159744, RING_BYTES = 155648, MISC_OFF = RING_BYTES + 320;

constexpr size_t MiB = 1u << 20;
constexpr size_t WS_CTL = 0, CTL_ZERO_BYTES = 1 * MiB;
constexpr int CW_BAR = 4096;
constexpr int CW_CMP = 7680;
constexpr int CW_SSM = 7680 + 16 * 16;
constexpr int CW_GEMV = CW_SSM + 16;
constexpr size_t WS_MOD = 32 * 1024;
constexpr size_t WS_MODP = 128 * 1024;
constexpr size_t WS_LUT = 512 * 1024;
constexpr size_t WS_BP = 520 * 1024;
constexpr size_t WS_KC = 1 * MiB;
constexpr size_t WS_VCT = 1 * MiB + 512 * 1024;
constexpr size_t WS_E = 2 * MiB;
constexpr size_t WS_WIN = 4 * MiB;
constexpr size_t WS_W8 = 28 * MiB;
constexpr size_t WS_WGLU = 43 * MiB;
constexpr size_t WS_WBN = 45 * MiB;
constexpr size_t WS_WBS = 49 * MiB;
constexpr size_t WS_WOUT = 53 * MiB;
constexpr size_t WS_WK1 = 61 * MiB;
constexpr size_t WS_WV1 = 61 * MiB + 512 * 1024;
constexpr size_t WS_WK2 = 62 * MiB;
constexpr size_t WS_WV2 = 62 * MiB + 64 * 1024;
constexpr size_t WS_H = 64 * MiB;
constexpr size_t WS_Q = 128 * MiB;
constexpr size_t WS_KCI = 160 * MiB, WS_VCI = 168 * MiB, WS_KS = 176 * MiB, WS_KW = 184 * MiB;
constexpr size_t WS_VST = 192 * MiB, WS_VWT = 200 * MiB;
constexpr size_t WS_NGB = 208 * MiB;
constexpr size_t WS_ZA = 212 * MiB;
constexpr size_t WS_US = 244 * MiB;
constexpr size_t WS_ZB = 276 * MiB;
constexpr size_t WS_GA = 308 * MiB, WS_GB = 372 * MiB;
constexpr size_t WS_OAB = 436 * MiB;
constexpr size_t WS_END = 500 * MiB;

typedef unsigned u32x2 __attribute__((ext_vector_type(2)));
typedef short s16x4 __attribute__((ext_vector_type(4)));

__device__ __forceinline__ float bflo(unsigned u) { return __builtin_bit_cast(float, u << 16); }
__device__ __forceinline__ float bfhi(unsigned u) { return __builtin_bit_cast(float, u & 0xffff0000u); }
__device__ __forceinline__ float bf2f(bf16 h) { return __builtin_bit_cast(float, (unsigned)h << 16); }
__device__ __forceinline__ unsigned cvtpk(float lo, float hi) { return pg8::cvt_pk_bf16(lo, hi); }
__device__ __forceinline__ float fexp(float x) { return __builtin_amdgcn_exp2f(x * 1.4426950408889634f); }
__device__ __forceinline__ float sigmoidf_(float v) { return __builtin_amdgcn_rcpf(1.f + fexp(-v)); }
__device__ __forceinline__ float siluf_(float v) { return v * sigmoidf_(v); }
__device__ __forceinline__ float gelu_tanh(float x) {
    const float z = 0.7978845608028654f * (x + 0.044715f * x * x * x);
    const float e = fexp(2.f * z);
    const float th = 1.f - 2.f * __builtin_amdgcn_rcpf(1.f + e);
    return 0.5f * x * (1.f + th);
}
__device__ __forceinline__ bf16x8 pack8(float a0, float a1, float a2, float a3, float a4, float a5, float a6, float a7) {
    v4u w; w.x = cvtpk(a0, a1); w.y = cvtpk(a2, a3); w.z = cvtpk(a4, a5); w.w = cvtpk(a6, a7);
    return __builtin_bit_cast(bf16x8, w);
}
__device__ __forceinline__ f32x4 mfma16(bf16x8 a, bf16x8 b, f32x4 c) { return __builtin_amdgcn_mfma_f32_16x16x32_bf16(a, b, c, 0, 0, 0); }
template <int CTRL> __device__ __forceinline__ float dppf(float x) { return __builtin_bit_cast(float, __builtin_amdgcn_mov_dpp(__builtin_bit_cast(int, x), CTRL, 0xf, 0xf, true)); }
template <int CTRL> __device__ __forceinline__ int dppi(int x) { return __builtin_amdgcn_mov_dpp(x, CTRL, 0xf, 0xf, true); }
constexpr int DPP_XOR1 = 0xB1, DPP_XOR2 = 0x4E, DPP_HMIRROR = 0x141;
__device__ __forceinline__ float xq_max(float x) {
    auto s = __builtin_amdgcn_permlane16_swap(__builtin_bit_cast(unsigned, x), __builtin_bit_cast(unsigned, x), false, false);
    x = fmaxf(__builtin_bit_cast(float, (unsigned)s[0]), __builtin_bit_cast(float, (unsigned)s[1]));
    auto t = __builtin_amdgcn_permlane32_swap(__builtin_bit_cast(unsigned, x), __builtin_bit_cast(unsigned, x), false, false);
    return fmaxf(__builtin_bit_cast(float, (unsigned)t[0]), __builtin_bit_cast(float, (unsigned)t[1]));
}
__device__ __forceinline__ float xq_sum(float x) {
    auto s = __builtin_amdgcn_permlane16_swap(__builtin_bit_cast(unsigned, x), __builtin_bit_cast(unsigned, x), false, false);
    x = __builtin_bit_cast(float, (unsigned)s[0]) + __builtin_bit_cast(float, (unsigned)s[1]);
    auto t = __builtin_amdgcn_permlane32_swap(__builtin_bit_cast(unsigned, x), __builtin_bit_cast(unsigned, x), false, false);
    return __builtin_bit_cast(float, (unsigned)t[0]) + __builtin_bit_cast(float, (unsigned)t[1]);
}

constexpr int DPP_RMIRROR = 0x140;
__device__ __forceinline__ float wave_sum(float v) {
    v += dppf<DPP_XOR1>(v); v += dppf<DPP_XOR2>(v); v += dppf<DPP_HMIRROR>(v); v += dppf<DPP_RMIRROR>(v);
    return xq_sum(v);
}

struct Ctx {
    float* out; unsigned char* ws;
    LAS unsigned char* lds;
    int tid, lane, wave, G, bid;
};
constexpr int PTR_OFF = RING_BYTES + 512;
__device__ __forceinline__ const float* inp(const Ctx& C, int i) {
    const LAS unsigned* tab = (const LAS unsigned*)(C.lds + PTR_OFF);
    const unsigned lo = __builtin_amdgcn_readfirstlane(tab[2 * i]), hi = __builtin_amdgcn_readfirstlane(tab[2 * i + 1]);
    return (const float*)(((unsigned long long)hi << 32) | lo);
}
#define WSP(T, off) ((T*)(C.ws + (off)))
__device__ __forceinline__ void counter_signal(const Ctx& C, int word) {
    if (C.tid == 0) { __builtin_amdgcn_fence(__ATOMIC_RELEASE, "agent"); asm volatile("s_waitcnt vmcnt(0)" ::: "memory");
        __hip_atomic_fetch_add((unsigned*)(C.ws + WS_CTL) + word, 1u, __ATOMIC_RELAXED, __HIP_MEMORY_SCOPE_AGENT); }
}
__device__ __forceinline__ void counter_wait(const Ctx& C, int word, unsigned target) {
    if (C.tid == 0) {
        unsigned* p = (unsigned*)(C.ws + WS_CTL) + word; unsigned sp = 0;
        while (__hip_atomic_load(p, __ATOMIC_RELAXED, __HIP_MEMORY_SCOPE_AGENT) < target) { __builtin_amdgcn_s_sleep(2); if (++sp > (1u << 22)) break; }
        __builtin_amdgcn_fence(__ATOMIC_ACQUIRE, "agent"); asm volatile("s_waitcnt vmcnt(0)" ::: "memory");
    }
    __syncthreads();
}

struct EpiIn {
    static constexpr bool PERM = true, AFTER_DRAIN = false, HAS_MID = false;
    unsigned char* ws; int gates;
    __device__ __forceinline__ void operator()(const pg8::f32x4 (&acc)[2][2][4][2], const pg8::Unit& u, int wr, int wc, int fr, int fq) const {
        const int pn = u.pn;
        int mode; size_t off; int ld; int cb;
        int kvid = -1;
        if (!gates) {
            if (pn < 4) { mode = 1; off = WS_Q; ld = 1024; cb = pn * 256; }
            else if (pn < 5) { mode = 0; off = WS_KCI; ld = 256; cb = 0; }
            else if (pn < 5 + NKVB) { kvid = kv_nth(0x1f & ~KV8MASK, pn - 5); }
            else if (pn < 9 + NKVB) { mode = 2; off = WS_ZA; ld = 1024; cb = (pn - 5 - NKVB) * 256; }
            else if (pn < 13 + NKVB) { mode = 0; off = WS_US; ld = 1024; cb = (pn - 9 - NKVB) * 256; }
            else if (pn < 17 + NKVB) { mode = 2; off = WS_ZB; ld = 1024; cb = (pn - 13 - NKVB) * 256; }
            else { mode = 5; off = WS_NGB; ld = 64; cb = 0; }
        } else {
            if (pn < NKV8) kvid = kv_nth(KV8MASK, pn);
            else { mode = 6; off = WS_GA; ld = 2048; cb = (pn - NKV8) * 128; }
        }
        if (kvid >= 0) { ld = 256; cb = 0; mode = (kvid == 2 || kvid == 4) ? 4 : 0;
            off = kvid == 0 ? WS_VCI : (kvid == 1 ? WS_KS : (kvid == 2 ? WS_VST : (kvid == 3 ? WS_KW : WS_VWT))); }
        const float gsc = gates ? 0.03125f : 1.f;
        bf16* base = (bf16*)(ws + off);
        const int row0 = u.pm * 256 + wr * 64 + fr;
        if (mode == 6) {
            bf16* gbp = (bf16*)(ws + WS_GB);
#pragma unroll
            for (int ai = 0; ai < 2; ++ai)
#pragma unroll
                for (int m = 0; m < 4; ++m) {
                    const size_t o = (size_t)(row0 + ai * 128 + m * 16) * 2048 + cb + wc * 32 + 8 * fq;
                    float ra[8], sb[8];
#pragma unroll
                    for (int e = 0; e < 8; ++e) {
                        const float a = acc[ai][0][m][e >> 2][e & 3] * gsc, bb = acc[ai][1][m][e >> 2][e & 3] * gsc;
                        const float A = 1.f + fexp(fminf(-a, 40.f)), B = 1.f + fexp(fminf(-bb, 40.f)), t = __builtin_amdgcn_rcpf(A * B);
                        ra[e] = t * B * B; sb[e] = t * A;
                    }
                    { v4u w; w.x = cvtpk(ra[0], ra[1]); w.y = cvtpk(ra[2], ra[3]); w.z = cvtpk(ra[4], ra[5]); w.w = cvtpk(ra[6], ra[7]); __builtin_nontemporal_store(w, (v4u*)(base + o)); }
                    { v4u w; w.x = cvtpk(sb[0], sb[1]); w.y = cvtpk(sb[2], sb[3]); w.z = cvtpk(sb[4], sb[5]); w.w = cvtpk(sb[6], sb[7]); __builtin_nontemporal_store(w, (v4u*)(gbp + o)); }
                }
            return;
        }
#pragma unroll
        for (int ai = 0; ai < 2; ++ai)
#pragma unroll
            for (int m = 0; m < 4; ++m) {
                const int row = row0 + ai * 128 + m * 16;
#pragma unroll
                for (int bj = 0; bj < 2; ++bj) {
                    const int cc = bj * 128 + wc * 32 + 8 * fq;
                    float v[8];
#pragma unroll
                    for (int e = 0; e < 4; ++e) { v[e] = acc[ai][bj][m][0][e] * gsc; v[4 + e] = acc[ai][bj][m][1][e] * gsc; }
                    if (mode == 1) {
#pragma unroll
                        for (int e = 0; e < 8; ++e) v[e] *= 0.125f;
                    } else if (mode == 2) {
#pragma unroll
                        for (int e = 0; e < 8; ++e) v[e] = siluf_(v[e]);
                    } else if (mode == 3 || mode == 5) {
#pragma unroll
                        for (int e = 0; e < 8; ++e) v[e] = sigmoidf_(v[e]);
                    }
                    if (mode == 4) {
                        const int b = row >> 12, t = row & 4095, g = cc >> 6, d0 = cc & 63, kk = t & 31;
                        const int pos = (t & 32) + 8 * ((kk & 15) >> 2) + 4 * (kk >> 4) + (kk & 3);
                        bf16* p = base + ((size_t)((b * 4 + g) * 64 + (t >> 6)) << 12) + d0 * 64 + pos;
#pragma unroll
                        for (int e = 0; e < 8; ++e) p[e * 64] = (bf16)(cvtpk(v[e], 0.f) & 0xffffu);
                    } else if (mode == 5) {
                        if (cc < 48) { v4u w; w.x = cvtpk(v[0], v[1]); w.y = cvtpk(v[2], v[3]); w.z = cvtpk(v[4], v[5]); w.w = cvtpk(v[6], v[7]);
                            *(v4u*)(base + (size_t)row * 64 + cc) = w; }
                    } else if (ld == 256) {
                        v4u w; w.x = cvtpk(v[0], v[1]); w.y = cvtpk(v[2], v[3]); w.z = cvtpk(v[4], v[5]); w.w = cvtpk(v[6], v[7]);
                        __builtin_nontemporal_store(w, (v4u*)(base + ((size_t)(((row >> 12) * 4 + (cc >> 6)) * 4096 + (row & 4095)) << 6) + (cc & 63)));
                    } else {
                        v4u w; w.x = cvtpk(v[0], v[1]); w.y = cvtpk(v[2], v[3]); w.z = cvtpk(v[4], v[5]); w.w = cvtpk(v[6], v[7]);
                        __builtin_nontemporal_store(w, (v4u*)(base + (size_t)row * ld + cb + cc));
                    }
                }
            }
    }
};

template <int MODE> struct EpiMix {
    static constexpr bool PERM = true, AFTER_DRAIN = false, HAS_MID = (MODE == 1);
    const bf16* P0; const bf16* P1; bf16* O; const float* F0; const float* F1; float* OF; int ld; int ldo;
    __device__ __forceinline__ void mid(pg8::f32x4 (&acc)[2][2][4][2], const pg8::Unit& u, int wr, int wc, int fr, int fq) const {
        const int row0 = u.pm * 256 + wr * 64 + fr;
#pragma unroll
        for (int ai = 0; ai < 2; ++ai) {
            v4u ga[4][2];
#pragma unroll
            for (int m = 0; m < 4; ++m)
#pragma unroll
                for (int bj = 0; bj < 2; ++bj) {
                    const size_t idx = (size_t)(row0 + ai * 128 + m * 16) * ld + u.pn * 256 + bj * 128 + wc * 32 + 8 * fq;
                    ga[m][bj] = *(const v4u*)(P0 + idx);
                }
#pragma unroll
            for (int m = 0; m < 4; ++m)
#pragma unroll
                for (int bj = 0; bj < 2; ++bj) {
                    const unsigned aa[4] = {ga[m][bj].x, ga[m][bj].y, ga[m][bj].z, ga[m][bj].w};
#pragma unroll
                    for (int e = 0; e < 4; ++e) { acc[ai][bj][m][e >> 1][(2 * e) & 3] *= bflo(aa[e]); acc[ai][bj][m][e >> 1][(2 * e + 1) & 3] *= bfhi(aa[e]); }
                }
            __builtin_amdgcn_sched_barrier(0);
        }
    }
    __device__ __forceinline__ void operator()(const pg8::f32x4 (&acc)[2][2][4][2], const pg8::Unit& u, int wr, int wc, int fr, int fq) const {
        const int row0 = u.pm * 256 + wr * 64 + fr;
        f32x4 cv[2][2];
        if (MODE == 0 || MODE == 3) {
#pragma unroll
            for (int bj = 0; bj < 2; ++bj) {
                const int col = u.pn * 256 + bj * 128 + wc * 32 + 8 * fq;
                const float* cp = MODE == 0 ? F0 + col : F1 + (u.pm >> 4) * 6144 + 4096 + col;
                cv[bj][0] = *(const f32x4*)cp; cv[bj][1] = *(const f32x4*)(cp + 4);
            }
        }
#pragma unroll
        for (int ai = 0; ai < 2; ++ai) {
            v4u la[4][2], lb[4][2];
            if (MODE != 3) {
#pragma unroll
                for (int m = 0; m < 4; ++m)
#pragma unroll
                    for (int bj = 0; bj < 2; ++bj) {
                        const size_t idx = (size_t)(row0 + ai * 128 + m * 16) * ld + u.pn * 256 + bj * 128 + wc * 32 + 8 * fq;
                        if (MODE == 0) { la[m][bj] = *(const v4u*)(P0 + idx); lb[m][bj] = *(const v4u*)(P1 + idx); }
                        else if (MODE == 1) { la[m][bj] = *(const v4u*)(P1 + idx); }
                        else { la[m][bj] = *(const v4u*)(P0 + idx); lb[m][bj] = *(const v4u*)(P1 + idx); }
                    }
            }
#pragma unroll
            for (int m = 0; m < 4; ++m) {
                const int row = row0 + ai * 128 + m * 16;
#pragma unroll
                for (int bj = 0; bj < 2; ++bj) {
                    const int col = u.pn * 256 + bj * 128 + wc * 32 + 8 * fq;
                    float v[8];
#pragma unroll
                    for (int e = 0; e < 4; ++e) { v[e] = acc[ai][bj][m][0][e]; v[4 + e] = acc[ai][bj][m][1][e]; }
                    if (MODE == 0) {
                        const v4u y = la[m][bj], z = lb[m][bj];
                        const f32x4 b0 = cv[bj][0], b1 = cv[bj][1];
                        const float bb[8] = {b0.x, b0.y, b0.z, b0.w, b1.x, b1.y, b1.z, b1.w};
                        const unsigned yy[4] = {y.x, y.y, y.z, y.w}, zz[4] = {z.x, z.y, z.z, z.w};
#pragma unroll
                        for (int e = 0; e < 4; ++e) {
                            v[2 * e] = bflo(yy[e]) * sigmoidf_(v[2 * e] + bb[2 * e]) * bflo(zz[e]);
                            v[2 * e + 1] = bfhi(yy[e]) * sigmoidf_(v[2 * e + 1] + bb[2 * e + 1]) * bfhi(zz[e]);
                        }
                    } else if (MODE == 1) {
                        const v4u g = la[m][bj]; const unsigned gg[4] = {g.x, g.y, g.z, g.w};
#pragma unroll
                        for (int e = 0; e < 4; ++e) { v[2 * e] *= bflo(gg[e]); v[2 * e + 1] *= bfhi(gg[e]); }
                    } else if (MODE == 2) {
                        const v4u g = la[m][bj], m1 = lb[m][bj];
                        const unsigned gg[4] = {g.x, g.y, g.z, g.w}, mm[4] = {m1.x, m1.y, m1.z, m1.w};
#pragma unroll
                        for (int e = 0; e < 4; ++e) { v[2 * e] = bflo(mm[e]) + v[2 * e] * bflo(gg[e]); v[2 * e + 1] = bfhi(mm[e]) + v[2 * e + 1] * bfhi(gg[e]); }
                    } else {
                        const f32x4 g0 = cv[bj][0], g1 = cv[bj][1];
                        v[0] *= g0.x; v[1] *= g0.y; v[2] *= g0.z; v[3] *= g0.w; v[4] *= g1.x; v[5] *= g1.y; v[6] *= g1.z; v[7] *= g1.w;
                        if (DBG == 1) {
#pragma unroll
                            for (int e = 0; e < 8; ++e) v[e] = 0.f; }
                    }
                    { v4u w; w.x = cvtpk(v[0], v[1]); w.y = cvtpk(v[2], v[3]); w.z = cvtpk(v[4], v[5]); w.w = cvtpk(v[6], v[7]); *(v4u*)(O + (size_t)row * ldo + col) = w; }
                }
            }
        }
    }
};

__device__ __forceinline__ int win_src_col(int n) {
    const int t = n >> 8, c = n & 255;
    if (n < INB) {
        if (t < 5) return n;
        if (t < 5 + NKVB) return 1280 + 256 * kv_nth(0x1f & ~KV8MASK, t - 5) + c;
        const int t2 = t - 5 - NKVB;
        if (t2 < 12) return 2608 + 256 * t2 + c;
        return c < 48 ? 2560 + c : -1;
    }
    const int t8 = t - INB / 256;
    if (t8 < NKV8) return 1280 + 256 * kv_nth(KV8MASK, t8) + c;
    { const int gt = t8 - NKV8; return c < 128 ? 5680 + 128 * gt + c : 7728 + 128 * gt + (c - 128); }
}
struct TItem { const float* src; unsigned char* dst; int N, sc; bool f8; };
__device__ __forceinline__ void titem_load(const TItem& T, f32x4 (&v)[16]) {
#pragma unroll
    for (int i = 0; i < 16; ++i) v[i] = (T.sc >= 0) ? __builtin_nontemporal_load((const f32x4*)(T.src + (size_t)(4 * i) * T.N)) : (f32x4){0.f, 0.f, 0.f, 0.f};
}
__device__ __forceinline__ void titem_store(const TItem& T, const f32x4 (&v)[16], LAS float* scr, int lane) {
    const int ksub = lane >> 4, n4 = 4 * (lane & 15);
    const bool f8 = T.f8;
    v4u o[8];
#pragma unroll
    for (int h = 0; h < 2; ++h) {
#pragma unroll
        for (int i = 0; i < 8; ++i) *(LAS f32x4*)(scr + (4 * i + ksub) * 68 + n4) = v[8 * h + i];
        LDS_WAIT(); asm volatile("" ::: "memory");
        if (f8) {
            unsigned wd[8];
#pragma unroll
            for (int c = 0; c < 8; ++c) { const LAS float* s = scr + (4 * c) * 68 + lane;
                int t = __builtin_amdgcn_cvt_pk_fp8_f32(s[0 * 68] * 32.f, s[1 * 68] * 32.f, 0, false); t = __builtin_amdgcn_cvt_pk_fp8_f32(s[2 * 68] * 32.f, s[3 * 68] * 32.f, t, true); wd[c] = (unsigned)t; }
            o[2 * h] = (v4u){wd[0], wd[1], wd[2], wd[3]}; o[2 * h + 1] = (v4u){wd[4], wd[5], wd[6], wd[7]};
        } else {
#pragma unroll
            for (int c = 0; c < 4; ++c) { const LAS float* s = scr + (8 * c) * 68 + lane;
                o[4 * h + c].x = cvtpk(s[0 * 68], s[1 * 68]); o[4 * h + c].y = cvtpk(s[2 * 68], s[3 * 68]); o[4 * h + c].z = cvtpk(s[4 * 68], s[5 * 68]); o[4 * h + c].w = cvtpk(s[6 * 68], s[7 * 68]); }
        }
        LDS_WAIT(); asm volatile("" ::: "memory");
    }
    v4u* wp = (v4u*)T.dst;
    if (f8) {
#pragma unroll
        for (int c = 0; c < 4; ++c) wp[c] = o[c];
    } else {
#pragma unroll
        for (int c = 0; c < 8; ++c) wp[c] = o[c];
    }
}

__device__ __forceinline__ void phase0(const Ctx& C) {
    LAS float* scr = (LAS float*)(C.lds + C.wave * 16384);
    const int gw = C.bid * NWAVES + C.wave, NGW = C.G * NWAVES, lane = C.lane;
    const int NGV = (C.G >= 192) ? 96 : 0;
    if (C.bid < 96 && (NGV || C.bid == 0)) {
        const float* cvec = inp(C, 1); const float* wada = inp(C, 2); float* modp = WSP(float, WS_MODP);
        for (int u = C.bid; u < 96; u += (NGV ? 96 : 1)) {
            const int nc = u % 24, kq = u / 24;
            const int n0 = nc * 256 + 4 * lane, kb = kq * 512 + C.wave * 64;
            f32x4 a0 = {0, 0, 0, 0}, a1 = a0, a2 = a0, a3 = a0;
#pragma unroll 16
            for (int k = kb; k < kb + 64; ++k) {
                const f32x4 w = __builtin_nontemporal_load((const f32x4*)(wada + (size_t)k * 6144 + n0));
                a0 += w * cvec[k]; a1 += w * cvec[2048 + k]; a2 += w * cvec[4096 + k]; a3 += w * cvec[6144 + k];
            }
            LAS f32x4* part = (LAS f32x4*)C.lds;
            part[(C.wave * 4 + 0) * 64 + lane] = a0; part[(C.wave * 4 + 1) * 64 + lane] = a1; part[(C.wave * 4 + 2) * 64 + lane] = a2; part[(C.wave * 4 + 3) * 64 + lane] = a3;
            __syncthreads();
            if (C.wave < 4) {
                f32x4 s = part[C.wave * 64 + lane];
#pragma unroll
                for (int w8 = 1; w8 < 8; ++w8) s += part[(w8 * 4 + C.wave) * 64 + lane];
                *(f32x4*)(modp + (size_t)(kq * 4 + C.wave) * 6144 + n0) = s;
                asm volatile("s_waitcnt vmcnt(0)" ::: "memory");
            }
            __syncthreads();
            counter_signal(C, CW_GEMV);
        }
    }
    {
        constexpr int I_IN = 32 * (INWP / 64), I_GLU = 16 * 16, I_BN = 16 * 32, I_OUT = 32 * 32, I_C1 = 32 * 2, I_C2 = 2 * 1;
        constexpr int NIT = I_IN + I_GLU + 2 * I_BN + I_OUT + 2 * I_C1 + 2 * I_C2;
        constexpr int QG = 2;
        const int NGW_G = NGV * NWAVES, NGWC = (C.G - NGV) * NWAVES, NG_IT = QG * NGW_G;
        int it, iend, istep;
        if (C.bid >= NGV) { it = NG_IT + (C.bid - NGV) * NWAVES + C.wave; iend = NIT; istep = NGWC; }
        else { it = C.bid * NWAVES + C.wave; iend = NG_IT; istep = NGW_G; }
        auto decode = [&](int item) -> TItem {
            int r = item; const float* W; int N, NP, ldk, koff = 0; size_t wo; bool win = false;
            if (r < I_IN) { W = inp(C, 4); N = INW; NP = INWP; ldk = 2048; wo = WS_WIN; win = true; }
            else if ((r -= I_IN) < I_GLU) { W = inp(C, 20); N = 1024; NP = 1024; ldk = 1024; wo = WS_WGLU; }
            else if ((r -= I_GLU) < I_BN) { W = inp(C, 22); N = 2048; NP = 2048; ldk = 2048; wo = WS_WBN; }
            else if ((r -= I_BN) < I_BN) { W = inp(C, 23); N = 2048; NP = 2048; ldk = 2048; koff = 1024; wo = WS_WBN; }
            else if ((r -= I_BN) < I_OUT) { W = inp(C, 24); N = 2048; NP = 2048; ldk = 2048; wo = WS_WOUT; }
            else if ((r -= I_OUT) < I_C1) { W = inp(C, 8); N = 128; NP = 128; ldk = 2048; wo = WS_WK1; }
            else if ((r -= I_C1) < I_C1) { W = inp(C, 10); N = 128; NP = 128; ldk = 2048; wo = WS_WV1; }
            else if ((r -= I_C1) < I_C2) { W = inp(C, 9); N = 64; NP = 64; ldk = 128; wo = WS_WK2; }
            else { r -= I_C2; W = inp(C, 11); N = 64; NP = 64; ldk = 128; wo = WS_WV2; }
            const int nblk = NP / 64, kb = r / nblk, nb = r - kb * nblk, k0 = 64 * kb, n0 = 64 * nb;
            const int nn = n0 + 4 * (lane & 15); const int sc = win ? win_src_col(nn) : nn;
            TItem T; T.N = N; T.sc = sc; T.f8 = win && n0 >= INB;
            T.src = W + (size_t)(k0 + (lane >> 4)) * N + (sc >= 0 ? sc : 0);
            T.dst = T.f8 ? C.ws + WS_W8 + (size_t)(n0 - INB + lane) * 2048 + k0 : C.ws + wo + ((size_t)(n0 + lane) * ldk + koff + k0) * 2;
            return T;
        };
        if (it < iend) {
            TItem T = decode(it);
            f32x4 v[16];
            titem_load(T, v);
            for (; it < iend; it += istep) {
                const bool more = it + istep < iend;
                TItem Tn = T; f32x4 nv[16];
                if (more) { Tn = decode(it + istep); titem_load(Tn, nv); }
                titem_store(T, v, scr, lane);
                if (more) {
#pragma unroll
                    for (int i = 0; i < 16; ++i) v[i] = nv[i];
                    T = Tn;
                }
            }
        }
    }
    if (C.bid == C.G - 1) {
        const float* rb = inp(C, 5); float* lut = WSP(float, WS_LUT);
        for (int i = C.tid; i < 16 * 128; i += NTHR) {
            const int h = i >> 7, d = i & 127; int bk;
            if (d < 16) bk = d; else { const float v = logf((float)d / 16.f) / 2.0794415416798357f * 16.f; bk = 16 + (int)v; if (bk > 31) bk = 31; }
            lut[i] = rb[bk * 16 + h];
        }
    }
}

__device__ __forceinline__ void phase1(const Ctx& C) {
    const int gw = C.bid * NWAVES + C.wave, NGW = C.G * NWAVES, lane = C.lane;
    const float* x = inp(C, 0); bf16* H = WSP(bf16, WS_H);
    const float* modp = WSP(const float, WS_MODP); const float* bada = inp(C, 3);
#define MOD4(b_, o_) ({ const int o4_ = (o_); f32x4 s_ = *(const f32x4*)(bada + o4_); \
        s_ += *(const f32x4*)(modp + (size_t)(0 * 4 + (b_)) * 6144 + o4_); s_ += *(const f32x4*)(modp + (size_t)(1 * 4 + (b_)) * 6144 + o4_); \
        s_ += *(const f32x4*)(modp + (size_t)(2 * 4 + (b_)) * 6144 + o4_); s_ += *(const f32x4*)(modp + (size_t)(3 * 4 + (b_)) * 6144 + o4_); s_; })
    for (int gq = gw; gq < 32; gq += NGW) {
        const int b = gq >> 3, o = 4096 + (gq & 7) * 256 + 4 * lane;
        *(f32x4*)(WSP(float, WS_MOD) + b * 6144 + o) = MOD4(b, o);
    }
    if (NGW == 2048) {
        const int b = gw & 3, r0 = gw >> 2;
        f32x4 sh[8], sc[8];
#pragma unroll
        for (int j = 0; j < 8; ++j) { sh[j] = MOD4(b, 4 * (lane + 64 * j)); const f32x4 g = MOD4(b, 2048 + 4 * (lane + 64 * j)); sc[j] = g + 1.f; }
        f32x4 v[8];
        { const f32x4* xr = (const f32x4*)(x + (size_t)(b * SEQ + r0) * DM) + lane;
#pragma unroll
          for (int j = 0; j < 8; ++j) v[j] = __builtin_nontemporal_load(xr + 64 * j); }
        for (int k = 0; k < 8; ++k) {
            const int m = b * SEQ + r0 + 512 * k;
            f32x4 nv[8];
            { const int mn = (k < 7) ? m + 512 : m; const f32x4* xr = (const f32x4*)(x + (size_t)mn * DM) + lane;
#pragma unroll
              for (int j = 0; j < 8; ++j) nv[j] = __builtin_nontemporal_load(xr + 64 * j); }
            float s = 0.f;
#pragma unroll
            for (int j = 0; j < 8; ++j) s += (v[j].x + v[j].y) + (v[j].z + v[j].w);
            const float mean = wave_sum(s) * (1.f / DM); float s2 = 0.f;
#pragma unroll
            for (int j = 0; j < 8; ++j) { v[j] = v[j] - mean; s2 += (v[j].x * v[j].x + v[j].y * v[j].y) + (v[j].z * v[j].z + v[j].w * v[j].w); }
            const float rstd = 1.f / sqrtf(wave_sum(s2) * (1.f / DM) + LN_EPS);
            u32x2* o8 = (u32x2*)(H + (size_t)m * DM) + lane;
#pragma unroll
            for (int j = 0; j < 8; ++j) {
                const f32x4 hh = v[j] * rstd * sc[j] + sh[j];
                u32x2 w; w.x = cvtpk(hh.x, hh.y); w.y = cvtpk(hh.z, hh.w); o8[64 * j] = w;
                int t8 = __builtin_amdgcn_cvt_pk_fp8_f32(hh.x, hh.y, 0, false); t8 = __builtin_amdgcn_cvt_pk_fp8_f32(hh.z, hh.w, t8, true);
                ((unsigned*)(C.ws + WS_OAB + (size_t)m * DM))[lane + 64 * j] = (unsigned)t8;
            }
#pragma unroll
            for (int j = 0; j < 8; ++j) v[j] = nv[j];
        }
    } else
    {
        f32x4 v[8];
        if (gw < MTOK) { const f32x4* xr = (const f32x4*)(x + (size_t)gw * DM) + lane;
#pragma unroll
            for (int j = 0; j < 8; ++j) v[j] = xr[64 * j]; }
        for (int m = gw; m < MTOK; m += NGW) {
            const int b = m >> 12;
            f32x4 nv[8];
            { const int mn = (m + NGW < MTOK) ? m + NGW : m; const f32x4* xr = (const f32x4*)(x + (size_t)mn * DM) + lane;
#pragma unroll
              for (int j = 0; j < 8; ++j) nv[j] = xr[64 * j]; }
            float s = 0.f;
#pragma unroll
            for (int j = 0; j < 8; ++j) s += (v[j].x + v[j].y) + (v[j].z + v[j].w);
            const float mean = wave_sum(s) * (1.f / DM); float s2 = 0.f;
#pragma unroll
            for (int j = 0; j < 8; ++j) { v[j] = v[j] - mean; s2 += (v[j].x * v[j].x + v[j].y * v[j].y) + (v[j].z * v[j].z + v[j].w * v[j].w); }
            const float rstd = 1.f / sqrtf(wave_sum(s2) * (1.f / DM) + LN_EPS);

            u32x2* o8 = (u32x2*)(H + (size_t)m * DM) + lane;
#pragma unroll
            for (int j = 0; j < 8; ++j) {
                const f32x4 a = MOD4(b, 4 * (lane + 64 * j)), g = MOD4(b, 2048 + 4 * (lane + 64 * j));
                const float h0 = v[j].x * rstd * (1.f + g.x) + a.x, h1 = v[j].y * rstd * (1.f + g.y) + a.y, h2 = v[j].z * rstd * (1.f + g.z) + a.z, h3 = v[j].w * rstd * (1.f + g.w) + a.w;
                u32x2 w; w.x = cvtpk(h0, h1); w.y = cvtpk(h2, h3); o8[64 * j] = w;
            }
#pragma unroll
            for (int j = 0; j < 8; ++j) v[j] = nv[j];
        }
    }
    for (int it = C.bid; it < 256; it += C.G) {
        const int kv = it >> 7, uu = it & 127; const float* pos = inp(C, kv ? 7 : 6); const float* w1 = inp(C, kv ? 10 : 8);
        float s = 0.f;
#pragma unroll
        for (int i = 0; i < 4; ++i) { const int k = 256 * C.wave + lane + 64 * i; s += pos[k] * w1[(size_t)k * 128 + uu]; }
        s = wave_sum(s);
        LAS float* red = (LAS float*)C.lds;
        if (lane == 0) red[C.wave] = s;
        __syncthreads();
        if (C.tid == 0) { float t = red[0]; for (int w8 = 1; w8 < 8; ++w8) t += red[w8]; WSP(float, WS_BP)[it] = t; }
        __syncthreads();
    }
}

__device__ __forceinline__ void phase_ln_out(const Ctx& C) {
    const int gw = C.bid * NWAVES + C.wave, NGW = C.G * NWAVES, lane = C.lane;
    const float* x = inp(C, 0); const float* lg = inp(C, 25); const float* lb = inp(C, 26); const bf16* GY = WSP(bf16, WS_Q);
    f32x4 v[8]; u32x2 y[8];
    f32x4 lgv[8], lbv[8];
#pragma unroll
    for (int j = 0; j < 8; ++j) { lgv[j] = ((const f32x4*)lg)[lane + 64 * j]; lbv[j] = ((const f32x4*)lb)[lane + 64 * j]; }
    if (gw < MTOK) { const f32x4* xr = (const f32x4*)(x + (size_t)gw * DM) + lane; const u32x2* yr = (const u32x2*)(GY + (size_t)gw * DM) + lane;
#pragma unroll
        for (int j = 0; j < 8; ++j) { v[j] = __builtin_nontemporal_load(xr + 64 * j); y[j] = yr[64 * j]; } }
    for (int m = gw; m < MTOK; m += NGW) {
        f32x4* zr = (f32x4*)(C.out + (size_t)m * DM) + lane;
        f32x4 nv[8]; u32x2 ny[8];
        { const int mn = (m + NGW < MTOK) ? m + NGW : m; const f32x4* xn = (const f32x4*)(x + (size_t)mn * DM) + lane; const u32x2* yn = (const u32x2*)(GY + (size_t)mn * DM) + lane;
#pragma unroll
          for (int j = 0; j < 8; ++j) { nv[j] = __builtin_nontemporal_load(xn + 64 * j); ny[j] = yn[64 * j]; } }
        float s = 0.f;
#pragma unroll
        for (int j = 0; j < 8; ++j) { v[j].x = DN_ALPHA * v[j].x + bflo(y[j].x); v[j].y = DN_ALPHA * v[j].y + bfhi(y[j].x); v[j].z = DN_ALPHA * v[j].z + bflo(y[j].y); v[j].w = DN_ALPHA * v[j].w + bfhi(y[j].y);
            s += (v[j].x + v[j].y) + (v[j].z + v[j].w); }
        const float mean = wave_sum(s) * (1.f / DM); float s2 = 0.f;
#pragma unroll
        for (int j = 0; j < 8; ++j) { v[j] = v[j] - mean; s2 += (v[j].x * v[j].x + v[j].y * v[j].y) + (v[j].z * v[j].z + v[j].w * v[j].w); }
        const float rstd = 1.f / sqrtf(wave_sum(s2) * (1.f / DM) + LN_EPS);
#pragma unroll
        for (int j = 0; j < 8; ++j) {
            const f32x4 g = lgv[j], bb = lbv[j];
            f32x4 o; o.x = v[j].x * rstd * g.x + bb.x; o.y = v[j].y * rstd * g.y + bb.y; o.z = v[j].z * rstd * g.z + bb.z; o.w = v[j].w * rstd * g.w + bb.w;
            __builtin_nontemporal_store(o, zr + 64 * j);
        }
#pragma unroll
        for (int j = 0; j < 8; ++j) { v[j] = nv[j]; y[j] = ny[j]; }
    }
}

constexpr int HS = 136;
constexpr int SSM_HS_OFF = 0, SSM_EL_OFF = 8 * 16 * HS * 2, SSM_SH_OFF = SSM_EL_OFF + 32 * 64 * 8;
typedef float f32x2v __attribute__((ext_vector_type(2)));
template <bool FINAL>
__device__ __forceinline__ void ssm_pass(const Ctx& C, int b, int g, const bf16x8 (&Bf)[8], const bf16x8 (&Cf)[4], const float (&lr)[4], const float (&li)[4],
                                         float (&hr)[4], float (&hi)[4], const float (&dskip)[4]) {
    const int lane = C.lane, c16 = lane & 15, q = lane >> 4, w = C.wave;
    const bf16* US = WSP(bf16, WS_US);
    LAS unsigned* Hs = (LAS unsigned*)(C.lds + SSM_HS_OFF + w * (16 * HS * 2));
    const size_t row0 = (size_t)(b * SEQ + 512 * w + 128 * (c16 >> 2) + (c16 & 3));
    const bf16* uptr = US + row0 * 1024 + g * 16 + 8 * (q & 1);
    const bf16* qptr = US + row0 * 1024 + g * 16 + 4 * q;
    constexpr int PG = 4;
    bf16x8 An[PG]; u32x2 un[PG];
#pragma unroll
    for (int i = 0; i < PG; ++i) { An[i] = *(const bf16x8*)(uptr + (size_t)i * 4096); un[i] = FINAL ? *(const u32x2*)(qptr + (size_t)i * 4096) : (u32x2){0u, 0u}; }
#pragma unroll 1
    for (int sg = 0; sg < 32 / PG; ++sg) {
        bf16x8 Ac[PG]; u32x2 uc[PG];
#pragma unroll
        for (int i = 0; i < PG; ++i) { Ac[i] = An[i]; uc[i] = un[i]; }
        { const int sn = (sg + 1 < 32 / PG) ? sg + 1 : sg;
#pragma unroll
          for (int i = 0; i < PG; ++i) { An[i] = *(const bf16x8*)(uptr + (size_t)(PG * sn + i) * 4096); un[i] = FINAL ? *(const u32x2*)(qptr + (size_t)(PG * sn + i) * 4096) : (u32x2){0u, 0u}; } }
#pragma unroll
        for (int si = 0; si < PG; ++si) {
            bf16x8 Af = Ac[si];
            if (q >= 2) Af = (bf16x8){0, 0, 0, 0, 0, 0, 0, 0};
            f32x4 d[8];
#pragma unroll
            for (int nt = 0; nt < 8; ++nt) d[nt] = mfma16(Af, Bf[nt], (f32x4){0.f, 0.f, 0.f, 0.f});
#pragma unroll
            for (int i = 0; i < 4; ++i)
#pragma unroll
                for (int nt = 0; nt < 4; ++nt) {
                    const float tr = __builtin_fmaf(lr[nt], hr[nt], __builtin_fmaf(-li[nt], hi[nt], d[nt][i])); hi[nt] = __builtin_fmaf(lr[nt], hi[nt], __builtin_fmaf(li[nt], hr[nt], d[nt + 4][i])); hr[nt] = tr;
                    asm("" : "+v"(hr[nt]), "+v"(hi[nt]));
                    if (FINAL) Hs[(4 * q + i) * (HS / 2) + 16 * nt + c16] = cvtpk(hr[nt], hi[nt]);
                }
            if (FINAL) {
                LDS_WAIT(); asm volatile("" ::: "memory");
                f32x4 y = {0.f, 0.f, 0.f, 0.f};
#pragma unroll
                for (int ks = 0; ks < 4; ++ks) { const bf16x8 hb = *(const LAS bf16x8*)((const LAS unsigned char*)Hs + c16 * (HS * 2) + (32 * ks + 8 * q) * 2); y = mfma16(Cf[ks], hb, y); }
                const u32x2 uq = uc[si];
                const float o0 = gelu_tanh(y[0] + dskip[0] * bflo(uq.x)), o1 = gelu_tanh(y[1] + dskip[1] * bfhi(uq.x));
                const float o2 = gelu_tanh(y[2] + dskip[2] * bflo(uq.y)), o3 = gelu_tanh(y[3] + dskip[3] * bfhi(uq.y));
                u32x2 ov; ov.x = cvtpk(o0, o1); ov.y = cvtpk(o2, o3);
                *(u32x2*)(WSP(bf16, WS_H) + (row0 + (size_t)(4 * (PG * sg + si))) * 1024 + g * 16 + 4 * q) = ov;
                LDS_WAIT(); asm volatile("" ::: "memory");
            }
        }
    }
}

__device__ __forceinline__ void ssm_item(const Ctx& C, int item) {
    const int lane = C.lane, c16 = lane & 15, q = lane >> 4, w = C.wave;
    const int g = item & 63, b = item >> 6;
    if (DBGT >= 40 && C.bid == 0 && C.tid == 0) { volatile LAS unsigned long long* TSX = (volatile LAS unsigned long long*)(C.lds + RING_BYTES + 1024); TSX[47] = __builtin_amdgcn_s_memrealtime(); }
    const float* a_re = inp(C, 12); const float* a_im = inp(C, 13); const float* log_dt = inp(C, 14);
    const float* b_re = inp(C, 15); const float* b_im = inp(C, 16); const float* c_re = inp(C, 17); const float* c_im = inp(C, 18); const float* dsk = inp(C, 19);
    LAS f32x2v* EL = (LAS f32x2v*)(C.lds + SSM_EL_OFF); LAS bf16x8* SH = (LAS bf16x8*)(C.lds + SSM_SH_OFF);
    const float ldt = log_dt[g];
    float ar[4], ai[4];
#pragma unroll
    for (int nt = 0; nt < 4; ++nt) { ar[nt] = a_re[g * 64 + 16 * nt + c16]; ai[nt] = a_im[g * 64 + 16 * nt + c16]; }
    const int ntw = w & 3, ps = g * 64 + 16 * ntw + c16;
    f32x4 r0 = {0.f, 0.f, 0.f, 0.f}, r1 = r0, i0 = r0, i1 = r0;
    if (q < 2) { r0 = *(const f32x4*)(b_re + (size_t)ps * 16 + 8 * q); r1 = *(const f32x4*)(b_re + (size_t)ps * 16 + 8 * q + 4);
                 i0 = *(const f32x4*)(b_im + (size_t)ps * 16 + 8 * q); i1 = *(const f32x4*)(b_im + (size_t)ps * 16 + 8 * q + 4); }
    f32x4 vr = {0.f, 0.f, 0.f, 0.f}, vi = vr;
    if (w < 4) { const size_t o = (size_t)(g * 16 + c16) * 64 + 16 * w + 4 * q; vr = *(const f32x4*)(c_re + o); vi = *(const f32x4*)(c_im + o); }
    const f32x4 dv = *(const f32x4*)(dsk + g * 16 + 4 * q);
    const float dt = __expf(ldt);
    float lr[4], li[4], fr[4], fi[4];
#pragma unroll
    for (int nt = 0; nt < 4; ++nt) {
        const float mag = __expf(ar[nt] * dt); lr[nt] = mag * __cosf(ai[nt] * dt); li[nt] = mag * __sinf(ai[nt] * dt);
        const float den = ar[nt] * ar[nt] + ai[nt] * ai[nt], nr = lr[nt] - 1.f, ni = li[nt];
        fr[nt] = (nr * ar[nt] + ni * ai[nt]) / den; fi[nt] = (ni * ar[nt] - nr * ai[nt]) / den;
    }
    {
        float frw = fr[0], fiw = fi[0];
#pragma unroll
        for (int nt = 1; nt < 4; ++nt) if (ntw == nt) { frw = fr[nt]; fiw = fi[nt]; }
        const float ca = (w >= 4) ? fiw : frw, cb = (w >= 4) ? frw : -fiw;
        bf16x8 f = pack8(ca * r0.x + cb * i0.x, ca * r0.y + cb * i0.y, ca * r0.z + cb * i0.z, ca * r0.w + cb * i0.w, ca * r1.x + cb * i1.x, ca * r1.y + cb * i1.y, ca * r1.z + cb * i1.z, ca * r1.w + cb * i1.w);
        if (q >= 2) f = (bf16x8){0, 0, 0, 0, 0, 0, 0, 0};
        SH[w * 64 + lane] = f;
        if (w < 4) SH[(8 + w) * 64 + lane] = pack8(vr.x, -vi.x, vr.y, -vi.y, vr.z, -vi.z, vr.w, -vi.w);
    }
    __syncthreads();
    bf16x8 Bf[8], Cf[4];
#pragma unroll
    for (int nt = 0; nt < 8; ++nt) Bf[nt] = SH[nt * 64 + lane];
#pragma unroll
    for (int ks = 0; ks < 4; ++ks) Cf[ks] = SH[(8 + ks) * 64 + lane];
    const float dskip[4] = {dv.x, dv.y, dv.z, dv.w};
    float hr[4] = {0.f, 0.f, 0.f, 0.f}, hi[4] = {0.f, 0.f, 0.f, 0.f};
    if (DBGT >= 40 && C.bid == 0 && C.tid == 0) { volatile LAS unsigned long long* TSX = (volatile LAS unsigned long long*)(C.lds + RING_BYTES + 1024); const unsigned long long tn = __builtin_amdgcn_s_memrealtime(); TSX[42] += tn - TSX[47]; TSX[47] = tn; }
    ssm_pass<false>(C, b, g, Bf, Cf, lr, li, hr, hi, dskip);
    if (DBGT >= 40 && C.bid == 0 && C.tid == 0) { volatile LAS unsigned long long* TSX = (volatile LAS unsigned long long*)(C.lds + RING_BYTES + 1024); const unsigned long long tn = __builtin_amdgcn_s_memrealtime(); TSX[43] += tn - TSX[47]; TSX[47] = tn; }
    const int sc = 4 * w + q;
#pragma unroll
    for (int nt = 0; nt < 4; ++nt) EL[sc * 64 + 16 * nt + c16] = (f32x2v){hr[nt], hi[nt]};
    __syncthreads();
    {
        float Lr[4], Li[4];
#pragma unroll
        for (int nt = 0; nt < 4; ++nt) { Lr[nt] = lr[nt]; Li[nt] = li[nt];
#pragma unroll
            for (int s = 0; s < 7; ++s) { const float t = Lr[nt] * Lr[nt] - Li[nt] * Li[nt]; Li[nt] = 2.f * Lr[nt] * Li[nt]; Lr[nt] = t; } }
#pragma unroll
        for (int nt = 0; nt < 4; ++nt) { hr[nt] = 0.f; hi[nt] = 0.f; }
        for (int cc = 0; cc < 31; ++cc) {
            if (cc < sc) {
#pragma unroll
                for (int nt = 0; nt < 4; ++nt) { const f32x2v e = EL[cc * 64 + 16 * nt + c16];
                    const float t = Lr[nt] * hr[nt] - Li[nt] * hi[nt] + e.x; hi[nt] = Lr[nt] * hi[nt] + Li[nt] * hr[nt] + e.y; hr[nt] = t; }
            }
        }
    }
    if (DBGT >= 40 && C.bid == 0 && C.tid == 0) { volatile LAS unsigned long long* TSX = (volatile LAS unsigned long long*)(C.lds + RING_BYTES + 1024); const unsigned long long tn = __builtin_amdgcn_s_memrealtime(); TSX[44] += tn - TSX[47]; TSX[47] = tn; }
    ssm_pass<true>(C, b, g, Bf, Cf, lr, li, hr, hi, dskip);
    asm volatile("s_waitcnt vmcnt(0)" ::: "memory");
    __syncthreads();
    counter_signal(C, CW_SSM);
    if (DBGT >= 40 && C.bid == 0 && C.tid == 0) { volatile LAS unsigned long long* TSX = (volatile LAS unsigned long long*)(C.lds + RING_BYTES + 1024); const unsigned long long tn = __builtin_amdgcn_s_memrealtime(); TSX[45] += tn - TSX[47]; TSX[47] = tn; }
}

__device__ __forceinline__ void compress_item(const Ctx& C, int item) {
    const int lane = C.lane, w = C.wave, c16 = lane & 15, q = lane >> 4, tid = C.tid;
    const int ntp = item & 7, g = (item >> 3) & 3, b = (item >> 5) & 3, kv = item >> 7;
    const bf16* SRC = kv ? WSP(bf16, WS_VCI) : WSP(bf16, WS_KCI);
    const bf16* W1 = kv ? WSP(bf16, WS_WV1) : WSP(bf16, WS_WK1);
    const bf16* W2 = kv ? WSP(bf16, WS_WV2) : WSP(bf16, WS_WK2);
    const float* bp = WSP(float, WS_BP) + kv * 128;
    LAS bf16* Hid = (LAS bf16*)C.lds;
    LAS unsigned char* As = C.lds + 8960;
    {
        const bf16* src = SRC + ((size_t)((b * 4 + g) * 4096) << 6);
#pragma unroll
        for (int i = 0; i < 9; ++i) {
            const int id = tid + 512 * i;
            if (id < 528 * 8) { const int r = id >> 3, cc = id & 7; int tok = 512 * ntp + r; tok = tok > SEQ - 1 ? SEQ - 1 : tok;
                *(LAS v4u*)(As + r * 128 + ((cc ^ ((r >> 4) & 7)) << 4)) = *(const v4u*)(src + (size_t)tok * 64 + cc * 8); }
        }
    }
    const bf16* brow = W1 + (size_t)(16 * w + c16) * 2048 + 8 * q;
    f32x4 acc0 = {0.f, 0.f, 0.f, 0.f}, acc1 = acc0;
    __syncthreads();
#pragma unroll 1
    for (int kb = 0; kb < 2; ++kb) {
        bf16x8 bb[32];
#pragma unroll
        for (int k2 = 0; k2 < 32; ++k2) bb[k2] = *(const bf16x8*)(brow + 32 * (32 * kb + k2));
#pragma unroll
        for (int k2 = 0; k2 < 32; ++k2) {
            const int ks = 32 * kb + k2, cc = 4 * (ks & 1) + q;
            const int r0 = 16 * c16 + (ks >> 1), r1 = r0 + 256;
            const bf16x8 a0 = *(const LAS bf16x8*)(As + r0 * 128 + ((cc ^ ((r0 >> 4) & 7)) << 4));
            const bf16x8 a1 = *(const LAS bf16x8*)(As + r1 * 128 + ((cc ^ ((r1 >> 4) & 7)) << 4));
            acc0 = mfma16(a0, bb[k2], acc0); acc1 = mfma16(a1, bb[k2], acc1);
        }
    }
    { const float bias = bp[16 * w + c16];
#pragma unroll
      for (int i = 0; i < 4; ++i) { Hid[(4 * q + i) * HS + 16 * w + c16] = (bf16)(cvtpk(gelu_tanh(acc0[i] + bias), 0.f) & 0xffffu);
                                    Hid[(16 + 4 * q + i) * HS + 16 * w + c16] = (bf16)(cvtpk(gelu_tanh(acc1[i] + bias), 0.f) & 0xffffu); } }
    __syncthreads();
    {
        const int rt = w >> 2, ct = w & 3;
        f32x4 o = {0.f, 0.f, 0.f, 0.f};
#pragma unroll
        for (int ks = 0; ks < 4; ++ks) {
            const bf16x8 a = *(const LAS bf16x8*)(Hid + (16 * rt + c16) * HS + 32 * ks + 8 * q);
            const bf16x8 bb = *(const bf16x8*)(W2 + (size_t)(16 * ct + c16) * 128 + 32 * ks + 8 * q);
            o = mfma16(a, bb, o);
        }
        const int dim = 16 * ct + c16, n0 = 32 * ntp + 16 * rt + 4 * q;
        float ov[4];
#pragma unroll
        for (int i = 0; i < 4; ++i) ov[i] = (n0 + i < 255) ? o[i] : 0.f;
        if (kv == 0) {
            bf16* kc = WSP(bf16, WS_KC) + (size_t)((b * 4 + g) * 256) * 64;
#pragma unroll
            for (int i = 0; i < 4; ++i) kc[(size_t)(n0 + i) * 64 + dim] = (bf16)(cvtpk(ov[i], 0.f) & 0xffffu);
        } else {
            bf16* vc = WSP(bf16, WS_VCT) + (size_t)((b * 4 + g) * 64 + dim) * 256 + n0;
            u32x2 wv; wv.x = cvtpk(ov[0], ov[1]); wv.y = cvtpk(ov[2], ov[3]); *(u32x2*)vc = wv;
        }
    }
    asm volatile("s_waitcnt vmcnt(0)" ::: "memory");
    __syncthreads();
    counter_signal(C, CW_CMP + 16 * (b * 4 + g));
}

constexpr int A_KC = 0, A_VCT = 36864;
constexpr int A_OS = 0;
constexpr int A_IMP = 70656, A_QS = 70656;
constexpr int A_KB = 107520, A_VB = 125952;
constexpr int A_ML = 144384;
#ifndef NOLOCK
#define NOLOCK 0
#endif
constexpr int A_LOCK = RING_BYTES + 768, A_TKT = RING_BYTES + 776;
constexpr int A_LUT = 152576, A_SEL = A_LUT + 2112, A_END = A_SEL + 512;
static_assert(A_ML + 8192 <= A_LUT && A_END <= RING_BYTES, "attention LDS map");
constexpr int KROW = 144, VCROW = 528, VROW = 144, KBUF = 64 * KROW, VBUF = 64 * VROW, LUTS = 132, OSROW = 272;
constexpr float NEG_BIG = -1e30f, LOG2E = 1.4426950408889634f;
#define NEG_INF (-__builtin_inff())

__device__ __forceinline__ float max16(const f32x4 (&s)[4]) {
    float a = fmaxf(fmaxf(s[0].x, s[0].y), fmaxf(s[0].z, s[0].w)), b = fmaxf(fmaxf(s[1].x, s[1].y), fmaxf(s[1].z, s[1].w));
    float c = fmaxf(fmaxf(s[2].x, s[2].y), fmaxf(s[2].z, s[2].w)), d = fmaxf(fmaxf(s[3].x, s[3].y), fmaxf(s[3].z, s[3].w));
    return fmaxf(fmaxf(a, b), fmaxf(c, d));
}

template <int MODE>
__device__ __forceinline__ void far_unit(LAS unsigned char* lds, const bf16x8 (&Kf)[4][2], const bf16x8 (&Vf)[2][4], const LAS float* lutx,
                                         int qi, int tqv, bool valid, int kpos0, float bfar, int q, int r, unsigned long long lockbits, bool lane0) {
    const bf16x8 q0 = *(const LAS bf16x8*)(lds + A_QS + qi * KROW + q * 16), q1 = *(const LAS bf16x8*)(lds + A_QS + qi * KROW + 64 + q * 16);
    LAS float* ml = (LAS float*)(lds + A_ML) + qi * 8;
    LAS float* os = (LAS float*)(lds + A_OS + qi * OSROW + q * 16);
    const float m_ref = ml[4];
    f32x4 s[4];
#pragma unroll
    for (int kt = 0; kt < 4; ++kt) { s[kt] = mfma16(Kf[kt][0], q0, (f32x4){0.f, 0.f, 0.f, 0.f}); s[kt] = mfma16(Kf[kt][1], q1, s[kt]); }
    float cadd = valid ? 0.f : NEG_INF;
    if (MODE == 0) cadd += bfar * LOG2E;
    else {
        const int dq = tqv - kpos0 - 4 * q;
#pragma unroll
        for (int kt = 0; kt < 4; ++kt)
#pragma unroll
            for (int i = 0; i < 4; ++i) { const int d = dq - 16 * kt - i; int dc = d < -1 ? -1 : d; dc = dc > 127 ? 127 : dc; s[kt][i] += lutx[r * LUTS + 1 + dc]; }
    }
    const float cc = cadd - m_ref * LOG2E;
    float ps = 0.f;
#pragma unroll
    for (int kt = 0; kt < 4; ++kt)
#pragma unroll
        for (int i = 0; i < 4; ++i) { const float e = __builtin_amdgcn_exp2f(fminf(__builtin_fmaf(s[kt][i], LOG2E, cc), 80.f)); s[kt][i] = e; ps += e; }
    f32x4 O[4];
#pragma unroll
    for (int mt = 0; mt < 4; ++mt) O[mt] = (f32x4){0.f, 0.f, 0.f, 0.f};
#pragma unroll
    for (int u = 0; u < 2; ++u) {
        const bf16x8 Pf = pack8(s[2 * u][0], s[2 * u][1], s[2 * u][2], s[2 * u][3], s[2 * u + 1][0], s[2 * u + 1][1], s[2 * u + 1][2], s[2 * u + 1][3]);
#pragma unroll
        for (int mt = 0; mt < 4; ++mt) O[mt] = mfma16(Vf[u][mt], Pf, O[mt]);
    }
    LAS unsigned long long* lockw = (LAS unsigned long long*)(lds + A_LOCK);
    asm volatile("" :: "v"(O[0]), "v"(O[1]), "v"(O[2]), "v"(O[3]), "v"(ps) : "memory");
    if (!NOLOCK) {
        unsigned long long old = 0ull;
        if (lane0) old = __hip_atomic_fetch_or(lockw, lockbits, __ATOMIC_ACQUIRE, __HIP_MEMORY_SCOPE_WORKGROUP);
        unsigned long long olds = ((unsigned long long)(unsigned)__builtin_amdgcn_readfirstlane((int)(unsigned)(old >> 32)) << 32) | (unsigned)__builtin_amdgcn_readfirstlane((int)(unsigned)old);
        if (olds & lockbits) {
            const unsigned long long mine = lockbits & ~olds;
            if (mine != 0ull && lane0) __hip_atomic_fetch_and(lockw, ~mine, __ATOMIC_RELAXED, __HIP_MEMORY_SCOPE_WORKGROUP);
            unsigned long long guess = olds & ~lockbits;
#pragma unroll 1
            for (;;) {
                __builtin_amdgcn_s_sleep(1);
                old = guess;
                if (lane0) __hip_atomic_compare_exchange_strong(lockw, &old, guess | lockbits, __ATOMIC_ACQUIRE, __ATOMIC_RELAXED, __HIP_MEMORY_SCOPE_WORKGROUP);
                olds = ((unsigned long long)(unsigned)__builtin_amdgcn_readfirstlane((int)(unsigned)(old >> 32)) << 32) | (unsigned)__builtin_amdgcn_readfirstlane((int)(unsigned)old);
                if (olds == guess) break;
                guess = olds & ~lockbits;
            }
        }
    }
    asm volatile("" ::: "memory");
    if (valid) {
        LAS f32x4* p = (LAS f32x4*)os;
        const f32x4 c0 = p[0], c1 = p[4], c2 = p[8], c3 = p[12]; const float lq = ml[q];
        p[0] = c0 + O[0]; p[4] = c1 + O[1]; p[8] = c2 + O[2]; p[12] = c3 + O[3]; ml[q] = lq + ps;
    }
    LDS_WAIT(); asm volatile("" ::: "memory");
    if (!NOLOCK && lane0) __hip_atomic_fetch_and(lockw, ~lockbits, __ATOMIC_RELEASE, __HIP_MEMORY_SCOPE_WORKGROUP);
}

struct AttnState { float m[2], l[2]; f32x4 O[2][4]; };
constexpr float RESCALE_THR = 8.f;
template <int MODE>
__device__ __forceinline__ void attn_block2(AttnState& S, const LAS unsigned char* kb, const LAS unsigned char* vb, const LAS float* lutx, const bf16x8 (&Qf)[2][2],
                                           const int (&tq)[2], int kpos0, bool on0, bool on1, bool act0, bool act1, float bfar, int c16, int q, int r) {
    bf16x8 Kf[4][2], Vf[2][4];
#pragma unroll
    for (int kt = 0; kt < 4; ++kt)
#pragma unroll
        for (int ks = 0; ks < 2; ++ks) Kf[kt][ks] = *(const LAS bf16x8*)(kb + (16 * kt + c16) * KROW + ks * 64 + q * 16);
#pragma unroll
    for (int u = 0; u < 2; ++u)
#pragma unroll
        for (int mt = 0; mt < 4; ++mt) Vf[u][mt] = *(const LAS bf16x8*)(vb + (16 * mt + c16) * VROW + 64 * u + 16 * q);
    f32x4 s[2][4];
#pragma unroll
    for (int ct = 0; ct < 2; ++ct) {
        if (!(ct ? act1 : act0)) continue;
#pragma unroll
        for (int kt = 0; kt < 4; ++kt) {
            s[ct][kt] = mfma16(Kf[kt][0], Qf[ct][0], (f32x4){0.f, 0.f, 0.f, 0.f});
            s[ct][kt] = mfma16(Kf[kt][1], Qf[ct][1], s[ct][kt]);
        }
    }
#pragma unroll
    for (int ct = 0; ct < 2; ++ct) {
        const bool act = ct ? act1 : act0; const bool on = ct ? on1 : on0;
        if (!act) continue;
        float cadd, mx;
        if (MODE == 0) {
            const float bl = on ? bfar : NEG_INF;
            mx = max16(s[ct]) + bl; cadd = bl * LOG2E;
        } else {
            const int dq = tq[ct] - kpos0 - 4 * q;
            const float offb = on ? 0.f : NEG_INF;
#pragma unroll
            for (int kt = 0; kt < 4; ++kt)
#pragma unroll
                for (int i = 0; i < 4; ++i) {
                    const int d = dq - 16 * kt - i;
                    if (MODE == 1) { int dc = d < -1 ? -1 : d; dc = dc > 127 ? 127 : dc; s[ct][kt][i] += lutx[r * LUTS + 1 + dc] + offb; }
                    else s[ct][kt][i] = d < 512 ? s[ct][kt][i] + bfar : NEG_INF;
                }
            mx = max16(s[ct]); cadd = 0.f;
        }
        mx = xq_max(mx);
        if (__any(mx > S.m[ct] + RESCALE_THR)) {
            const float mn = fmaxf(S.m[ct], mx), alpha = __builtin_amdgcn_exp2f((S.m[ct] - mn) * LOG2E);
            S.m[ct] = mn; S.l[ct] *= alpha;
#pragma unroll
            for (int mt = 0; mt < 4; ++mt) S.O[ct][mt] = S.O[ct][mt] * alpha;
        }
        const float cc = cadd - S.m[ct] * LOG2E;
        float ps = 0.f;
#pragma unroll
        for (int kt = 0; kt < 4; ++kt)
#pragma unroll
            for (int i = 0; i < 4; ++i) { const float e = __builtin_amdgcn_exp2f(__builtin_fmaf(s[ct][kt][i], LOG2E, cc)); s[ct][kt][i] = e; ps += e; }
        S.l[ct] += ps;
#pragma unroll
        for (int u = 0; u < 2; ++u) {
            const bf16x8 Pf = pack8(s[ct][2 * u][0], s[ct][2 * u][1], s[ct][2 * u][2], s[ct][2 * u][3], s[ct][2 * u + 1][0], s[ct][2 * u + 1][1], s[ct][2 * u + 1][2], s[ct][2 * u + 1][3]);
#pragma unroll
            for (int mt = 0; mt < 4; ++mt) S.O[ct][mt] = mfma16(Vf[u][mt], Pf, S.O[ct][mt]);
        }
    }
}

__device__ __forceinline__ void vt_store(LAS unsigned char* rowp, int k0, v4u v) {
    const int u = k0 >> 5, kk = k0 & 31, qq = (kk & 15) >> 2, hh = kk >> 4;
    LAS unsigned char* p = rowp + (32 * u + 8 * qq + 4 * hh) * 2;
    u32x2 a; a.x = v.x; a.y = v.y; u32x2 bq; bq.x = v.z; bq.y = v.w;
    *(LAS u32x2*)p = a; *(LAS u32x2*)(p + 16) = bq;
}

__device__ __forceinline__ int nth_bit(unsigned long long m, int k) { for (int i = 0; i < k; ++i) m &= m - 1ull; return __builtin_ctzll(m); }

__device__ __forceinline__ void attn_item(const Ctx& C, int b, int g, int cur) {
    LAS unsigned char* lds = C.lds;
    int lane_ = C.lane; asm volatile("" : "+v"(lane_));
    const int lane = lane_, w = C.wave, tid = w * 64 + lane, c16 = lane & 15, q = lane >> 4, r = c16 & 3;
    const int t0 = cur * 64;
    const bf16* Qg = WSP(bf16, WS_Q); const bf16* NGB = WSP(bf16, WS_NGB); const bf16* ZA = WSP(bf16, WS_ZA);
    LAS float* lutx = (LAS float*)(lds + A_LUT); LAS float* imp = (LAS float*)(lds + A_IMP);
    LAS unsigned long long* selm = (LAS unsigned long long*)(lds + A_SEL);
    const int srow = tid >> 3, scc = tid & 7, kdst = A_KB + srow * KROW + scc * 16, vdst = A_VB + srow * VROW + scc * 16;
    counter_wait(C, CW_CMP + 16 * (b * 4 + g), 16u);
    {
        const bf16* kcg = WSP(bf16, WS_KC) + (size_t)((b * 4 + g) * 256) * 64;
        const bf16* vcg = WSP(bf16, WS_VCT) + (size_t)((b * 4 + g) * 64) * 256;
#pragma unroll
        for (int i = 0; i < 4; ++i) {
            const int id = tid + 512 * i;
            { const int row = id >> 3, cc = id & 7; *(LAS v4u*)(lds + A_KC + row * KROW + cc * 16) = *(const v4u*)(kcg + row * 64 + cc * 8); }
            { const int dim = id >> 5, kc = id & 31; vt_store(lds + A_VCT + dim * VCROW, 8 * kc, *(const v4u*)(vcg + dim * 256 + kc * 8)); }
        }
        lutx[(tid >> 7) * LUTS + 1 + (tid & 127)] = WSP(float, WS_LUT)[(g * 4 + (tid >> 7)) * 128 + (tid & 127)];
        if (tid < 4) lutx[tid * LUTS] = NEG_INF;
        *(LAS v4u*)(lds + kdst) = *(const v4u*)(WSP(bf16, WS_KS) + ((size_t)((b * 4 + g) * 4096 + srow) << 6) + scc * 8);
        *(LAS v4u*)(lds + vdst) = *(const v4u*)(WSP(bf16, WS_VST) + ((size_t)((b * 4 + g) * 64) << 12) + srow * 64 + scc * 8);
    }
    bf16x8 Qf[2][2]; int tq[2];
#pragma unroll
    for (int ct = 0; ct < 2; ++ct) {
        tq[ct] = t0 + 8 * w + 4 * ct + (c16 >> 2);
        const size_t row = (size_t)(b * SEQ + tq[ct]);
#pragma unroll
        for (int ks = 0; ks < 2; ++ks) Qf[ct][ks] = *(const bf16x8*)(Qg + row * 1024 + (g * 4 + r) * 64 + 32 * ks + 8 * q);
    }
    unsigned gpk[2][2];
#pragma unroll
    for (int ct = 0; ct < 2; ++ct) { const bf16* gp = NGB + (size_t)(b * SEQ + tq[ct]) * 64 + (g * 4 + r) * 3;
        gpk[ct][0] = (unsigned)gp[0] | ((unsigned)gp[1] << 16); gpk[ct][1] = (unsigned)gp[2]; }
#define GATE(ct, br) ((DBG == 4 + (br)) ? 0.f : ((br) == 0 ? bflo(gpk[ct][0]) : ((br) == 1 ? bfhi(gpk[ct][0]) : bflo(gpk[ct][1]))))
    const float bfar = WSP(float, WS_LUT)[(g * 4 + r) * 128 + 127];
    f32x4 Ot[2][4];
    __syncthreads();
    const int nch = (4 * cur + 3 + 31) >> 5;
    {
        float mA[2] = {NEG_BIG, NEG_BIG}, lA[2] = {0.f, 0.f};
#define CMP_PASS1(kt, FARB) do { \
            const bf16x8 k0 = *(const LAS bf16x8*)(lds + A_KC + (16 * (kt) + c16) * KROW + q * 16), k1 = *(const LAS bf16x8*)(lds + A_KC + (16 * (kt) + c16) * KROW + 64 + q * 16); \
            _Pragma("unroll") for (int ct = 0; ct < 2; ++ct) { \
                f32x4 s = mfma16(k0, Qf[ct][0], (f32x4){0.f, 0.f, 0.f, 0.f}); s = mfma16(k1, Qf[ct][1], s); \
                if (FARB) { s[0] += bfar; s[1] += bfar; s[2] += bfar; s[3] += bfar; } \
                else { const int dq = tq[ct] - 31 - 64 * q - 256 * (kt); \
                    _Pragma("unroll") for (int i = 0; i < 4; ++i) { int dc = dq - 16 * i; dc = dc < -1 ? -1 : dc; dc = dc > 127 ? 127 : dc; s[i] += lutx[r * LUTS + 1 + dc]; } } \
                const float mx = fmaxf(fmaxf(s[0], s[1]), fmaxf(s[2], s[3])); \
                const float mn = fmaxf(mA[ct], mx); const float cc = -mn * LOG2E; \
                const float ps = (__builtin_amdgcn_exp2f(__builtin_fmaf(s[0], LOG2E, cc)) + __builtin_amdgcn_exp2f(__builtin_fmaf(s[1], LOG2E, cc))) + \
                                 (__builtin_amdgcn_exp2f(__builtin_fmaf(s[2], LOG2E, cc)) + __builtin_amdgcn_exp2f(__builtin_fmaf(s[3], LOG2E, cc))); \
                lA[ct] = lA[ct] * __builtin_amdgcn_exp2f((mA[ct] - mn) * LOG2E) + ps; mA[ct] = mn; } } while (0)
        const int tqmin = t0 + 8 * w;
        int kfar = tqmin >= 142 ? (tqmin - 142) >> 8 : 0; kfar = kfar < 2 * nch ? kfar : 2 * nch; kfar &= ~1;
#pragma unroll 1
        for (int kt = 0; kt < kfar; kt += 2) { CMP_PASS1(kt, true); CMP_PASS1(kt + 1, true); }
#pragma unroll 1
        for (int kt = kfar; kt < 2 * nch; kt += 2) { CMP_PASS1(kt, false); CMP_PASS1(kt + 1, false); }
#undef CMP_PASS1
        float Mc[2], invL[2];
#pragma unroll
        for (int ct = 0; ct < 2; ++ct) {
            const float mm = xq_max(mA[ct]);
            const float ll = xq_sum(lA[ct] * __builtin_amdgcn_exp2f((mA[ct] - mm) * LOG2E));
            Mc[ct] = -mm * LOG2E; invL[ct] = ll > 0.f ? 1.f / ll : 0.f;
        }
        f32x4 Oc[2][4];
#pragma unroll
        for (int ct = 0; ct < 2; ++ct)
#pragma unroll
            for (int mt = 0; mt < 4; ++mt) Oc[ct][mt] = (f32x4){0.f, 0.f, 0.f, 0.f};
        float carry[2] = {0.f, 0.f};
#define CMP_PASS2(u, FARB) do { \
            float p[2][2][4]; \
            _Pragma("unroll") for (int hf = 0; hf < 2; ++hf) { \
                const int kt = 2 * (u) + hf; \
                const bf16x8 k0 = *(const LAS bf16x8*)(lds + A_KC + (16 * kt + c16) * KROW + q * 16), k1 = *(const LAS bf16x8*)(lds + A_KC + (16 * kt + c16) * KROW + 64 + q * 16); \
                _Pragma("unroll") for (int ct = 0; ct < 2; ++ct) { \
                    f32x4 s = mfma16(k0, Qf[ct][0], (f32x4){0.f, 0.f, 0.f, 0.f}); s = mfma16(k1, Qf[ct][1], s); \
                    const int dq = tq[ct] - 31 - 64 * q - 256 * kt; \
                    float own = 0.f; \
                    _Pragma("unroll") for (int i = 0; i < 4; ++i) { float bi_; \
                        if (FARB) bi_ = bfar; else { int dc = dq - 16 * i; dc = dc < -1 ? -1 : dc; dc = dc > 127 ? 127 : dc; bi_ = lutx[r * LUTS + 1 + dc]; } \
                        const float e = __builtin_amdgcn_exp2f(__builtin_fmaf(s[i] + bi_, LOG2E, Mc[ct])) * invL[ct]; p[ct][hf][i] = e; own += e; } \
                      \
                    float ra, rb; \
                    { auto s16 = __builtin_amdgcn_permlane16_swap(__builtin_bit_cast(unsigned, p[ct][hf][3]), __builtin_bit_cast(unsigned, p[ct][hf][3]), false, false); \
                      const unsigned x16 = (q & 1) ? (unsigned)s16[0] : (unsigned)s16[1]; \
                      ra = __builtin_bit_cast(float, x16); \
                      auto s32 = __builtin_amdgcn_permlane32_swap(x16, x16, false, false); \
                      rb = __builtin_bit_cast(float, (q & 2) ? (unsigned)s32[0] : (unsigned)s32[1]); } \
                    const float prev3 = (q & 1) ? ra : (q == 2 ? rb : carry[ct]); carry[ct] = rb; \
                    float v = own + prev3; v += dppf<DPP_XOR1>(v); v += dppf<DPP_XOR2>(v); \
                    if (r == 0) imp[(8 * w + 4 * ct + (c16 >> 2)) * 64 + 4 * kt + q] = v; \
                } \
            } \
            bf16x8 Pf[2]; \
            _Pragma("unroll") for (int ct = 0; ct < 2; ++ct) Pf[ct] = pack8(p[ct][0][0], p[ct][0][1], p[ct][0][2], p[ct][0][3], p[ct][1][0], p[ct][1][1], p[ct][1][2], p[ct][1][3]); \
            _Pragma("unroll") for (int mt = 0; mt < 4; ++mt) { \
                const bf16x8 a = *(const LAS bf16x8*)(lds + A_VCT + (16 * mt + c16) * VCROW + 64 * (u) + 16 * q); \
                _Pragma("unroll") for (int ct = 0; ct < 2; ++ct) Oc[ct][mt] = mfma16(a, Pf[ct], Oc[ct][mt]); \
            } } while (0)
#pragma unroll 1
        for (int u = 0; u < (kfar >> 1); ++u) CMP_PASS2(u, true);
#pragma unroll 1
        for (int u = (kfar >> 1); u < nch; ++u) CMP_PASS2(u, false);
#undef CMP_PASS2
#pragma unroll
        for (int ct = 0; ct < 2; ++ct)
#pragma unroll
            for (int mt = 0; mt < 4; ++mt) Ot[ct][mt] = Oc[ct][mt] * GATE(ct, 0);
    }
    LDS_WAIT(); asm volatile("" ::: "memory");
    {
        const int ts = lane >> 3, sub = lane & 7;
        unsigned long long mask;
        if (cur <= 7) mask = (2ull << cur) - 1ull;
        else {
            float v[8];
#pragma unroll
            for (int i = 0; i < 8; ++i) { const int j = sub * 8 + i; v[i] = (j >= 1 && j <= cur - 2) ? imp[(8 * w + ts) * 64 + j] : -3e38f; }
            mask = 1ull | (1ull << cur) | (1ull << (cur - 1));
#pragma unroll 1
            for (int rd = 0; rd < 5; ++rd) {
                float best = v[0]; int bi = 0;
#pragma unroll
                for (int i = 1; i < 8; ++i) if (v[i] > best) { best = v[i]; bi = i; }
                int bj = sub * 8 + bi;
#pragma unroll
                for (int st = 0; st < 3; ++st) {
                    const float ov = st == 0 ? dppf<DPP_XOR1>(best) : (st == 1 ? dppf<DPP_XOR2>(best) : dppf<DPP_HMIRROR>(best));
                    const int oj = st == 0 ? dppi<DPP_XOR1>(bj) : (st == 1 ? dppi<DPP_XOR2>(bj) : dppi<DPP_HMIRROR>(bj));
                    if (ov > best || (ov == best && oj < bj)) { best = ov; bj = oj; } }
                mask |= 1ull << bj;
#pragma unroll
                for (int i = 0; i < 8; ++i) if (bj == sub * 8 + i) v[i] = -3e38f;
            }
        }
        if (sub == 0) selm[8 * w + ts] = mask;
    }
    LDS_WAIT(); asm volatile("" ::: "memory");
    __syncthreads();
#pragma unroll
    for (int ct = 0; ct < 2; ++ct) {
        const int qi = (8 * w + 4 * ct + (c16 >> 2)) * 4 + r;
        *(LAS bf16x8*)(lds + A_QS + qi * KROW + q * 16) = Qf[ct][0]; *(LAS bf16x8*)(lds + A_QS + qi * KROW + 64 + q * 16) = Qf[ct][1];
#pragma unroll
        for (int mt = 0; mt < 4; ++mt) *(LAS f32x4*)(lds + A_OS + qi * OSROW + q * 16 + 64 * mt) = (f32x4){0.f, 0.f, 0.f, 0.f};
        ((LAS float*)(lds + A_ML))[qi * 8 + q] = 0.f; if (q == 0) ((LAS float*)(lds + A_ML))[qi * 8 + 4] = NEG_BIG;
        if (q == 1) ((LAS float*)(lds + A_ML))[qi * 8 + 5] = GATE(ct, 1);
        if (q == 2) ((LAS float*)(lds + A_ML))[qi * 8 + 6] = GATE(ct, 2);
    }
    __syncthreads();
    {
        const int nd = cur + 1 < 3 ? cur + 1 : 3, jlo = cur >= 8 ? cur - 8 : 0, nw = cur - jlo + 1, ntot = nd + nw;
#define LIST_BLOCK(idx) ((idx) < nd ? ((idx) == 0 ? 0 : cur - (nd - 1 - (idx))) : jlo + (idx) - nd)
#define STAGE_FETCH(dk, dv, idx) do { const int brn_ = (idx) >= nd, jn_ = LIST_BLOCK(idx); \
            const bf16* Kg_ = brn_ ? WSP(bf16, WS_KW) : WSP(bf16, WS_KS); const bf16* Vg_ = brn_ ? WSP(bf16, WS_VWT) : WSP(bf16, WS_VST); \
            dk = *(const v4u*)(Kg_ + ((size_t)((b * 4 + g) * 4096 + 64 * jn_ + srow) << 6) + scc * 8); \
            dv = *(const v4u*)(Vg_ + ((size_t)((b * 4 + g) * 64 + jn_) << 12) + srow * 64 + scc * 8); } while (0)
        v4u ka = {0u, 0u, 0u, 0u}, va = ka;
        if (ntot > 1) STAGE_FETCH(ka, va, 1);
        AttnState S;
#pragma unroll
        for (int ct = 0; ct < 2; ++ct) { S.m[ct] = NEG_BIG; S.l[ct] = 0.f;
#pragma unroll
            for (int mt = 0; mt < 4; ++mt) S.O[ct][mt] = (f32x4){0.f, 0.f, 0.f, 0.f}; }
#pragma unroll 1
        for (int ib = 0; ib < nd; ++ib) {
            const int j = LIST_BLOCK(ib), bufo = (ib & 1);
            v4u kr = {0u, 0u, 0u, 0u}, vr = kr;
            if (ib + 2 <= nd && ib + 2 < ntot) STAGE_FETCH(kr, vr, ib + 2);
            const LAS unsigned char* kb = lds + A_KB + bufo * KBUF; const LAS unsigned char* vb = lds + A_VB + bufo * VBUF;
            if (cur - j <= 2) attn_block2<1>(S, kb, vb, lutx, Qf, tq, 64 * j, true, true, true, true, bfar, c16, q, r);
            else attn_block2<0>(S, kb, vb, lutx, Qf, tq, 64 * j, true, true, true, true, bfar, c16, q, r);
            if (ib + 1 < ntot) { *(LAS v4u*)(lds + kdst + (bufo ^ 1) * KBUF) = ka; *(LAS v4u*)(lds + vdst + (bufo ^ 1) * VBUF) = va; }
            ka = kr; va = vr;
            __syncthreads();
        }
#pragma unroll
        for (int ct = 0; ct < 2; ++ct) {
            const int qi = (8 * w + 4 * ct + (c16 >> 2)) * 4 + r;
#pragma unroll
            for (int mt = 0; mt < 4; ++mt) *(LAS f32x4*)(lds + A_OS + qi * OSROW + q * 16 + 64 * mt) = S.O[ct][mt];
            ((LAS float*)(lds + A_ML))[qi * 8 + q] = S.l[ct]; if (q == 0) ((LAS float*)(lds + A_ML))[qi * 8 + 4] = S.m[ct];
        }
        if (tid == 0) *(LAS unsigned*)(lds + A_TKT) = 0u;
        __syncthreads();
#pragma unroll 1
        for (;;) {
            int tk_ = 0;
            if (lane == 0) tk_ = (int)__hip_atomic_fetch_add((LAS unsigned*)(lds + A_TKT), 1u, __ATOMIC_RELAXED, __HIP_MEMORY_SCOPE_WORKGROUP);
            tk_ = __builtin_amdgcn_readfirstlane(tk_);
            const int nfar = cur - 2;
            if (tk_ >= 2 * nfar) break;
            const bool sweep2 = tk_ >= nfar;
            const int j = 1 + (sweep2 ? tk_ - nfar : tk_);
            const unsigned wj = ((const LAS unsigned*)(lds + A_SEL))[2 * lane + (j >> 5)];
            const unsigned long long amask = __ballot((wj >> (j & 31)) & 1u);
            const int na = __builtin_popcountll(amask), nu = (na + 3) >> 2;
            if (nu == 0 || (nu >= 2) == sweep2) continue;
            bf16x8 Kf[4][2], Vf[2][4];
            { const bf16* kg = WSP(bf16, WS_KS) + ((size_t)((b * 4 + g) * 4096 + 64 * j) << 6); const bf16* vg = WSP(bf16, WS_VST) + ((size_t)((b * 4 + g) * 64 + j) << 12);
#pragma unroll
              for (int kt = 0; kt < 4; ++kt)
#pragma unroll
                  for (int ks = 0; ks < 2; ++ks) Kf[kt][ks] = *(const bf16x8*)(kg + (16 * kt + c16) * 64 + ks * 32 + q * 8);
#pragma unroll
              for (int u = 0; u < 2; ++u)
#pragma unroll
                  for (int mt = 0; mt < 4; ++mt) Vf[u][mt] = *(const bf16x8*)(vg + (16 * mt + c16) * 64 + 32 * u + 8 * q); }
#pragma unroll 1
            for (int un = 0; un < nu; ++un) {
                int tk; bool valid; unsigned long long lockbits;
                if (amask == ~0ull) { tk = 4 * un + (c16 >> 2); valid = true; lockbits = 0xfull << (4 * un); }
                else { unsigned long long m = amask; for (int i = 0; i < 4 * un; ++i) m &= m - 1ull;
                    const int rem = na - 4 * un;
                    int t0s = __builtin_ctzll(m); m &= m - 1ull; int t1s = rem > 1 ? __builtin_ctzll(m) : t0s; if (rem > 1) m &= m - 1ull;
                    int t2s = rem > 2 ? __builtin_ctzll(m) : t0s; if (rem > 2) m &= m - 1ull; int t3s = rem > 3 ? __builtin_ctzll(m) : t0s;
                    lockbits = (1ull << t0s) | (1ull << t1s) | (1ull << t2s) | (1ull << t3s);
                    const int sl = c16 >> 2; tk = sl == 0 ? t0s : (sl == 1 ? t1s : (sl == 2 ? t2s : t3s)); valid = sl < rem; }
                const int qi = tk * 4 + r, tqv = t0 + tk;
                if (cur - j <= 2) far_unit<1>(lds, Kf, Vf, lutx, qi, tqv, valid, 64 * j, 0.f, q, r, lockbits, lane == 0);
                else far_unit<0>(lds, Kf, Vf, lutx, qi, tqv, valid, 64 * j, lutx[r * LUTS + 128], q, r, lockbits, lane == 0);
            }
        }
        if (nd + 1 < ntot) STAGE_FETCH(ka, va, nd + 1);
        LDS_WAIT(); asm volatile("" ::: "memory");
        __syncthreads();
        LAS f32x4* otl = (LAS f32x4*)(lds + A_OS + w * 8192) + lane;
#pragma unroll
        for (int ct = 0; ct < 2; ++ct) {
            const int qi = (8 * w + 4 * ct + (c16 >> 2)) * 4 + r;
            const LAS float* ml = (const LAS float*)(lds + A_ML) + qi * 8;
            const float L = xq_sum(ml[q]); const float inv = L > 0.f ? ml[5] / L : 0.f;
#pragma unroll
            for (int mt = 0; mt < 4; ++mt) Ot[ct][mt] += *(const LAS f32x4*)(lds + A_OS + qi * OSROW + q * 16 + 64 * mt) * inv;
        }
        __syncthreads();
#pragma unroll
        for (int ct = 0; ct < 2; ++ct)
#pragma unroll
            for (int mt = 0; mt < 4; ++mt) otl[(ct * 4 + mt) * 64] = Ot[ct][mt];
#pragma unroll
        for (int ct = 0; ct < 2; ++ct) { S.m[ct] = NEG_BIG; S.l[ct] = 0.f;
#pragma unroll
            for (int mt = 0; mt < 4; ++mt) S.O[ct][mt] = (f32x4){0.f, 0.f, 0.f, 0.f};
            const int qi = (8 * w + 4 * ct + (c16 >> 2)) * 4 + r;
            Qf[ct][0] = *(const LAS bf16x8*)(lds + A_QS + qi * KROW + q * 16); Qf[ct][1] = *(const LAS bf16x8*)(lds + A_QS + qi * KROW + 64 + q * 16); }
#pragma unroll 1
        for (int ib = nd; ib < ntot; ++ib) {
            const int j = LIST_BLOCK(ib), bufo = (ib & 1);
            v4u kr = {0u, 0u, 0u, 0u}, vr = kr;
            if (ib + 2 < ntot) STAGE_FETCH(kr, vr, ib + 2);
            const LAS unsigned char* kb = lds + A_KB + bufo * KBUF; const LAS unsigned char* vb = lds + A_VB + bufo * VBUF;
            const float bfw = lutx[r * LUTS + 128];
            if (cur - j <= 2) attn_block2<1>(S, kb, vb, lutx, Qf, tq, 64 * j, true, true, true, true, bfw, c16, q, r);
            else if (cur - j == 8) attn_block2<2>(S, kb, vb, lutx, Qf, tq, 64 * j, true, true, true, true, bfw, c16, q, r);
            else attn_block2<0>(S, kb, vb, lutx, Qf, tq, 64 * j, true, true, true, true, bfw, c16, q, r);
            if (ib + 1 < ntot) { *(LAS v4u*)(lds + kdst + (bufo ^ 1) * KBUF) = ka; *(LAS v4u*)(lds + vdst + (bufo ^ 1) * VBUF) = va; }
            ka = kr; va = vr;
            __syncthreads();
        }
#undef STAGE_FETCH
#undef LIST_BLOCK
#pragma unroll
        for (int ct = 0; ct < 2; ++ct) {
            const int qi = (8 * w + 4 * ct + (c16 >> 2)) * 4 + r;
            const float L = xq_sum(S.l[ct]); const float inv = L > 0.f ? ((const LAS float*)(lds + A_ML))[qi * 8 + 6] / L : 0.f;
#pragma unroll
            for (int mt = 0; mt < 4; ++mt) Ot[ct][mt] = otl[(ct * 4 + mt) * 64] + S.O[ct][mt] * inv;
        }
    }
    bf16* OA = WSP(bf16, WS_OAB);
    int lane_e = lane; asm volatile("" : "+v"(lane_e));
    const int c16e = lane_e & 15, qe = lane_e >> 4, re = c16e & 3;
#pragma unroll
    for (int ct = 0; ct < 2; ++ct) {
        const int tqe = t0 + 8 * w + 4 * ct + (c16e >> 2);
        const size_t base = (size_t)(b * SEQ + tqe) * 1024 + (g * 4 + re) * 64 + 4 * qe, obase = base + (size_t)(b * SEQ + tqe) * 1024;
#pragma unroll
        for (int mt = 0; mt < 4; ++mt) {
            const u32x2 z = *(const u32x2*)(ZA + base + 16 * mt);
            const f32x4 ov = Ot[ct][mt];
            u32x2 o; o.x = cvtpk(ov.x * bflo(z.x), ov.y * bfhi(z.x)); o.y = cvtpk(ov.z * bflo(z.y), ov.w * bfhi(z.y));
            *(u32x2*)(OA + obase + 16 * mt) = o;
        }
    }
    __syncthreads();
}

#ifndef PHMASK
#define PHMASK 0x1ff
#endif
struct Args { const float* in[27]; float* out; unsigned char* ws; int pad0, pad1; };

__global__ void __launch_bounds__(NTHR, 2) mega_fwd(Args args) {
    extern __shared__ __attribute__((aligned(16))) unsigned char lds_raw[];
    Ctx C;
    C.out = args.out; C.ws = args.ws; C.lds = (LAS unsigned char*)lds_raw;
    C.wave = __builtin_amdgcn_readfirstlane((int)threadIdx.x >> 6); C.G = gridDim.x; C.bid = blockIdx.x;
#define REFRESH_TID() do { unsigned m_ = ~0u; asm volatile("" : "+s"(m_)); const int l_ = __builtin_amdgcn_mbcnt_hi(m_, __builtin_amdgcn_mbcnt_lo(m_, 0u)); C.lane = l_; C.tid = C.wave * 64 + l_; } while (0)
    REFRESH_TID();
    volatile LAS unsigned* MISC = (volatile LAS unsigned*)(C.lds + MISC_OFF);
    for (int u = C.tid; u < (LDS_BYTES - RING_BYTES) / 4; u += NTHR) ((LAS unsigned*)(C.lds + RING_BYTES))[u] = 0u;
    __syncthreads();
    if (C.tid < 27) { const unsigned long long pv = (unsigned long long)args.in[C.tid]; LAS unsigned* tab = (LAS unsigned*)(C.lds + PTR_OFF); tab[2 * C.tid] = (unsigned)pv; tab[2 * C.tid + 1] = (unsigned)(pv >> 32); }
    __syncthreads();
    XcdBarrier bar = xcd_barrier_post((unsigned*)(C.ws + WS_CTL) + CW_BAR, MISC + 8, C.tid == 0);
    volatile LAS unsigned long long* TS = (volatile LAS unsigned long long*)(C.lds + RING_BYTES + 1024);
    int n_ts = 0;
#define STAMP() do { if (DBGT >= 0) { if (C.tid == 0) TS[n_ts] = __builtin_amdgcn_s_memrealtime(); ++n_ts; } } while (0)
#define GRID_BAR() do { REFRESH_TID(); xcd_barrier(bar, C.tid == 0); STAMP(); REFRESH_TID(); } while (0)
    STAMP();
    LAS unsigned char* ring = C.lds;

    if (PHMASK & (1 << 0))
    phase0(C);
    REFRESH_TID(); counter_wait(C, CW_GEMV, 96u); STAMP(); REFRESH_TID();
    if (PHMASK & (1 << 1))
    phase1(C);
    GRID_BAR();
    if (PHMASK & (1 << 2))
    {
#ifndef NO_BFGEMM
        { pg8::Gemm g{WSP(const bf16, WS_H), WSP(const bf16, WS_WIN), MTOK, INB, DM}; pg8::StaticOrder S; S.init(MTOK, INB, C.G, C.bid);
          EpiIn E{C.ws, 0};
          pg8::gemm_phase<EpiIn, pg8::StaticOrder, true, true, false>(ring, g, S, E, C.tid); }
#endif
#ifndef NO_FP8GEMM
        { pg8::Gemm g{WSP(const bf16, WS_OAB), WSP(const bf16, WS_W8), MTOK, ING, DM / 2}; pg8::StaticOrder S; S.init(MTOK, ING, C.G, (C.bid + C.G / 2) % C.G);
          EpiIn E{C.ws, 1};
          pg8::gemm_phase<EpiIn, pg8::StaticOrder, true, true, true>(ring, g, S, E, C.tid); }
#endif
    }
    GRID_BAR();
    if (PHMASK & (1 << 3))
    {
        for (int it = C.bid; it < 256; it += C.G) compress_item(C, it);
        for (int it = C.bid; it < 256; it += C.G) ssm_item(C, it);
    }
    __syncthreads(); STAMP(); REFRESH_TID();
    if (PHMASK & (1 << 4))
    {
        __syncthreads();
        if (DBGT >= 0 && C.tid == 0) TS[15] = __builtin_amdgcn_s_memrealtime();
        REFRESH_TID();
#ifndef NO_ATTN
        for (int k = C.bid; k < 1024; k += C.G) {
            const int rd = k >> 8, kk = k & 255, bg = kk & 15, jj = kk >> 4;
            const unsigned long long tw = (rd == 0) ? (jj < 8 ? 0x382d36393f3a3e3dull : 0x353326312e2c2f34ull)
                                        : (rd == 1) ? (jj < 8 ? 0x1f2a272b30373c3bull : 0x181a251d1c211e17ull)
                                                    : (jj < 8 ? 0x1520232422282932ull : 0x10111b1219161413ull);
            const int cur = (rd == 3) ? jj : (int)((tw >> (8 * (jj & 7))) & 255ull);
            attn_item(C, bg >> 2, bg & 3, cur);
        }
#endif
    }
    __syncthreads(); STAMP(); REFRESH_TID();
    if (PHMASK & (1 << 5))
    {
        counter_wait(C, CW_SSM, 256u);
        pg8::Gemm g{WSP(const bf16, WS_H), WSP(const bf16, WS_WGLU), MTOK, 1024, 1024}; pg8::StaticOrder S; S.init(MTOK, 1024, C.G, C.bid);
        EpiMix<0> E{WSP(const bf16, WS_H), WSP(const bf16, WS_ZB), WSP(bf16, WS_OAB) + 1024, inp(C, 21), nullptr, nullptr, 1024, 2048};
        pg8::gemm_phase<EpiMix<0>, pg8::StaticOrder, false, true>(ring, g, S, E, C.tid);
    }
    GRID_BAR();
    if (PHMASK & (1 << 6))
    {
        pg8::Gemm g{WSP(const bf16, WS_OAB), WSP(const bf16, WS_WBN), MTOK, 2048, 1024, 2048}; pg8::SplitKOrder S; S.init(MTOK, 2048, C.G, C.bid);
        EpiMix<1> E{WSP(const bf16, WS_GA), WSP(const bf16, WS_GB), WSP(bf16, WS_H), nullptr, nullptr, nullptr, 2048, 2048};
        pg8::gemm_phase<EpiMix<1>, pg8::SplitKOrder, true, true>(ring, g, S, E, C.tid);
    }
    GRID_BAR();
    if (PHMASK & (1 << 7))
    {
        pg8::Gemm g{WSP(const bf16, WS_H), WSP(const bf16, WS_WOUT), MTOK, 2048, 2048}; pg8::StaticOrder S; S.init(MTOK, 2048, C.G, C.bid);
        EpiMix<3> E{nullptr, nullptr, WSP(bf16, WS_Q), nullptr, WSP(const float, WS_MOD), nullptr, 2048, 2048};
        pg8::gemm_phase<EpiMix<3>, pg8::StaticOrder, true, true>(ring, g, S, E, C.tid);
    }
    GRID_BAR();
    if (PHMASK & (1 << 8))
    phase_ln_out(C);
    if (DBGT >= 0) {
        __syncthreads(); STAMP(); __syncthreads();
        if (C.bid == 0 && C.wave == 1) {
            const float T2 = (DBGT == 19) ? (float)(TS[9] - TS[0]) * 0.01f * DBGS : (DBGT >= 21) ? (float)TS[DBGT] * 0.01f * DBGS : (DBGT == 20) ? (float)(TS[15] - TS[4]) * 0.01f * DBGS : (float)(TS[DBGT + 1] - TS[DBGT]) * 0.01f * DBGS;
            f32x4* zr = (f32x4*)(C.out + (size_t)1 * DM) + C.lane;
#pragma unroll
            for (int j = 0; j < 8; ++j) { f32x4 v = zr[64 * j]; v.x += T2; v.y += T2; v.z += T2; v.w += T2; zr[64 * j] = v; }
        }
    }
}

extern "C" void kernel_launch(void* const* d_in, const int* in_sizes, int n_in, void* d_out, int out_size, void* d_ws, size_t ws_size, hipStream_t stream) {
    static int grid = 0;
    if (grid == 0) {
        if (n_in != 27 || out_size != MTOK * DM || ws_size < WS_END) { fprintf(stderr, "kernel_launch: unexpected problem (n_in %d, out %d, ws %zu)\n", n_in, out_size, ws_size); grid = -1; return; }
        int dev = 0, cus = 0, per_cu = 0;
        if (hipGetDevice(&dev) != hipSuccess || hipDeviceGetAttribute(&cus, hipDeviceAttributeMultiprocessorCount, dev) != hipSuccess) { grid = -1; return; }
        if (hipFuncSetAttribute((const void*)mega_fwd, hipFuncAttributeMaxDynamicSharedMemorySize, LDS_BYTES) != hipSuccess) { fprintf(stderr, "kernel_launch: hipFuncSetAttribute failed\n"); grid = -1; return; }
        if (hipOccupancyMaxActiveBlocksPerMultiprocessor(&per_cu, (const void*)mega_fwd, NTHR, LDS_BYTES) != hipSuccess || per_cu < 1) { fprintf(stderr, "kernel_launch: occupancy query says %d\n", per_cu); }
        (void)hipGetLastError();
        grid = cus;
    }
    if (grid < 0) return;
    if (hipMemsetAsync((char*)d_ws + 16384, 0, 16384, stream) != hipSuccess) return;
    Args a{};
    for (int i = 0; i < 27; ++i) a.in[i] = (const float*)d_in[i];
    a.out = (float*)d_out; a.ws = (unsigned char*)d_ws;
    hipLaunchKernelGGL(mega_fwd, dim3(grid), dim3(NTHR), LDS_BYTES, stream, a);
}
```
